# Optimizing an MI355X kernel written in HIP

```python
import math
import jax, jax.numpy as jnp
from jax import lax
import numpy as np

D_MODEL = 1024
BATCH = 16
SEQ = 2048
DEPTH = 4

CHUNK = 64
RET_HEADS = 4
RET_QK_DIM = 128
RET_V_DIM = 256
RET_QK = RET_HEADS * RET_QK_DIM
RET_V = RET_HEADS * RET_V_DIM
ROPE_BASE = 10000.0
SG_BLOCK = 128
SG_GROUPS = 8
SG_WIDTH = D_MODEL
SG_GROUP_DIM = SG_WIDTH // SG_GROUPS
IN_SIZES = [RET_QK, RET_QK, RET_V, RET_V, SG_WIDTH, SG_WIDTH, D_MODEL, D_MODEL]
IN_SPLITS = [int(s) for s in np.cumsum(IN_SIZES)[:-1]]
IN_WIDTH = int(sum(IN_SIZES))
N_EXPERTS = 32
TOP_K = 4
D_EXPERT = D_MODEL
SWIGLU_LIMIT = 7.0
SWIGLU_ALPHA = 1.702
MOE_BLOCK = 128
LN_EPS = 1e-5
DN_ALPHA = (2 * DEPTH) ** 0.25
DN_BETA = (8 * DEPTH) ** -0.25

kernel_name = "retention_sgu_moe_deepnorm_hybrid"


def layer_norm(x, g, b):
    xf = x.astype(jnp.float32)
    mu = jnp.mean(xf, -1, keepdims=True)
    var = jnp.mean(jnp.square(xf - mu), -1, keepdims=True)
    return ((xf - mu) * lax.rsqrt(var + LN_EPS) * g + b).astype(x.dtype)


def head_norm(y):
    yf = y.astype(jnp.float32)
    mu = jnp.mean(yf, -1, keepdims=True)
    var = jnp.mean(jnp.square(yf - mu), -1, keepdims=True)
    return (yf - mu) * lax.rsqrt(var + LN_EPS)


def rotary(x, pos):
    half = x.shape[-1] // 2
    inv = ROPE_BASE ** (-jnp.arange(half, dtype=jnp.float32) / half)
    ang = pos.astype(jnp.float32)[:, None] * inv[None, :]
    cos = jnp.cos(ang)[None, :, None, :]
    sin = jnp.sin(ang)[None, :, None, :]
    x1, x2 = x[..., :half], x[..., half:]
    return jnp.concatenate([x1 * cos - x2 * sin, x1 * sin + x2 * cos], -1)


def retention(q, k, v):
    B, S, H, dk = q.shape
    dv = v.shape[-1]
    n = S // CHUNK
    log_g = jnp.log(1.0 - jnp.exp(jnp.linspace(math.log(1.0 / 32), math.log(1.0 / 512), H)))
    idx = jnp.arange(CHUNK, dtype=jnp.float32)
    diff = idx[:, None] - idx[None, :]
    inner_decay = jnp.where(diff >= 0, jnp.exp(log_g[:, None, None] * jnp.maximum(diff, 0.0)), 0.0)
    q_decay = jnp.exp(log_g[:, None] * (idx[None, :] + 1.0))
    k_decay = jnp.exp(log_g[:, None] * (CHUNK - 1.0 - idx[None, :]))
    chunk_decay = jnp.exp(log_g * CHUNK)
    qc = q.astype(jnp.float32).reshape(B, n, CHUNK, H, dk)
    kc = k.astype(jnp.float32).reshape(B, n, CHUNK, H, dk)
    vc = v.astype(jnp.float32).reshape(B, n, CHUNK, H, dv)
    scores = jnp.einsum('bnihd,bnjhd->bnhij', qc, kc) * inner_decay
    inner = jnp.einsum('bnhij,bnjhe->bnihe', scores, vc)

    def step(state, blk):
        qb, kb, vb = blk
        cross = jnp.einsum('bihd,bhde->bihe', qb, state) * q_decay.T[None, :, :, None]
        state = state * chunk_decay[None, :, None, None] + jnp.einsum(
            'bjhd,hj,bjhe->bhde', kb, k_decay, vb)
        return state, cross

    init = jnp.zeros((B, H, dk, dv), jnp.float32)
    _, cross = lax.scan(step, init, (qc.swapaxes(0, 1), kc.swapaxes(0, 1), vc.swapaxes(0, 1)))
    out = inner + cross.swapaxes(0, 1)
    return out.reshape(B, S, H, dv)


def spatial_gating(u, vs, ln_g, ln_b, w_s, b_s):
    B, S, _ = u.shape
    vn = layer_norm(vs, ln_g, ln_b)
    nb = S // SG_BLOCK
    vb = vn.reshape(B, nb, SG_BLOCK, SG_GROUPS, SG_GROUP_DIM)
    chunk_id = jnp.arange(SG_BLOCK) // CHUNK
    mask = chunk_id[:, None] >= chunk_id[None, :]
    w = jnp.where(mask[None], w_s, 0.0)
    mixed = jnp.einsum('gqp,bnpgc->bnqgc', w, vb) + b_s.T[None, None, :, :, None]
    return u * mixed.reshape(B, S, SG_WIDTH)


def moe(x, router_w, router_b, w1, b1, w2, b2):
    B, S, D = x.shape
    T = B * S
    A = T * TOP_K
    xt = x.reshape(T, D)
    logits = (xt @ router_w + router_b).astype(jnp.float32)
    top_val, top_idx = lax.top_k(logits, TOP_K)
    gates = jax.nn.softmax(top_val, axis=-1)
    e_flat = top_idx.reshape(A)
    tok_flat = jnp.arange(A, dtype=jnp.int32) // TOP_K
    g_flat = gates.reshape(A)
    order = jnp.argsort(e_flat)
    e_sorted = e_flat[order]
    counts = jnp.bincount(e_flat, length=N_EXPERTS)
    padded = (counts + MOE_BLOCK - 1) // MOE_BLOCK * MOE_BLOCK
    start = jnp.cumsum(counts) - counts
    pend = jnp.cumsum(padded)
    pstart = pend - padded
    dest = pstart[e_sorted] + jnp.arange(A) - start[e_sorted]
    P = A + N_EXPERTS * MOE_BLOCK
    n_blocks = P // MOE_BLOCK
    buf_tok = jnp.zeros((P,), jnp.int32).at[dest].set(tok_flat[order])
    buf_gate = jnp.zeros((P,), jnp.float32).at[dest].set(g_flat[order])
    block_start = jnp.arange(n_blocks) * MOE_BLOCK
    block_exp = jnp.minimum(jnp.searchsorted(pend, block_start, side='right'), N_EXPERTS - 1)
    xb = xt[buf_tok].reshape(n_blocks, MOE_BLOCK, D)

    def expert_block(args):
        xblk, e = args
        h = xblk @ w1[e] + b1[e]
        gate = jnp.minimum(h[:, :D_EXPERT], SWIGLU_LIMIT)
        up = jnp.clip(h[:, D_EXPERT:], -SWIGLU_LIMIT, SWIGLU_LIMIT)
        act = gate * jax.nn.sigmoid(SWIGLU_ALPHA * gate) * (up + 1.0)
        return act @ w2[e] + b2[e]

    yb = lax.map(expert_block, (xb, block_exp)).reshape(P, D)
    yw = yb * buf_gate[:, None].astype(yb.dtype)
    y = jnp.zeros((T, D), yw.dtype).at[buf_tok].add(yw)
    return y.reshape(B, S, D)


def mixer(x, pos, w_in, p_ret, sg_ln_g, sg_ln_b, sg_w, sg_b, p_sg, w_o):
    B, S, _ = x.shape
    proj = x @ w_in
    q, k, v, g, u, vs, ga, gb = jnp.split(proj, IN_SPLITS, axis=-1)
    q = rotary(q.reshape(B, S, RET_HEADS, RET_QK_DIM), pos)
    k = rotary(k.reshape(B, S, RET_HEADS, RET_QK_DIM), pos) * (RET_QK_DIM ** -0.5)
    y_ret = retention(q, k, v.reshape(B, S, RET_HEADS, RET_V_DIM))
    y_ret = head_norm(y_ret).reshape(B, S, RET_V) * jax.nn.silu(g)
    y_sg = spatial_gating(jax.nn.gelu(u), jax.nn.gelu(vs), sg_ln_g, sg_ln_b, sg_w, sg_b)
    h = jax.nn.sigmoid(ga) * (y_ret @ p_ret) + jax.nn.sigmoid(gb) * (y_sg @ p_sg)
    return h @ w_o


def setup_inputs(seed: int = 0) -> dict:
    key = jax.random.key(seed)
    ks = jax.random.split(key, 20)
    L, D, E, F = DEPTH, D_MODEL, N_EXPERTS, D_EXPERT
    nrm = lambda k, shape, s: jax.random.normal(k, shape, jnp.float32) * s
    return {
        "x": nrm(ks[0], (BATCH, SEQ, D), 1.0),
        "w_in": nrm(ks[1], (L, D, IN_WIDTH), D ** -0.5),
        "p_ret": nrm(ks[2], (L, RET_V, D), RET_V ** -0.5),
        "sg_ln_g": 1.0 + nrm(ks[3], (L, SG_WIDTH), 0.01),
        "sg_ln_b": nrm(ks[4], (L, SG_WIDTH), 0.01),
        "sg_w": nrm(ks[5], (L, SG_GROUPS, SG_BLOCK, SG_BLOCK), SG_BLOCK ** -0.5),
        "sg_b": 1.0 + nrm(ks[6], (L, SG_GROUPS, SG_BLOCK), 0.01),
        "p_sg": nrm(ks[7], (L, SG_WIDTH, D), SG_WIDTH ** -0.5),
        "w_o": nrm(ks[8], (L, D, D), DN_BETA * D ** -0.5),
        "ln1_g": 1.0 + nrm(ks[9], (L, D), 0.01),
        "ln1_b": nrm(ks[10], (L, D), 0.01),
        "router_w": nrm(ks[11], (L, D, E), D ** -0.5),
        "router_b": nrm(ks[12], (L, E), 0.01),
        "e_w1": nrm(ks[13], (L, E, D, 2 * F), D ** -0.5),
        "e_b1": nrm(ks[14], (L, E, 2 * F), 0.01),
        "e_w2": nrm(ks[15], (L, E, F, D), DN_BETA * F ** -0.5),
        "e_b2": nrm(ks[16], (L, E, D), 0.01),
        "ln2_g": 1.0 + nrm(ks[17], (L, D), 0.01),
        "ln2_b": nrm(ks[18], (L, D), 0.01),
    }


def reference(x, w_in, p_ret, sg_ln_g, sg_ln_b, sg_w, sg_b, p_sg, w_o, ln1_g, ln1_b,
              router_w, router_b, e_w1, e_b1, e_w2, e_b2, ln2_g, ln2_b):
    pos = jnp.arange(x.shape[1], dtype=jnp.int32)
    for l in range(DEPTH):
        mix = mixer(x, pos, w_in[l], p_ret[l], sg_ln_g[l], sg_ln_b[l], sg_w[l], sg_b[l],
                    p_sg[l], w_o[l])
        x = layer_norm(DN_ALPHA * x + mix, ln1_g[l], ln1_b[l])
        ffn = moe(x, router_w[l], router_b[l], e_w1[l], e_b1[l], e_w2[l], e_b2[l])
        x = layer_norm(DN_ALPHA * x + ffn, ln2_g[l], ln2_b[l])
    return x
```

```cpp
#include <hip/hip_runtime.h>
#include <cstdio>
#include <cstdint>

#ifndef MK_N_LAUNCHES
#define MK_N_LAUNCHES 1
#endif

#ifndef INPROJ_FP8
#define INPROJ_FP8 1
#endif
#ifndef GATE_U8
#define GATE_U8 1
#endif
#ifndef PROBE_DMA
#define PROBE_DMA 1
#endif
#ifndef MOE_BIAS_LDS
#define MOE_BIAS_LDS 1
#endif
#ifndef DMA_IN_MMA
#define DMA_IN_MMA 0
#endif
#ifndef PROBE_LDS
#define PROBE_LDS 1
#endif
#ifndef PROBE_MMA
#define PROBE_MMA 1
#endif
#ifndef F8_SP2
#define F8_SP2 0
#endif
#ifndef MOE_FP8
#define MOE_FP8 1
#endif
#define LAS __attribute__((address_space(3)))
#define GAS __attribute__((address_space(1)))
typedef unsigned short bf16;
typedef short bf16x8 __attribute__((ext_vector_type(8)));
typedef short s16x4 __attribute__((ext_vector_type(4)));
typedef float f32x4 __attribute__((ext_vector_type(4)));
typedef float f32x2 __attribute__((ext_vector_type(2)));
typedef unsigned u32x4 __attribute__((ext_vector_type(4)));
typedef unsigned u32x2 __attribute__((ext_vector_type(2)));
typedef int i32x4 __attribute__((ext_vector_type(4)));
typedef GAS unsigned gu32;

constexpr int DM = 1024, NBATCH = 16, SEQ = 2048, T = NBATCH * SEQ, NL = 4;
constexpr int INW = 7168, NE = 32, TOPK = 4, DEXP = 1024;
constexpr int C_Q = 0, C_K = 512, C_V = 1024, C_G = 2048, C_U = 3072, C_VS = 4096, C_GA = 5120, C_GB = 6144;
constexpr float LN_EPS = 1e-5f, DN_ALPHA = 1.681792830507429f;
constexpr int AROWS = T * TOPK + NE * 256;
constexpr int NWAVES = 8, NTHREADS = 512;

constexpr size_t MiB = 1u << 20;
constexpr size_t WS_CTL = 0, CTL_ZERO_BYTES = 65536;
constexpr size_t WS_ST1 = 256 * 1024;
constexpr size_t WS_ROPE = 1 * MiB;
constexpr size_t WS_ROPEB = (1944 + 100) * MiB;
constexpr size_t WS_SEL = 2 * MiB;
constexpr size_t WS_TOK = 3 * MiB;
constexpr size_t WS_SGW = 7 * MiB;
constexpr size_t WS_WIN = 8 * MiB;
constexpr size_t WS_PRET = 64 * MiB, WS_PSG = 72 * MiB, WS_WO = 80 * MiB;
constexpr size_t WS_W1 = 88 * MiB;
constexpr size_t WS_W2 = 600 * MiB;
constexpr size_t WS_XF = 856 * MiB;
constexpr size_t WS_XB = 984 * MiB;
constexpr size_t WS_XQ = 856 * MiB;
constexpr size_t WS_P = 1048 * MiB;
constexpr size_t WS_YRET = 1496 * MiB, WS_YSG = 1560 * MiB;
constexpr size_t WS_HF = 1624 * MiB;
constexpr size_t WS_HB = 1752 * MiB;
constexpr size_t WS_Z = 1816 * MiB;
constexpr size_t WS_X1F = 1944 * MiB;
constexpr size_t WS_PG8 = (1944 + 32) * MiB;
constexpr size_t WS_X1B = 2072 * MiB;
constexpr size_t WS_ACT = 2136 * MiB;
constexpr size_t WS_YRAW = 2408 * MiB;
constexpr size_t WS_END = 2680 * MiB;
static_assert((size_t)AROWS * 1024 * 2 <= 272 * MiB, "expert row buffers");
constexpr int CW_TMO = 0, CW_CODE = 1, CW_BAR = 4096, CW_CNT = 8192;

constexpr int RING_BYTES = 131072;
constexpr int IDX_OFF = RING_BYTES, IDX_SLOTS = 18;
constexpr int TSTART_OFF = IDX_OFF + IDX_SLOTS * 1024;
constexpr int LCNT_OFF = TSTART_OFF + 256, LBASE_OFF = LCNT_OFF + 128, LSEL_OFF = LBASE_OFF + 128;
constexpr int MISC_OFF = LSEL_OFF + 2048;
constexpr int LDS_BYTES = 163840;
constexpr int BIAS_OFF = 153600;
static_assert(MISC_OFF + 64 <= BIAS_OFF && BIAS_OFF + 2048 <= LDS_BYTES, "LDS map");

#define RLX_AGENT __ATOMIC_RELAXED, __HIP_MEMORY_SCOPE_AGENT
#define LDS_WAIT() asm volatile("s_waitcnt lgkmcnt(0)" ::: "memory")
#define VM_WAIT() asm volatile("s_waitcnt vmcnt(0)" ::: "memory")
__device__ __forceinline__ unsigned cvt_pk_bf16(float lo, float hi) { unsigned r; asm volatile("v_cvt_pk_bf16_f32 %0, %1, %2" : "=v"(r) : "v"(lo), "v"(hi)); return r; }
__device__ __forceinline__ unsigned cvt4_fp8(float a, float b, float c, float d) { int w = __builtin_amdgcn_cvt_pk_fp8_f32(a, b, 0, false); w = __builtin_amdgcn_cvt_pk_fp8_f32(c, d, w, true); return (unsigned)w; }
__device__ __forceinline__ void unpack8_u8(const u32x2 w, f32x4& a, f32x4& b) {
    a = (f32x4){(float)(w.x & 0xffu), (float)((w.x >> 8) & 0xffu), (float)((w.x >> 16) & 0xffu), (float)(w.x >> 24)} * (1.0f / 255.0f);
    b = (f32x4){(float)(w.y & 0xffu), (float)((w.y >> 8) & 0xffu), (float)((w.y >> 16) & 0xffu), (float)(w.y >> 24)} * (1.0f / 255.0f); }
__device__ __forceinline__ unsigned pack4_u8(const f32x4 s) { return (unsigned)(s[0] * 255.0f + 0.5f) | ((unsigned)(s[1] * 255.0f + 0.5f) << 8) | ((unsigned)(s[2] * 255.0f + 0.5f) << 16) | ((unsigned)(s[3] * 255.0f + 0.5f) << 24); }
__device__ __forceinline__ float bf_lo(unsigned w) { return __uint_as_float(w << 16); }
__device__ __forceinline__ float bf_hi(unsigned w) { return __uint_as_float(w & 0xffff0000u); }
__device__ __forceinline__ float sigmoidf_(float x) { return __builtin_amdgcn_rcpf(1.0f + __builtin_amdgcn_exp2f(x * -1.4426950408889634f)); }
__device__ __forceinline__ float siluf_(float x) { return x * sigmoidf_(x); }
__device__ __forceinline__ float geluf_(float x) { return x * sigmoidf_(1.5957691216057308f * (x + 0.044715f * x * x * x)); }
__device__ __forceinline__ float lg2_gamma(int h) { return h == 0 ? -0.04580368961312479f : h == 1 ? -0.018003552928331026f : h == 2 ? -0.007117849617096985f : -0.0028205190623786626f; }
__device__ __forceinline__ int opaque_tid() { int t = threadIdx.x; asm volatile("" : "+v"(t)); return t; }
__device__ __forceinline__ float wave_sum(float v) {
#pragma unroll
    for (int o = 1; o < 64; o <<= 1) v += __shfl_xor(v, o);
    return v;
}

#define XB_TMO      128
#define XB_XCNT(j)  (256  + 64 * (j))
#define XB_XSUB(j)  (1280 + 64 * (j))
#define XB_XGEN(j)  (2304 + 64 * (j))
#define XB_TOP      3328
#define XB_TOPGEN   3392
#define XCD_BAR_WORDS 3456
#define XB_SPIN_CAP (1u << 18)
__device__ __forceinline__ unsigned xb_ld(unsigned* p)              { return __hip_atomic_load(p, __ATOMIC_RELAXED, __HIP_MEMORY_SCOPE_AGENT); }
__device__ __forceinline__ unsigned xb_add(unsigned* p, unsigned v) { return __hip_atomic_fetch_add(p, v, __ATOMIC_RELAXED, __HIP_MEMORY_SCOPE_AGENT); }
__device__ __forceinline__ unsigned xb_xcc_id() { return (unsigned)__builtin_amdgcn_s_getreg((3 << 11) | 20) & 0xFu; }
#define XB_SPIN(cond, bar) do { unsigned _sp = 0; while (cond) { __builtin_amdgcn_s_sleep(1); \
    if ((++_sp & 255u) == 0u) { if (xb_ld(&(bar)[XB_TMO])) break; if (_sp > XB_SPIN_CAP) { atomicAdd(&(bar)[XB_TMO], 1u); break; } } } } while (0)
struct XcdBarrier { unsigned* bar; unsigned x; volatile LAS unsigned* st; };
__device__ __forceinline__ XcdBarrier xcd_barrier_post(unsigned* bar, volatile LAS unsigned* st) {
    XcdBarrier b; b.bar = bar; b.x = xb_xcc_id(); b.st = st;
    if (threadIdx.x == 0) (void)xb_add(&bar[XB_XCNT(b.x)], 1u);
    return b;
}
__device__ __forceinline__ void xcd_barrier_complete(unsigned* bar, unsigned x, unsigned& nloc, unsigned& nx) {
    const unsigned G = gridDim.x * gridDim.y * gridDim.z;
    unsigned sum, cnt, mine, sp = 0u;
    for (;;) {
        sum = 0u; cnt = 0u; mine = 0u;
#pragma unroll
        for (unsigned j = 0; j < 16; ++j) { const unsigned c = xb_ld(&bar[XB_XCNT(j)]); sum += c; cnt += (c > 0u) ? 1u : 0u; mine = (j == x) ? c : mine; }
        if (sum == G) break;
        __builtin_amdgcn_s_sleep(1);
        if ((++sp & 255u) == 0u) { if (xb_ld(&bar[XB_TMO])) break; if (sp > XB_SPIN_CAP) { atomicAdd(&bar[XB_TMO], 1u); break; } }
    }
    nloc = mine > 0u ? mine : 1u; nx = cnt > 0u ? cnt : 1u;
}
__device__ __forceinline__ void xcd_barrier(const XcdBarrier& b) {
    asm volatile("s_waitcnt vmcnt(0)" ::: "memory");
    __syncthreads();
    if (threadIdx.x == 0) {
        unsigned* bar = b.bar;
        __builtin_amdgcn_s_waitcnt(0);
        unsigned nloc = b.st[0], nx = b.st[1];
        if (nloc == 0u) { xcd_barrier_complete(bar, b.x, nloc, nx); b.st[0] = nloc; b.st[1] = nx; }
        const unsigned old = xb_add(&bar[XB_XSUB(b.x)], 1u);
        const unsigned gen = old / nloc;
        if (old + 1u == (gen + 1u) * nloc) {
            __builtin_amdgcn_fence(__ATOMIC_RELEASE, "agent");
            asm volatile("s_waitcnt vmcnt(0)" ::: "memory");
            const unsigned og = xb_add(&bar[XB_TOP], 1u);
            const unsigned tg = og / nx;
            if (og + 1u == (tg + 1u) * nx) xb_add(&bar[XB_TOPGEN], 1u);
            else XB_SPIN(xb_ld(&bar[XB_TOPGEN]) == tg, bar);
            __builtin_amdgcn_fence(__ATOMIC_ACQUIRE, "agent");
            xb_add(&bar[XB_XGEN(b.x)], 1u);
            asm volatile("s_waitcnt vmcnt(0)" ::: "memory");
        } else {
            XB_SPIN(xb_ld(&bar[XB_XGEN(b.x)]) == gen, bar);
            __builtin_amdgcn_fence(__ATOMIC_ACQUIRE, "agent");
            asm volatile("s_waitcnt vmcnt(0)" ::: "memory");
        }
    }
    __syncthreads();
}

namespace pg8 {
constexpr int BM = 256, BK = 64, HALF = 128, HTB = HALF * BK * 2, STAGE_BYTES = 8 * HTB, NXCD = 8, WGM = 8;
__host__ __device__ __forceinline__ int lds_byte(int r, int c) { const int st = (r >> 4) * 2 + (c >> 5), rr = r & 15, cc = c & 31, ob = rr * 64 + cc * 2; return st * 1024 + (ob ^ (((ob >> 9) & 1) << 5)); }
__host__ __device__ __forceinline__ void stage_rc(int b, int& R, int& C) { const int st = b / 1024, sb = b % 1024, swz = sb ^ (((sb >> 9) & 1) << 5); R = (st >> 1) * 16 + swz / 64; C = (st & 1) * 32 + (swz % 64) / 2; }
__host__ __device__ __forceinline__ int perm32(int rho) { const int n = rho >> 4, i = rho & 15; return 8 * (i >> 2) + 4 * n + (i & 3); }

struct Unit { const char* a; const char* b; int r0, c0, e, slot; };

struct StaticOrder {
    int nM, nN, nwg, G, c;
    __device__ void init(int M, int N, int G_, int c_) { nM = M / BM; nN = N / BM; nwg = nM * nN; G = G_; c = c_; }
    __device__ bool next(int i, int& pm, int& pn) const {
        const long L = (long)i * G + c; if (L >= nwg) return false;
        int wgid = (int)L; { const int q = nwg / NXCD, r = nwg % NXCD, xcd = wgid % NXCD, off = wgid / NXCD; wgid = (xcd < r ? xcd * (q + 1) : r * (q + 1) + (xcd - r) * q) + off; }
        const int nig = WGM * nN, gid = wgid / nig, fm = gid * WGM, gsz = (nM - fm) < WGM ? (nM - fm) : WGM;
        pm = fm + ((wgid % nig) % gsz); pn = (wgid % nig) / gsz; return true;
    }
};
struct DenseSched {
    const char* A; const char* Bt; int KB; StaticOrder so;
    __device__ void init(const bf16* A_, const bf16* Bt_, int M, int N, int K_, int G, int c) { A = (const char*)A_; Bt = (const char*)Bt_; KB = 2 * K_; so.init(M, N, G, c); }
    __device__ __forceinline__ bool next(int i, Unit& u) const { int pm, pn; if (!so.next(i, pm, pn)) return false;
        u.a = A + (size_t)pm * BM * KB; u.b = Bt + (size_t)pn * BM * KB; u.r0 = pm * BM; u.c0 = pn * BM; u.e = 0; u.slot = i; return true; }
    __device__ __forceinline__ void aoff(const Unit&, const int (&R)[2], const int (&C)[2], unsigned (&v)[2][2]) const {
#pragma unroll
        for (int h = 0; h < 2; ++h)
#pragma unroll
            for (int i = 0; i < 2; ++i) v[h][i] = (unsigned)((h * HALF + R[i]) * KB + C[i] * 2); }
};
struct InProjSched {
    const char* A; const char* Bt; int KB, G, c;
    __device__ __forceinline__ bool next(int i, Unit& u) const {
        const int L = i * G + c; if (L >= 128 * 28) return false;
        const int x = L & 7, off = L >> 3, blk = off >> 6, r = off & 63;
        const int pm = 16 * x + (r & 7) + 8 * (r >> 5), ob = blk == 0 ? 6 : blk == 1 ? 5 : blk == 2 ? 2 : blk == 3 ? 3 : blk == 4 ? 4 : blk == 5 ? 0 : 1, pn = 4 * ob + ((r >> 3) & 3);
        u.a = A + (size_t)pm * BM * KB; u.b = Bt + (size_t)pn * BM * KB; u.r0 = pm * BM; u.c0 = pn * BM; u.e = 0; u.slot = i; return true; }
    __device__ __forceinline__ void aoff(const Unit&, const int (&R)[2], const int (&C)[2], unsigned (&v)[2][2]) const {
#pragma unroll
        for (int h = 0; h < 2; ++h)
#pragma unroll
            for (int i = 0; i < 2; ++i) v[h][i] = (unsigned)((h * HALF + R[i]) * KB + C[i] * 2); }
};
__device__ __forceinline__ void moe_unit_map(int i, int c, int nN, int G, int& mtg, int& pn) {
    if (G == 256) { const int x = c & 7, r = c >> 3, mpx = 32 / nN; mtg = i * (256 / nN) + x * mpx + r / nN; pn = r % nN; }
    else { const int U = i * G + c; mtg = U / nN; pn = U - mtg * nN; } }
template <bool GATHER> struct MoeSched {
    const char* A; const char* Wt; int KB, N, nN, G, c; const LAS int* tstart; const LAS int* idx;
    __device__ __forceinline__ bool next(int i, Unit& u) const {
        int mtg, pn; moe_unit_map(i, c, nN, G, mtg, pn); if (mtg >= __builtin_amdgcn_readfirstlane(tstart[32])) return false;
        int e = 0;
#pragma unroll
        for (int k = 1; k < 32; ++k) e += (tstart[k] <= mtg) ? 1 : 0;
        e = __builtin_amdgcn_readfirstlane(e);
        u.e = e; u.r0 = mtg * BM; u.c0 = pn * BM; u.slot = i;
        u.a = GATHER ? A : A + (size_t)mtg * BM * KB; u.b = Wt + ((size_t)e * N + (size_t)pn * BM) * KB; return true; }
    __device__ __forceinline__ void aoff(const Unit& u, const int (&R)[2], const int (&C)[2], unsigned (&v)[2][2]) const {
#pragma unroll
        for (int h = 0; h < 2; ++h)
#pragma unroll
            for (int i = 0; i < 2; ++i) { const int row = GATHER ? idx[u.slot * 256 + h * HALF + R[i]] : (h * HALF + R[i]); v[h][i] = (unsigned)(row * KB + C[i] * 2); } }
};

typedef int v8i32 __attribute__((ext_vector_type(8)));
template <class E, class = void> struct has_bias_lds { static constexpr bool value = false; };
template <class E> struct has_bias_lds<E, decltype((void)E::BIAS_LDS)> { static constexpr bool value = E::BIAS_LDS; };
template <class E, class = void> struct has_probe2 { static constexpr bool value = false; };
template <class E> struct has_probe2<E, decltype((void)E::PROBE2)> { static constexpr bool value = true; };
template <class Epi, class Sched, bool GATHER, bool ALIGN_EPI, bool SP2, bool F8 = false>
__device__ __forceinline__ void gemm_phase(LAS unsigned char* lds, const int KB, const Sched& S, const Epi& E) {
    const int tid = opaque_tid(), wid = __builtin_amdgcn_readfirstlane(tid >> 6), lane = tid & 63, wr = wid >> 2, wc = wid & 3, fr = lane & 15, fq = lane >> 4;
    const int nt = KB / (2 * BK);
    int Rr[2], Cc[2]; unsigned voffB[2], voffB1[2];
#pragma unroll
    for (int i = 0; i < 2; ++i) { int R, C; stage_rc(tid * 16 + i * 8192, R, C); Rr[i] = R; Cc[i] = C; const int Rb = (R >> 5) * 64 + ((R & 15) >> 2) * 16 + ((R >> 4) & 1) * 4 + (R & 3);
        voffB[i] = (unsigned)(Rb * KB + C * 2); voffB1[i] = (unsigned)((Rb + 8) * KB + C * 2); }
    const size_t kstep = (size_t)(BK * 2);
    const size_t hstep = (size_t)HALF * KB;
    const unsigned ldsw = (unsigned)wid * 1024u;
    const int aoff = lds_byte(wr * 64 + fr, fq * 8), boff = lds_byte(wc * 32 + fr, fq * 8);
    u32x4 dmy = {0u, 0u, 0u, 0u}; const unsigned abase = (unsigned)(size_t)(lds + aoff), bbase = (unsigned)(size_t)(lds + 65536 + boff); (void)abase; (void)bbase;
#define PG8_SA(b, h) (((b) * 2 + (h)) * HTB)
#define PG8_SB(b, h) ((4 + (b) * 2 + (h)) * HTB)
#define PG8_STAGE(bufoff, gbase, voff) do { _Pragma("unroll") for (int _i = 0; _i < 2; ++_i) _Pragma("unroll") for (int _d = 0; _d < PROBE_DMA; ++_d) \
        __builtin_amdgcn_global_load_lds((const unsigned*)((const char*)(gbase) + (voff)[_i]), (LAS unsigned*)(lds + (bufoff) + ldsw + _i * 8192), 16, 0, 0); } while (0)
#define PG8_CAT8(lo, hi) __builtin_bit_cast(v8i32, __builtin_shufflevector((lo), (hi), 0, 1, 2, 3, 4, 5, 6, 7, 8, 9, 10, 11, 12, 13, 14, 15))
#define PG8_DMY(base, off) do { if (PROBE_LDS == 2) asm volatile("ds_read_b128 %0, %1 offset:%2" : "+v"(dmy) : "v"(base), "n"(off)); } while (0)
#define PG8_LDA(dst, b, h) do { if constexpr (F8) { _Pragma("unroll") for (int m = 0; m < 4; ++m) { PG8_DMY(abase, PG8_SA(b, h) + m * 2048); PG8_DMY(abase, PG8_SA(b, h) + m * 2048 + 1024); } } if constexpr (F8) { _Pragma("unroll") for (int m = 0; m < 4; ++m) dst##8[m] = PG8_CAT8(*(const LAS bf16x8*)(lds + PG8_SA(b, h) + aoff + m * 2048), *(const LAS bf16x8*)(lds + PG8_SA(b, h) + aoff + m * 2048 + 1024)); } \
        else { _Pragma("unroll") for (int m = 0; m < 4; ++m) _Pragma("unroll") for (int k = 0; k < 2; ++k) dst[m][k] = *(const LAS bf16x8*)(lds + PG8_SA(b, h) + aoff + m * 2048 + k * 1024); } } while (0)
#define PG8_LDB(dst, b, h) do { if constexpr (F8) { _Pragma("unroll") for (int n = 0; n < 2; ++n) { PG8_DMY(bbase, PG8_SB(b, h) - 65536 + n * 2048); PG8_DMY(bbase, PG8_SB(b, h) - 65536 + n * 2048 + 1024); } } if constexpr (F8) { _Pragma("unroll") for (int n = 0; n < 2; ++n) dst##8[n] = PG8_CAT8(*(const LAS bf16x8*)(lds + PG8_SB(b, h) + boff + n * 2048), *(const LAS bf16x8*)(lds + PG8_SB(b, h) + boff + n * 2048 + 1024)); } \
        else { _Pragma("unroll") for (int n = 0; n < 2; ++n) _Pragma("unroll") for (int k = 0; k < 2; ++k) dst[n][k] = *(const LAS bf16x8*)(lds + PG8_SB(b, h) + boff + n * 2048 + k * 1024); } } while (0)
#define PG8_MMA(ai, bj, At, Bt) do { __builtin_amdgcn_s_setprio(1); \
        if constexpr (F8) { _Pragma("unroll") for (int m = 0; m < 4; ++m) _Pragma("unroll") for (int n = 0; n < 2; ++n) \
            { asm volatile("v_mfma_f32_16x16x128_f8f6f4 %0, %1, %2, %0" : "+v"(acc[ai][bj][m][n]) : "v"(Bt##8[n]), "v"(At##8[m])); \
              if (PROBE_MMA == 2) asm volatile("v_mfma_f32_16x16x128_f8f6f4 %0, %1, %2, %0" : "+v"(acc[ai][bj][m][n]) : "v"(Bt##8[n]), "v"(At##8[m])); } } \
        else { _Pragma("unroll") for (int m = 0; m < 4; ++m) _Pragma("unroll") for (int n = 0; n < 2; ++n) _Pragma("unroll") for (int k = 0; k < 2; ++k) \
            acc[ai][bj][m][n] = __builtin_amdgcn_mfma_f32_16x16x32_bf16(Bt[n][k], At[m][k], acc[ai][bj][m][n], 0, 0, 0); } \
        __builtin_amdgcn_s_setprio(0); } while (0)
#define PG8_MFMA8_(ai, bj, At, Bt, m, n) asm volatile("v_mfma_f32_16x16x128_f8f6f4 %0, %1, %2, %0" : "+v"(acc[ai][bj][m][n]) : "v"(Bt##8[n]), "v"(At##8[m]))
#define PG8_PIECE_(bufoff, gbase, voff, i) __builtin_amdgcn_global_load_lds((const unsigned*)((const char*)(gbase) + (voff)[i]), (LAS unsigned*)(lds + (bufoff) + ldsw + (i) * 8192), 16, 0, 0)
#define PG8_MMA_ST(ai, bj, At, Bt, bufoff, gbase, voff) do { if constexpr (F8) { __builtin_amdgcn_s_setprio(1); \
        PG8_MFMA8_(ai, bj, At, Bt, 0, 0); PG8_MFMA8_(ai, bj, At, Bt, 0, 1); PG8_SCHED; PG8_PIECE_(bufoff, gbase, voff, 0); PG8_SCHED; \
        PG8_MFMA8_(ai, bj, At, Bt, 1, 0); PG8_MFMA8_(ai, bj, At, Bt, 1, 1); PG8_MFMA8_(ai, bj, At, Bt, 2, 0); PG8_SCHED; PG8_PIECE_(bufoff, gbase, voff, 1); PG8_SCHED; \
        PG8_MFMA8_(ai, bj, At, Bt, 2, 1); PG8_MFMA8_(ai, bj, At, Bt, 3, 0); PG8_MFMA8_(ai, bj, At, Bt, 3, 1); __builtin_amdgcn_s_setprio(0); } } while (0)
#define PG8_WAIT_V(n) asm volatile("s_waitcnt vmcnt(%0)" :: "n"((n) * PROBE_DMA) : "memory")
#define PG8_WAIT_L(n) asm volatile("s_waitcnt lgkmcnt(" #n ")" ::: "memory")
#define PG8_BAR __builtin_amdgcn_s_barrier()
#define PG8_SCHED __builtin_amdgcn_sched_barrier(0)
    Unit cur, nxt; int ui = 0;
    if (!S.next(0, cur)) return;
    unsigned vA[2][2], vN[2][2];
    S.aoff(cur, Rr, Cc, vA);
    f32x4 acc[2][2][4][2];
#pragma unroll
    for (int a = 0; a < 2; ++a)
#pragma unroll
        for (int b = 0; b < 2; ++b)
#pragma unroll
            for (int m = 0; m < 4; ++m)
#pragma unroll
                for (int n = 0; n < 2; ++n) acc[a][b][m][n] = (f32x4){0.f, 0.f, 0.f, 0.f};
    bf16x8 At[4][2], B0[2][2], B1[2][2];
    v8i32 At8[4], B08[2], B18[2];
    const char* cA = cur.a; const char* cB = cur.b;
    if constexpr (has_bias_lds<Epi>::value) { if (wid == 0) E.bias_dma(cur, lane); }
    if constexpr (SP2) {
        PG8_STAGE(PG8_SB(0, 0), cB, voffB); PG8_STAGE(PG8_SB(0, 1), cB, voffB1); PG8_STAGE(PG8_SA(0, 0), cA, vA[0]); PG8_STAGE(PG8_SA(0, 1), cA, vA[1]);
        if (wr == 1) PG8_BAR;
        PG8_WAIT_V(2); PG8_BAR;
        PG8_STAGE(PG8_SB(1, 0), cB + kstep, voffB); PG8_STAGE(PG8_SA(1, 0), cA + kstep, vA[0]); PG8_STAGE(PG8_SB(1, 1), cB + kstep, voffB1);
        PG8_WAIT_V(6); PG8_BAR;
    } else {
        PG8_STAGE(PG8_SB(0, 0), cB, voffB); PG8_STAGE(PG8_SA(0, 0), cA, vA[0]); PG8_STAGE(PG8_SB(0, 1), cB, voffB1); PG8_STAGE(PG8_SA(0, 1), cA, vA[1]);
        if (wr == 1) PG8_BAR;
        PG8_WAIT_V(4); PG8_BAR;
        PG8_STAGE(PG8_SB(1, 0), cB + kstep, voffB); PG8_STAGE(PG8_SA(1, 0), cA + kstep, vA[0]); PG8_STAGE(PG8_SB(1, 1), cB + kstep, voffB1);
        PG8_WAIT_V(6); PG8_BAR;
    }
    for (;;) {
        const bool has_next = S.next(ui + 1, nxt);
        const char* nA = has_next ? nxt.a : cA; const char* nB = has_next ? nxt.b : cB;
        if (GATHER && has_next) S.aoff(nxt, Rr, Cc, vN);
        else {
#pragma unroll
            for (int h = 0; h < 2; ++h)
#pragma unroll
                for (int i = 0; i < 2; ++i) vN[h][i] = vA[h][i]; }
#pragma unroll 1
        for (int t = 0; t < nt; t += 2) {
            const bool last = (t == nt - 2);
            const char* a1 = cA + (size_t)(t + 1) * kstep;
            const char* a2 = last ? nA : cA + (size_t)(t + 2) * kstep; const char* b2 = last ? nB : cB + (size_t)(t + 2) * kstep;
            const char* a3 = a2 + kstep; const char* b3 = b2 + kstep;
            unsigned v2[2][2];
#pragma unroll
            for (int h = 0; h < 2; ++h)
#pragma unroll
                for (int i = 0; i < 2; ++i) v2[h][i] = last ? vN[h][i] : vA[h][i];
            if constexpr (SP2) {
            PG8_LDB(B0, 0, 0); PG8_LDB(B1, 0, 1); PG8_SCHED; PG8_LDA(At, 0, 0); PG8_STAGE(PG8_SA(1, 1), a1, vA[1]);
            PG8_WAIT_V(8); PG8_WAIT_L(0); PG8_BAR; PG8_MMA(0, 0, At, B0); PG8_MMA(0, 1, At, B1); PG8_BAR; PG8_SCHED;
            PG8_LDA(At, 0, 1); PG8_STAGE(PG8_SB(0, 0), b2, voffB); PG8_STAGE(PG8_SB(0, 1), b2, voffB1); PG8_STAGE(PG8_SA(0, 0), a2, v2[0]);
            PG8_WAIT_V(8); PG8_WAIT_L(0); PG8_BAR; PG8_MMA(1, 0, At, B0); PG8_MMA(1, 1, At, B1); PG8_BAR; PG8_SCHED;
            PG8_LDB(B0, 1, 0); PG8_LDB(B1, 1, 1); PG8_SCHED; PG8_LDA(At, 1, 0); PG8_STAGE(PG8_SA(0, 1), a2, v2[1]);
            PG8_WAIT_V(8); PG8_WAIT_L(0); PG8_BAR; PG8_MMA(0, 0, At, B0); PG8_MMA(0, 1, At, B1); PG8_BAR; PG8_SCHED;
            PG8_LDA(At, 1, 1); PG8_STAGE(PG8_SB(1, 0), b3, voffB); PG8_STAGE(PG8_SB(1, 1), b3, voffB1); PG8_STAGE(PG8_SA(1, 0), a3, v2[0]);
            PG8_WAIT_V(8); PG8_WAIT_L(0); PG8_BAR; PG8_MMA(1, 0, At, B0); PG8_MMA(1, 1, At, B1); PG8_BAR; PG8_SCHED;
            } else if constexpr (F8 && DMA_IN_MMA) {
            PG8_LDB(B0, 0, 0); PG8_SCHED; PG8_LDA(At, 0, 0);
            PG8_WAIT_L(8); PG8_BAR; PG8_WAIT_L(0); PG8_MMA_ST(0, 0, At, B0, PG8_SA(1, 1), a1, vA[1]); PG8_BAR; PG8_SCHED;
            PG8_LDB(B1, 0, 1);
            PG8_BAR; PG8_WAIT_L(0); PG8_MMA_ST(0, 1, At, B1, PG8_SB(0, 0), b2, voffB); PG8_BAR; PG8_SCHED;
            PG8_LDA(At, 0, 1);
            PG8_BAR; PG8_WAIT_L(0); PG8_MMA_ST(1, 0, At, B0, PG8_SA(0, 0), a2, v2[0]); PG8_BAR; PG8_SCHED;
            PG8_WAIT_V(4); PG8_BAR; PG8_MMA_ST(1, 1, At, B1, PG8_SB(0, 1), b2, voffB1); PG8_BAR; PG8_SCHED;
            PG8_LDB(B0, 1, 0); PG8_SCHED; PG8_LDA(At, 1, 0);
            PG8_WAIT_L(8); PG8_BAR; PG8_WAIT_L(0); PG8_MMA_ST(0, 0, At, B0, PG8_SA(0, 1), a2, v2[1]); PG8_BAR; PG8_SCHED;
            PG8_LDB(B1, 1, 1);
            PG8_BAR; PG8_WAIT_L(0); PG8_MMA_ST(0, 1, At, B1, PG8_SB(1, 0), b3, voffB); PG8_BAR; PG8_SCHED;
            PG8_LDA(At, 1, 1);
            PG8_BAR; PG8_WAIT_L(0); PG8_MMA_ST(1, 0, At, B0, PG8_SA(1, 0), a3, v2[0]); PG8_BAR; PG8_SCHED;
            PG8_WAIT_V(4); PG8_BAR; PG8_MMA_ST(1, 1, At, B1, PG8_SB(1, 1), b3, voffB1); PG8_BAR; PG8_SCHED;
            } else {
            PG8_LDB(B0, 0, 0); PG8_SCHED; PG8_LDA(At, 0, 0); PG8_STAGE(PG8_SA(1, 1), a1, vA[1]);
            PG8_WAIT_L(8); PG8_BAR; PG8_WAIT_L(0); PG8_MMA(0, 0, At, B0); PG8_BAR; PG8_SCHED;
            PG8_LDB(B1, 0, 1); PG8_STAGE(PG8_SB(0, 0), b2, voffB);
            PG8_BAR; PG8_WAIT_L(0); PG8_MMA(0, 1, At, B1); PG8_BAR;
            PG8_LDA(At, 0, 1); PG8_STAGE(PG8_SA(0, 0), a2, v2[0]);
            PG8_BAR; PG8_WAIT_L(0); PG8_MMA(1, 0, At, B0); PG8_BAR; PG8_SCHED;
            PG8_STAGE(PG8_SB(0, 1), b2, voffB1);
            PG8_WAIT_V(6); PG8_BAR; PG8_MMA(1, 1, At, B1); PG8_BAR;
            PG8_LDB(B0, 1, 0); PG8_SCHED; PG8_LDA(At, 1, 0); PG8_STAGE(PG8_SA(0, 1), a2, v2[1]);
            PG8_WAIT_L(8); PG8_BAR; PG8_WAIT_L(0); PG8_MMA(0, 0, At, B0); PG8_BAR; PG8_SCHED;
            PG8_LDB(B1, 1, 1); PG8_STAGE(PG8_SB(1, 0), b3, voffB);
            PG8_BAR; PG8_WAIT_L(0); PG8_MMA(0, 1, At, B1); PG8_BAR;
            PG8_LDA(At, 1, 1); PG8_STAGE(PG8_SA(1, 0), a3, v2[0]);
            PG8_BAR; PG8_WAIT_L(0); PG8_MMA(1, 0, At, B0); PG8_BAR; PG8_SCHED;
            PG8_STAGE(PG8_SB(1, 1), b3, voffB1);
            PG8_WAIT_V(6); PG8_BAR; PG8_MMA(1, 1, At, B1); PG8_BAR;
            }
        }
        if (PROBE_LDS == 2) asm volatile("s_waitcnt lgkmcnt(0)" :: "v"(dmy) : "memory");
        if constexpr (ALIGN_EPI) { if (wr == 0) PG8_BAR; }
        if constexpr (F8) asm volatile("s_nop 15\n\ts_nop 15" ::: "memory");
        { int fr_e = fr, fq_e = fq; asm volatile("" : "+v"(fr_e), "+v"(fq_e));
          E(acc, cur, wr, wc, fr_e, fq_e);
#if defined(PROBE_EPI2)
          if constexpr (has_probe2<Epi>::value) { asm volatile("" : "+v"(fr_e), "+v"(fq_e)); E(acc, cur, wr, wc, fr_e, fq_e); }
#endif
        }
        if (!has_next) break;
        if constexpr (has_bias_lds<Epi>::value) { if (wid == 0) E.bias_dma(nxt, lane); }
#pragma unroll
        for (int a = 0; a < 2; ++a)
#pragma unroll
            for (int b = 0; b < 2; ++b)
#pragma unroll
                for (int m = 0; m < 4; ++m)
#pragma unroll
                    for (int n = 0; n < 2; ++n) acc[a][b][m][n] = (f32x4){0.f, 0.f, 0.f, 0.f};
        cur = nxt; cA = nA; cB = nB; ++ui;
#pragma unroll
        for (int h = 0; h < 2; ++h)
#pragma unroll
            for (int i = 0; i < 2; ++i) vA[h][i] = vN[h][i];
        if constexpr (ALIGN_EPI) { if (wr == 1) PG8_BAR; }
    }
    PG8_WAIT_V(0);
    if constexpr (!ALIGN_EPI) { if (wr == 0) PG8_BAR; }
    PG8_BAR;
#undef PG8_SA
#undef PG8_SB
#undef PG8_STAGE
#undef PG8_LDA
#undef PG8_LDB
#undef PG8_MMA
#undef PG8_MMA_ST
#undef PG8_MFMA8_
#undef PG8_PIECE_
#undef PG8_CAT8
#undef PG8_WAIT_V
#undef PG8_WAIT_L
#undef PG8_BAR
#undef PG8_SCHED
}
}
typedef f32x4 AccT[2][2][4][2];

#define EPI_LOOP(...) \
    _Pragma("unroll") for (int ai = 0; ai < 2; ++ai) _Pragma("unroll") for (int m = 0; m < 4; ++m) { const int row = u.r0 + ai * 128 + wr * 64 + m * 16 + fr; u32x4 ow[2]; \
    _Pragma("unroll") for (int bj = 0; bj < 2; ++bj) { const int col = u.c0 + wc * 64 + 16 * fq + 8 * bj; const f32x4 v0 = acc[ai][bj][m][0], v1 = acc[ai][bj][m][1]; __VA_ARGS__ } \
    EPI_STORE(u.r0 + ai * 128 + wr * 64 + m * 16, u.c0 + wc * 64 + 16 * fq, ow); }
#ifndef EPI_PIPE_A
#define EPI_PIPE_A 1
#endif
#ifndef EPI_PIPE_C1
#define EPI_PIPE_C1 1
#endif
#ifndef EPI_PIPE_C2
#define EPI_PIPE_C2 1
#endif
#ifndef EPI_PIPE_D
#define EPI_PIPE_D 1
#endif
#define EPI_LD_BATCH_(LD) _Pragma("unroll") for (int mm = 0; mm < 2; ++mm) { const int row = u.r0 + ai * 128 + wr * 64 + (2 * mp + mm) * 16 + fr; \
    _Pragma("unroll") for (int bj = 0; bj < 2; ++bj) { const int col = u.c0 + wc * 64 + 16 * fq + 8 * bj; LD } }
#define EPI_LOOP_LD(NLD, LD, ...) { u32x4 ldq[2][2][2][NLD]; \
    { constexpr int ai = 0, mp = 0; auto& ld = ldq[0]; EPI_LD_BATCH_(LD) } \
    _Pragma("unroll") for (int q = 0; q < 4; ++q) { \
    if (EPI_PIPE && q < 3) { const int ai = (q + 1) >> 1, mp = (q + 1) & 1; auto& ld = ldq[(q + 1) & 1]; EPI_LD_BATCH_(LD) } \
    { const int ai = q >> 1, mp = q & 1; auto& ld = ldq[EPI_PIPE ? (q & 1) : 0]; if (!EPI_PIPE && q > 0) { EPI_LD_BATCH_(LD) } \
    _Pragma("unroll") for (int mm = 0; mm < 2; ++mm) { const int m = 2 * mp + mm; const int row = u.r0 + ai * 128 + wr * 64 + m * 16 + fr; u32x4 ow[2]; \
    _Pragma("unroll") for (int bj = 0; bj < 2; ++bj) { const int col = u.c0 + wc * 64 + 16 * fq + 8 * bj; const f32x4 v0 = acc[ai][bj][m][0] * EPI_SCALE, v1 = acc[ai][bj][m][1] * EPI_SCALE; __VA_ARGS__ } \
    EPI_STORE(u.r0 + ai * 128 + wr * 64 + m * 16, u.c0 + wc * 64 + 16 * fq, ow); } } } }
__device__ __forceinline__ void store_pair16(bf16* base, int ld, int R0, int fr, int col16, const u32x4 (&ow)[2]) {
    const bool lo = fr < 8; u32x4 recv;
#pragma unroll
    for (int j = 0; j < 4; ++j) { const unsigned snd = lo ? ow[1][j] : ow[0][j]; recv[j] = (unsigned)__builtin_amdgcn_update_dpp(0, (int)snd, 0x128, 0xF, 0xF, true); }
    u32x4 d1, d2;
#pragma unroll
    for (int j = 0; j < 4; ++j) { d1[j] = lo ? ow[0][j] : recv[j]; d2[j] = lo ? recv[j] : ow[1][j]; }
    bf16* p = base + (size_t)(R0 + (fr & 7)) * ld + col16 + (lo ? 0 : 8);
    *(u32x4*)p = d1; *(u32x4*)(p + (size_t)8 * ld) = d2;
}
__device__ __forceinline__ u32x4 pack8(const f32x4 a, const f32x4 b) { u32x4 w; w.x = cvt_pk_bf16(a[0], a[1]); w.y = cvt_pk_bf16(a[2], a[3]); w.z = cvt_pk_bf16(b[0], b[1]); w.w = cvt_pk_bf16(b[2], b[3]); return w; }
__device__ __forceinline__ void unpack8(const u32x4 w, f32x4& a, f32x4& b) { a = (f32x4){bf_lo(w.x), bf_hi(w.x), bf_lo(w.y), bf_hi(w.y)}; b = (f32x4){bf_lo(w.z), bf_hi(w.z), bf_lo(w.w), bf_hi(w.w)}; }

#define EPI_STORE(R0_, C16_, OW_) do { if (ST_G8) *(u32x4*)(ST_G8 + (size_t)((R0_) + fr) * (2 * DM) + ((C16_) - C_GA)) = (u32x4){OW_[0].x, OW_[0].y, OW_[1].x, OW_[1].y}; else store_pair16(ST_BASE, ST_LD, R0_, fr, C16_, OW_); } while (0)
struct EpiInProj {
#if defined(PROBE_EPI2) && PROBE_EPI2 == 1
    static constexpr bool PROBE2 = true;
#endif
    bf16* P; const bf16* rcs; unsigned char* PG8;
    __device__ __forceinline__ void operator()(const AccT& acc, const pg8::Unit& u, int wr, int wc, int fr, int fq) const {
        const int c0 = __builtin_amdgcn_readfirstlane(u.c0);
        const int mode = c0 < C_K ? 0 : c0 < C_V ? 1 : c0 < C_G ? 2 : c0 < C_U ? 3 : c0 < C_GA ? 4 : 5;
        switch (mode) { case 0: run<0>(acc, u, wr, wc, fr, fq); break; case 1: run<1>(acc, u, wr, wc, fr, fq); break; case 2: run<2>(acc, u, wr, wc, fr, fq); break;
                        case 3: run<3>(acc, u, wr, wc, fr, fq); break; case 4: run<4>(acc, u, wr, wc, fr, fq); break; default: run<5>(acc, u, wr, wc, fr, fq); break; }
    }
    template <int mode> __device__ __forceinline__ void run(const AccT& acc, const pg8::Unit& u, int wr, int wc, int fr, int fq) const {
        bf16* const ST_BASE = P; constexpr int ST_LD = INW; constexpr float EPI_SCALE = INPROJ_FP8 ? 1.0f / 256.0f / PROBE_MMA : 1.0f; constexpr bool EPI_PIPE = EPI_PIPE_A != 0;
        unsigned char* const ST_G8 = (GATE_U8 && mode == 5) ? PG8 : nullptr;
        EPI_LOOP_LD(1, if (mode <= 1) { const int pos = row & (SEQ - 1); const int jg = (col & 127) >> 3; ld[mm][bj][0] = *(const u32x4*)(rcs + (pos * 16 + jg) * 8); } ,
            f32x4 o0, o1;
            if (mode <= 1) {
                const int pos = row & (SEQ - 1), h = (col & 511) >> 7;
                f32x4 cs, sn; unpack8(ld[mm][bj][0], cs, sn);
                const float lg = lg2_gamma(h) * (float)(pos & 63);
                const float sc = mode == 0 ? __builtin_amdgcn_exp2f(lg) : __builtin_amdgcn_exp2f(-lg) * 0.08838834764831845f;
                o0 = (v0 * cs - v1 * sn) * sc; o1 = (v0 * sn + v1 * cs) * sc;
            } else if (mode == 2) { o0 = v0; o1 = v1; }
            else if (mode == 3) { _Pragma("unroll") for (int j = 0; j < 4; ++j) { o0[j] = siluf_(v0[j]); o1[j] = siluf_(v1[j]); } }
            else if (mode == 4) { _Pragma("unroll") for (int j = 0; j < 4; ++j) { o0[j] = geluf_(v0[j]); o1[j] = geluf_(v1[j]); } }
            else { _Pragma("unroll") for (int j = 0; j < 4; ++j) { o0[j] = sigmoidf_(v0[j]); o1[j] = sigmoidf_(v1[j]); } }
            if (GATE_U8 && mode == 5) { ow[bj].x = pack4_u8(o0); ow[bj].y = pack4_u8(o1); } else
            ow[bj] = pack8(o0, o1);
        )
    }
};
struct EpiGate1 {
    const bf16* P; bf16* H1; const unsigned char* PG8;
    __device__ __forceinline__ void operator()(const AccT& acc, const pg8::Unit& u, int wr, int wc, int fr, int fq) const {
        bf16* const ST_BASE = H1; constexpr int ST_LD = DM; constexpr float EPI_SCALE = 1.0f; unsigned char* const ST_G8 = nullptr; constexpr bool EPI_PIPE = EPI_PIPE_C1 != 0;
        EPI_LOOP_LD(1, if (GATE_U8) { const u32x2 q8 = *(const u32x2*)(PG8 + (size_t)row * (2 * DM) + col); ld[mm][bj][0].x = q8.x; ld[mm][bj][0].y = q8.y; } else ld[mm][bj][0] = *(const u32x4*)(P + (size_t)row * INW + C_GA + col); ,
            f32x4 g0, g1; if (GATE_U8) unpack8_u8((u32x2){ld[mm][bj][0].x, ld[mm][bj][0].y}, g0, g1); else unpack8(ld[mm][bj][0], g0, g1);
            ow[bj] = pack8(v0 * g0, v1 * g1);
        )
    }
};
struct EpiGate2 {
    const bf16* P; const bf16* H1; bf16* Hb; const unsigned char* PG8;
    __device__ __forceinline__ void operator()(const AccT& acc, const pg8::Unit& u, int wr, int wc, int fr, int fq) const {
        bf16* const ST_BASE = Hb; constexpr int ST_LD = DM; constexpr float EPI_SCALE = 1.0f; unsigned char* const ST_G8 = nullptr; constexpr bool EPI_PIPE = EPI_PIPE_C2 != 0;
        EPI_LOOP_LD(2, if (GATE_U8) { const u32x2 q8 = *(const u32x2*)(PG8 + (size_t)row * (2 * DM) + DM + col); ld[mm][bj][0].x = q8.x; ld[mm][bj][0].y = q8.y; } else ld[mm][bj][0] = *(const u32x4*)(P + (size_t)row * INW + C_GB + col); ld[mm][bj][1] = *(const u32x4*)(H1 + (size_t)row * DM + col); ,
            f32x4 g0, g1, h0, h1; if (GATE_U8) unpack8_u8((u32x2){ld[mm][bj][0].x, ld[mm][bj][0].y}, g0, g1); else unpack8(ld[mm][bj][0], g0, g1); unpack8(ld[mm][bj][1], h0, h1);
            ow[bj] = pack8(h0 + v0 * g0, h1 + v1 * g1);
        )
    }
};
struct EpiResid {
    const float* Xf; const bf16* Xb; bf16* Z;
    __device__ __forceinline__ void operator()(const AccT& acc, const pg8::Unit& u, int wr, int wc, int fr, int fq) const {
        bf16* const ST_BASE = Z; constexpr int ST_LD = DM; constexpr float EPI_SCALE = 1.0f; unsigned char* const ST_G8 = nullptr; constexpr bool EPI_PIPE = EPI_PIPE_D != 0;
        EPI_LOOP_LD(2, if (Xf) { ld[mm][bj][0] = *(const u32x4*)(Xf + (size_t)row * DM + col); ld[mm][bj][1] = *(const u32x4*)(Xf + (size_t)row * DM + col + 4); } else ld[mm][bj][0] = *(const u32x4*)(Xb + (size_t)row * DM + col); ,
            f32x4 x0, x1;
            if (Xf) { x0 = __builtin_bit_cast(f32x4, ld[mm][bj][0]); x1 = __builtin_bit_cast(f32x4, ld[mm][bj][1]); }
            else unpack8(ld[mm][bj][0], x0, x1);
            ow[bj] = pack8(x0 * DN_ALPHA + v0, x1 * DN_ALPHA + v1);
        )
    }
};
struct EpiSwiglu {
#if defined(PROBE_EPI2) && PROBE_EPI2 == 3
    static constexpr bool PROBE2 = true;
#endif
    bf16* Act; const float* b1; LAS unsigned char* L;
    static constexpr bool BIAS_LDS = MOE_BIAS_LDS != 0;
    __device__ __forceinline__ void bias_dma(const pg8::Unit& u, int lane) const {
        const float* src = b1 + (size_t)u.e * 2 * DEXP + (u.c0 >> 1) + (lane < 32 ? lane * 4 : DEXP + (lane - 32) * 4);
        __builtin_amdgcn_global_load_lds((const unsigned*)src, (LAS unsigned*)(L + BIAS_OFF + (u.slot & 1) * 1024), 16, 0, 0); }
    __device__ __forceinline__ void operator()(const AccT& acc, const pg8::Unit& u, int wr, int wc, int fr, int fq) const {
        const int j0 = (u.c0 >> 1) + wc * 32 + 8 * fq;
        const float* be = b1 + (size_t)u.e * 2 * DEXP + j0;
        f32x4 bg0, bg1, bu0, bu1;
        if (BIAS_LDS) { const LAS float* bl = (const LAS float*)(L + BIAS_OFF + (u.slot & 1) * 1024) + wc * 32 + 8 * fq;
            bg0 = *(const LAS f32x4*)bl; bg1 = *(const LAS f32x4*)(bl + 4); bu0 = *(const LAS f32x4*)(bl + 128); bu1 = *(const LAS f32x4*)(bl + 132); }
        else { bg0 = *(const f32x4*)be; bg1 = *(const f32x4*)(be + 4); bu0 = *(const f32x4*)(be + DEXP); bu1 = *(const f32x4*)(be + DEXP + 4); }
        constexpr float sc = MOE_FP8 ? 1.0f / 256.0f / PROBE_MMA : 1.0f;
#pragma unroll
        for (int ai = 0; ai < 2; ++ai)
#pragma unroll
            for (int m = 0; m < 4; ++m) { const int row = u.r0 + ai * 128 + wr * 64 + m * 16 + fr;
                const f32x4 hg0 = acc[ai][0][m][0] * sc + bg0, hg1 = acc[ai][0][m][1] * sc + bg1, hu0 = acc[ai][1][m][0] * sc + bu0, hu1 = acc[ai][1][m][1] * sc + bu1; float a[8];
#pragma unroll
                for (int j = 0; j < 4; ++j) { const float g0 = fminf(hg0[j], 7.0f), u0 = fminf(fmaxf(hu0[j], -7.0f), 7.0f), g1 = fminf(hg1[j], 7.0f), u1 = fminf(fmaxf(hu1[j], -7.0f), 7.0f);
                    a[j] = g0 * sigmoidf_(1.702f * g0) * (u0 + 1.0f); a[4 + j] = g1 * sigmoidf_(1.702f * g1) * (u1 + 1.0f); }
                if (MOE_FP8) { u32x2 w; w.x = cvt4_fp8(a[0] * 4.0f, a[1] * 4.0f, a[2] * 4.0f, a[3] * 4.0f); w.y = cvt4_fp8(a[4] * 4.0f, a[5] * 4.0f, a[6] * 4.0f, a[7] * 4.0f); *(u32x2*)((unsigned char*)Act + (size_t)row * DEXP + j0) = w; }
                else { u32x4 w; w.x = cvt_pk_bf16(a[0], a[1]); w.y = cvt_pk_bf16(a[2], a[3]); w.z = cvt_pk_bf16(a[4], a[5]); w.w = cvt_pk_bf16(a[6], a[7]); *(u32x4*)(Act + (size_t)row * DEXP + j0) = w; } }
    }
};
struct EpiBias {
    bf16* Y; const float* b2; LAS unsigned char* L;
    static constexpr bool BIAS_LDS = MOE_BIAS_LDS != 0;
    __device__ __forceinline__ void bias_dma(const pg8::Unit& u, int lane) const {
        __builtin_amdgcn_global_load_lds((const unsigned*)(b2 + (size_t)u.e * DM + u.c0 + lane * 4), (LAS unsigned*)(L + BIAS_OFF + (u.slot & 1) * 1024), 16, 0, 0); }
    __device__ __forceinline__ void operator()(const AccT& acc, const pg8::Unit& u, int wr, int wc, int fr, int fq) const {
        const float* be = b2 + (size_t)u.e * DM; f32x4 b0a[2], b1a[2];
#pragma unroll
        for (int bj = 0; bj < 2; ++bj) { const int cc = u.c0 + wc * 64 + 16 * fq + 8 * bj;
            if (BIAS_LDS) { const LAS float* bl = (const LAS float*)(L + BIAS_OFF + (u.slot & 1) * 1024) + wc * 64 + 16 * fq + 8 * bj; b0a[bj] = *(const LAS f32x4*)bl; b1a[bj] = *(const LAS f32x4*)(bl + 4); }
            else { b0a[bj] = *(const f32x4*)(be + cc); b1a[bj] = *(const f32x4*)(be + cc + 4); } }
        bf16* const ST_BASE = Y; constexpr int ST_LD = DM; unsigned char* const ST_G8 = nullptr;
        if (MOE_FP8) {
#pragma unroll
            for (int ai = 0; ai < 2; ++ai)
#pragma unroll
                for (int m = 0; m < 4; ++m) { const int row = u.r0 + ai * 128 + wr * 64 + m * 16 + fr; u32x4 w;
#pragma unroll
                    for (int bj = 0; bj < 2; ++bj) { const f32x4 y0 = (acc[ai][bj][m][0] * (1.0f / 512.0f / PROBE_MMA) + b0a[bj]) * 16.0f, y1 = (acc[ai][bj][m][1] * (1.0f / 512.0f / PROBE_MMA) + b1a[bj]) * 16.0f;
                        w[2 * bj] = cvt4_fp8(y0[0], y0[1], y0[2], y0[3]); w[2 * bj + 1] = cvt4_fp8(y1[0], y1[1], y1[2], y1[3]); }
                    *(u32x4*)((unsigned char*)Y + (size_t)row * DM + u.c0 + wc * 64 + 16 * fq) = w; }
        } else {
        EPI_LOOP(
            const f32x4 b0v = b0a[bj], b1v = b1a[bj];
            ow[bj] = pack8(v0 + b0v, v1 + b1v);
        )
        }
    }
};

struct Frame {
    LAS unsigned char* lds; volatile LAS unsigned* MISC; unsigned* ctl;
    int tid, lane, wave, G, bid;
    unsigned char* ws;
};
#define WSP(T_, off) ((T_*)(F.ws + (off)))
__device__ __forceinline__ void frame_refresh(Frame& F) { F.tid = opaque_tid(); F.lane = F.tid & 63; F.wave = __builtin_amdgcn_readfirstlane(F.tid >> 6);
    int b_ = blockIdx.x, g_ = gridDim.x; asm volatile("" : "+s"(b_), "+s"(g_)); F.bid = b_; F.G = g_; }

template <class FN>
__device__ __forceinline__ void transpose_item(const float* __restrict__ W, int N, bf16* __restrict__ WT, int K, int k0, int n0, FN srccol, LAS float* scr, int lane) {
    const int dq = lane & 15, ks = lane >> 4; const int sc = srccol(n0 + 4 * dq);
    f32x4 v[16];
#pragma unroll
    for (int it = 0; it < 16; ++it) v[it] = *(const f32x4*)(W + (size_t)(k0 + 4 * it + ks) * N + sc);
#pragma unroll
    for (int it = 0; it < 16; ++it) { LAS float* d = scr + (4 * it + ks) * 65 + 4 * dq; d[0] = v[it][0]; d[1] = v[it][1]; d[2] = v[it][2]; d[3] = v[it][3]; }
    LDS_WAIT();
    const int c = lane >> 3, ns = lane & 7;
#pragma unroll
    for (int j = 0; j < 8; ++j) { const int n = 8 * j + ns; const LAS float* s = scr + (8 * c) * 65 + n;
        u32x4 o; o.x = cvt_pk_bf16(s[0], s[65]); o.y = cvt_pk_bf16(s[2 * 65], s[3 * 65]); o.z = cvt_pk_bf16(s[4 * 65], s[5 * 65]); o.w = cvt_pk_bf16(s[6 * 65], s[7 * 65]);
        *(u32x4*)(WT + (size_t)(n0 + n) * K + k0 + 8 * c) = o; }
    LDS_WAIT();
}
template <class FN>
__device__ __forceinline__ void transpose_item_f8(const float* __restrict__ W, int N, unsigned char* __restrict__ WT, int K, int k0, int n0, FN srccol, float scale, LAS float* scr, int lane) {
    const int dq = lane & 7, ks = lane >> 3; const int sc = srccol(n0 + 4 * dq);
    f32x4 v[16];
#pragma unroll
    for (int it = 0; it < 16; ++it) v[it] = *(const f32x4*)(W + (size_t)(k0 + 8 * it + ks) * N + sc);
#pragma unroll
    for (int it = 0; it < 16; ++it) { LAS float* d = scr + (8 * it + ks) * 33 + 4 * dq; d[0] = v[it][0] * scale; d[1] = v[it][1] * scale; d[2] = v[it][2] * scale; d[3] = v[it][3] * scale; }
    LDS_WAIT();
    const int c = lane & 7, ns = lane >> 3;
#pragma unroll
    for (int j = 0; j < 4; ++j) { const int n = 8 * j + ns; const LAS float* s = scr + (16 * c) * 33 + n;
        u32x4 o; o.x = cvt4_fp8(s[0], s[33], s[2 * 33], s[3 * 33]); o.y = cvt4_fp8(s[4 * 33], s[5 * 33], s[6 * 33], s[7 * 33]);
        o.z = cvt4_fp8(s[8 * 33], s[9 * 33], s[10 * 33], s[11 * 33]); o.w = cvt4_fp8(s[12 * 33], s[13 * 33], s[14 * 33], s[15 * 33]);
        *(u32x4*)(WT + (size_t)(n0 + n) * K + k0 + 16 * c) = o; }
    LDS_WAIT();
}
struct ColId { __device__ int operator()(int n) const { return n; } };
struct ColQK { __device__ int operator()(int n) const { if (n >= C_V) return n; const int cl = n & 127, g8 = cl >> 3, i = cl & 7; return (n & ~127) + (i < 4 ? 4 * g8 + i : 64 + 4 * g8 + (i - 4)); } };
struct ColGU { __device__ int operator()(int n) const { const int pn = n >> 8, wi = n & 255, hid = pn * 128 + (wi >> 4) * 8 + (wi & 7); return (wi & 8) ? DEXP + hid : hid; } };

__device__ __forceinline__ void p0_prologue(Frame& F, const float* x, const float* w_in, const float* p_ret, const float* p_sg, const float* w_o, const float* sg_w, const float* e_w1, const float* e_w2) {
    LAS float* scr = (LAS float*)(F.lds + F.wave * 16896);
    const int gw = F.bid * NWAVES + F.wave, NGW = F.G * NWAVES;
    constexpr int I_IN = (DM / 64) * (INW / 64), I_SQ = (DM / 64) * (DM / 64), I_W1 = NE * (DM / 64) * (2 * DEXP / 64), I_W2 = NE * (DEXP / 64) * (DM / 64);
    constexpr int I_LAYER = I_IN + 3 * I_SQ + I_W1 + I_W2;
    for (int it = gw; it < NL * I_LAYER; it += NGW) {
        const int l = it / I_LAYER; int r = it - l * I_LAYER;
        if (r < I_IN) { const int nb = INW / 64, kb = r / nb, nn = r - kb * nb;
            if (INPROJ_FP8) { const int nb8 = INW / 32, kb8 = r / nb8, nn8 = r - kb8 * nb8; transpose_item_f8(w_in + (size_t)l * DM * INW, INW, WSP(unsigned char, WS_WIN) + (size_t)l * INW * DM, DM, 128 * kb8, 32 * nn8, ColQK(), 64.0f, scr, F.lane); }
            else transpose_item(w_in + (size_t)l * DM * INW, INW, WSP(bf16, WS_WIN) + (size_t)l * INW * DM, DM, 64 * kb, 64 * nn, ColQK(), scr, F.lane);
            continue; } r -= I_IN;
        if (r < 3 * I_SQ) { const int which = r / I_SQ; r -= which * I_SQ; const int kb = r / 16, nn = r & 15;
            const float* src = (which == 0 ? p_ret : which == 1 ? p_sg : w_o) + (size_t)l * DM * DM;
            bf16* dst = WSP(bf16, which == 0 ? WS_PRET : which == 1 ? WS_PSG : WS_WO) + (size_t)l * DM * DM;
            transpose_item(src, DM, dst, DM, 64 * kb, 64 * nn, ColId(), scr, F.lane); continue; } r -= 3 * I_SQ;
        if (r < I_W1) { const int e = r / 512; r -= e * 512; const int kb = r / 32, nn = r & 31;
            if (MOE_FP8) transpose_item_f8(e_w1 + ((size_t)l * NE + e) * DM * 2 * DEXP, 2 * DEXP, WSP(unsigned char, WS_W1) + ((size_t)l * NE + e) * 2 * DEXP * DM, DM, 128 * (r >> 6), 32 * (r & 63), ColGU(), 64.0f, scr, F.lane);
            else transpose_item(e_w1 + ((size_t)l * NE + e) * DM * 2 * DEXP, 2 * DEXP, WSP(bf16, WS_W1) + ((size_t)l * NE + e) * 2 * DEXP * DM, DM, 64 * kb, 64 * nn, ColGU(), scr, F.lane);
            continue; } r -= I_W1;
        { const int e = r / 256; r -= e * 256; const int kb = r / 16, nn = r & 15;
            if (MOE_FP8) transpose_item_f8(e_w2 + ((size_t)l * NE + e) * DEXP * DM, DM, WSP(unsigned char, WS_W2) + ((size_t)l * NE + e) * DM * DEXP, DEXP, 128 * (r >> 5), 32 * (r & 31), ColId(), 128.0f, scr, F.lane);
            else transpose_item(e_w2 + ((size_t)l * NE + e) * DEXP * DM, DM, WSP(bf16, WS_W2) + ((size_t)l * NE + e) * DM * DEXP, DEXP, 64 * kb, 64 * nn, ColId(), scr, F.lane); }
    }
    const size_t gt = (size_t)F.bid * NTHREADS + F.tid, NT = (size_t)F.G * NTHREADS;
    { const f32x4* s = (const f32x4*)sg_w; u32x2* d = WSP(u32x2, WS_SGW);
      for (size_t i = gt; i < (size_t)NL * 8 * 128 * 128 / 4; i += NT) { const f32x4 v = s[i]; u32x2 w; w.x = cvt_pk_bf16(v[0], v[1]); w.y = cvt_pk_bf16(v[2], v[3]); d[i] = w; } }
    { const f32x4* s = (const f32x4*)x; u32x2* d = WSP(u32x2, WS_XB);
      unsigned* dq = WSP(unsigned, WS_XQ);
      for (size_t i = gt; i < (size_t)T * DM / 4; i += NT) { const f32x4 v = s[i]; if (INPROJ_FP8) dq[i] = cvt4_fp8(v[0] * 4.0f, v[1] * 4.0f, v[2] * 4.0f, v[3] * 4.0f); else { u32x2 w; w.x = cvt_pk_bf16(v[0], v[1]); w.y = cvt_pk_bf16(v[2], v[3]); d[i] = w; } } }
    { float* rc = WSP(float, WS_ROPE); float* rs = rc + SEQ * 64;
      for (size_t i = gt; i < (size_t)SEQ * 64; i += NT) { const int pos = (int)(i >> 6), j = (int)(i & 63);
          const double inv = exp2(-(double)j * (13.287712379549449 / 64.0)), ang = (double)pos * inv;
          const double qd = rint(ang * 0.6366197723675814); const int qi = (int)qd;
          const double r = (ang - qd * 1.5707963267341256) - qd * 6.077100506506192e-11, r2 = r * r;
          const double sn = r * (1.0 + r2 * (-1.0 / 6 + r2 * (1.0 / 120 + r2 * (-1.0 / 5040 + r2 * (1.0 / 362880 + r2 * (-1.0 / 39916800 + r2 * (1.0 / 6227020800.0)))))));
          const double cs = 1.0 + r2 * (-0.5 + r2 * (1.0 / 24 + r2 * (-1.0 / 720 + r2 * (1.0 / 40320 + r2 * (-1.0 / 3628800 + r2 * (1.0 / 479001600.0 + r2 * (-1.0 / 87178291200.0)))))));
          const int qm = qi & 3; const double c = qm == 0 ? cs : qm == 1 ? -sn : qm == 2 ? -cs : sn, sv = qm == 0 ? sn : qm == 1 ? cs : qm == 2 ? -sn : -cs;
          rc[i] = (float)c; rs[i] = (float)sv;
          unsigned short* rcs = WSP(unsigned short, WS_ROPEB); const size_t o = ((size_t)pos * 16 + (j >> 2)) * 8 + (j & 3);
          rcs[o] = (unsigned short)(cvt_pk_bf16((float)c, 0.0f) & 0xffffu); rcs[o + 4] = (unsigned short)(cvt_pk_bf16((float)sv, 0.0f) & 0xffffu); } }
}

typedef short v4i16_t __attribute__((ext_vector_type(4)));
__device__ __forceinline__ s16x4 tr_read(const LAS unsigned char* p) { return __builtin_bit_cast(s16x4, __builtin_amdgcn_ds_read_tr16_b64_v4i16((LAS v4i16_t*)p)); }
__device__ __forceinline__ bf16x8 cat8(s16x4 a, s16x4 b) { return __builtin_shufflevector(a, b, 0, 1, 2, 3, 4, 5, 6, 7); }
constexpr int RQ_STRIDE = 272, RV_STRIDE = 544;
constexpr int RO_STRIDE = 528;
constexpr int R_Q = 0, R_K = 64 * RQ_STRIDE, R_V = 2 * 64 * RQ_STRIDE, R_SF = R_V + 64 * RV_STRIDE, R_ST = R_SF + 8192, R_OT = R_ST + 4096, R_END = R_OT + 64 * RO_STRIDE;
static_assert(R_END <= RING_BYTES, "retention LDS");

constexpr int RSEG = 4, RCPS = SEQ / 64 / RSEG;
__device__ __forceinline__ float* sloc_ptr(Frame& F, int bh, int seg, int w) { return WSP(float, WS_X1F) + ((size_t)((bh * 3 + seg) * 8 + w)) * 4096; }
__device__ __forceinline__ void ret_unit(Frame& F, int b, int h, int seg) {
    LAS unsigned char* L = F.lds;
    __syncthreads();
    const int tid = F.tid, lane = F.lane, w = F.wave, l15 = lane & 15, rq = lane >> 4, tq = l15 >> 2, tp = lane & 3, es = 32 * w;
    const bf16* P = WSP(bf16, WS_P); bf16* Y = WSP(bf16, WS_YRET);
    const float gam = __builtin_amdgcn_exp2f(lg2_gamma(h)), g63 = __builtin_amdgcn_exp2f(63.0f * lg2_gamma(h));
    const unsigned qoff = (unsigned)((tid >> 4) * INW + h * 128 + (tid & 15) * 8) * 2u, voffv = (unsigned)((tid >> 5) * INW + C_V + h * 256 + (tid & 31) * 8) * 2u;
    const unsigned qlds = (unsigned)((tid >> 4) * RQ_STRIDE + (tid & 15) * 16), vlds = (unsigned)((tid >> 5) * RV_STRIDE + (tid & 31) * 16);
    const unsigned goff = (unsigned)((tid >> 5) * INW + C_G + h * 256 + (tid & 31) * 8) * 2u, yoff = (unsigned)((tid >> 5) * DM + h * 256 + (tid & 31) * 8) * 2u, olds = (unsigned)((tid >> 5) * RO_STRIDE + (tid & 31) * 16);
    u32x4 pq[2], pk[2], pv[4];
    const size_t tb = (size_t)b * SEQ;
    const char* Pc = (const char*)P; char* Yc = (char*)Y;
#define RET_LOAD(c) do { const char* ub_ = Pc + (tb + (size_t)(c) * 64) * INW * 2; \
        _Pragma("unroll") for (int i = 0; i < 2; ++i) { const char* rp = ub_ + (size_t)(32 * i) * INW * 2 + qoff; pq[i] = __builtin_nontemporal_load((const u32x4*)(rp + C_Q * 2)); pk[i] = __builtin_nontemporal_load((const u32x4*)(rp + C_K * 2)); } \
        _Pragma("unroll") for (int i = 0; i < 4; ++i) pv[i] = __builtin_nontemporal_load((const u32x4*)(ub_ + (size_t)(16 * i) * INW * 2 + voffv)); } while (0)
#define RET_STORE() do { \
        _Pragma("unroll") for (int i = 0; i < 2; ++i) { *(LAS u32x4*)(L + R_Q + qlds + i * 32 * RQ_STRIDE) = pq[i]; *(LAS u32x4*)(L + R_K + qlds + i * 32 * RQ_STRIDE) = pk[i]; } \
        _Pragma("unroll") for (int i = 0; i < 4; ++i) *(LAS u32x4*)(L + R_V + vlds + i * 16 * RV_STRIDE) = pv[i]; } while (0)
    if (tid < 64) { *(LAS u32x2*)(L + R_SF + ((0 * 2 + 0) * 64 + tid) * 16 + 8) = (u32x2){0u, 0u}; *(LAS u32x2*)(L + R_SF + ((2 * 2 + 1) * 64 + tid) * 16 + 8) = (u32x2){0u, 0u}; }
    const int c0 = seg * RCPS;
    RET_LOAD(c0); RET_STORE(); RET_LOAD(c0 + 1);
    f32x4 St[8][2];
#pragma unroll
    for (int dt = 0; dt < 8; ++dt) { St[dt][0] = (f32x4){0.f, 0.f, 0.f, 0.f}; St[dt][1] = (f32x4){0.f, 0.f, 0.f, 0.f}; }
    if (seg > 0) {
        const float fseg = __builtin_amdgcn_exp2f((float)(64 * RCPS) * lg2_gamma(h));
        for (int sg = 0; sg < seg; ++sg) { const float* sp = sloc_ptr(F, b * 4 + h, sg, w) + lane;
#pragma unroll
            for (int dt = 0; dt < 8; ++dt)
#pragma unroll
                for (int et = 0; et < 2; ++et)
#pragma unroll
                    for (int r = 0; r < 4; ++r) St[dt][et][r] = St[dt][et][r] * fseg + sp[((dt * 2 + et) * 4 + r) * 64]; } }
    __syncthreads();
    for (int cc = 0; cc < RCPS; ++cc) {
        const int c = c0 + cc;
        const size_t t0 = tb + (size_t)c * 64;
        u32x4 gp[4];
#pragma unroll
        for (int k = 0; k < 4; ++k) gp[k] = __builtin_nontemporal_load((const u32x4*)(Pc + (t0 + 16 * k) * INW * 2 + goff));
#pragma unroll
        for (int rep = 0; rep < 2; ++rep) {
            const int id = w + 8 * rep;
            if (id < 10) {
                const int tj = id < 4 ? 0 : id < 7 ? 1 : id < 9 ? 2 : 3, ti = id < 4 ? id : id < 7 ? id - 3 : id < 9 ? id - 5 : 3;
                f32x4 s = (f32x4){0.f, 0.f, 0.f, 0.f};
#pragma unroll
                for (int kb = 0; kb < 4; ++kb) {
                    const bf16x8 a = *(const LAS bf16x8*)(L + R_K + (16 * tj + l15) * RQ_STRIDE + (32 * kb + 8 * rq) * 2);
                    const bf16x8 q = *(const LAS bf16x8*)(L + R_Q + (16 * ti + l15) * RQ_STRIDE + (32 * kb + 8 * rq) * 2);
                    s = __builtin_amdgcn_mfma_f32_16x16x32_bf16(a, q, s, 0, 0, 0); }
                if (tj == ti) {
#pragma unroll
                    for (int r = 0; r < 4; ++r) s[r] = (l15 >= 4 * rq + r) ? s[r] : 0.f; }
                u32x2 wv; wv.x = cvt_pk_bf16(s[0], s[1]); wv.y = cvt_pk_bf16(s[2], s[3]);
                *(LAS u32x2*)(L + R_SF + ((ti * 2 + (tj >> 1)) * 64 + lane) * 16 + (tj & 1) * 8) = wv;
            }
        }
        __syncthreads();
        f32x4 O[2][4];
#pragma unroll
        for (int et = 0; et < 2; ++et)
#pragma unroll
            for (int ti = 0; ti < 4; ++ti) O[et][ti] = (f32x4){0.f, 0.f, 0.f, 0.f};
#pragma unroll
        for (int kb = 0; kb < 4; ++kb) {
            bf16x8 A[2];
#pragma unroll
            for (int et = 0; et < 2; ++et) { const f32x4 s0 = St[2 * kb][et], s1 = St[2 * kb + 1][et];
                u32x4 p; p.x = cvt_pk_bf16(s0[0], s0[1]); p.y = cvt_pk_bf16(s0[2], s0[3]); p.z = cvt_pk_bf16(s1[0], s1[1]); p.w = cvt_pk_bf16(s1[2], s1[3]); A[et] = __builtin_bit_cast(bf16x8, p); }
#pragma unroll
            for (int ti = 0; ti < 4; ++ti) {
                const LAS unsigned char* qp = L + R_Q + (16 * ti + l15) * RQ_STRIDE + (32 * kb + 4 * rq) * 2;
                const bf16x8 Bq = cat8(*(const LAS s16x4*)qp, *(const LAS s16x4*)(qp + 32));
#pragma unroll
                for (int et = 0; et < 2; ++et) O[et][ti] = __builtin_amdgcn_mfma_f32_16x16x32_bf16(A[et], Bq, O[et][ti], 0, 0, 0); }
            __builtin_amdgcn_sched_barrier(0);
        }
#pragma unroll
        for (int et = 0; et < 2; ++et)
#pragma unroll
            for (int ti = 0; ti < 4; ++ti) O[et][ti] *= gam;
#pragma unroll
        for (int kb = 0; kb < 2; ++kb) {
            bf16x8 Av[2];
#pragma unroll
            for (int et = 0; et < 2; ++et) { const LAS unsigned char* vp = L + R_V + (32 * kb + 4 * rq + tq) * RV_STRIDE + (es + 16 * et + 4 * tp) * 2;
                Av[et] = cat8(tr_read(vp), tr_read(vp + 16 * RV_STRIDE)); }
#pragma unroll
            for (int ti = 2 * kb; ti < 4; ++ti) {
                const bf16x8 Bs = *(const LAS bf16x8*)(L + R_SF + ((ti * 2 + kb) * 64 + lane) * 16);
#pragma unroll
                for (int et = 0; et < 2; ++et) O[et][ti] = __builtin_amdgcn_mfma_f32_16x16x32_bf16(Av[et], Bs, O[et][ti], 0, 0, 0); }
            __builtin_amdgcn_sched_barrier(0);
        }
#pragma unroll
        for (int dt = 0; dt < 8; ++dt) { St[dt][0] *= gam; St[dt][1] *= gam; }
#pragma unroll
        for (int kb = 0; kb < 2; ++kb) {
            bf16x8 Bv[2];
#pragma unroll
            for (int et = 0; et < 2; ++et) { const LAS unsigned char* vp = L + R_V + (32 * kb + 8 * rq + tq) * RV_STRIDE + (es + 16 * et + 4 * tp) * 2;
                Bv[et] = cat8(tr_read(vp), tr_read(vp + 4 * RV_STRIDE)); }
#pragma unroll
            for (int dt = 0; dt < 8; ++dt) { const LAS unsigned char* kp = L + R_K + (32 * kb + 8 * rq + tq) * RQ_STRIDE + (16 * dt + 4 * tp) * 2;
                const bf16x8 Ak = cat8(tr_read(kp), tr_read(kp + 4 * RQ_STRIDE));
#pragma unroll
                for (int et = 0; et < 2; ++et) St[dt][et] = __builtin_amdgcn_mfma_f32_16x16x32_bf16(Ak, Bv[et], St[dt][et], 0, 0, 0);
                if (dt & 1) __builtin_amdgcn_sched_barrier(0); }
        }
#pragma unroll
        for (int dt = 0; dt < 8; ++dt) { St[dt][0] *= g63; St[dt][1] *= g63; }
#pragma unroll
        for (int ti = 0; ti < 4; ++ti) { float s = 0.f, ss = 0.f;
#pragma unroll
            for (int et = 0; et < 2; ++et)
#pragma unroll
                for (int r = 0; r < 4; ++r) { const float v = O[et][ti][r]; s += v; ss += v * v; }
            s += __shfl_xor(s, 16); s += __shfl_xor(s, 32); ss += __shfl_xor(ss, 16); ss += __shfl_xor(ss, 32);
            if (lane < 16) *(LAS f32x2*)(L + R_ST + ((16 * ti + lane) * 8 + w) * 8) = (f32x2){s, ss}; }
        __syncthreads();
        if (cc + 1 < RCPS) { RET_STORE(); if (cc + 2 < RCPS) RET_LOAD(c + 2); }
#pragma unroll
        for (int ti = 0; ti < 4; ++ti) { float s = 0.f, ss = 0.f;
            const LAS f32x4* sp = (const LAS f32x4*)(L + R_ST + (16 * ti + l15) * 64);
#pragma unroll
            for (int k = 0; k < 4; ++k) { const f32x4 v = sp[k]; s += v[0] + v[2]; ss += v[1] + v[3]; }
            const float mean = s * (1.0f / 256.0f), var = ss * (1.0f / 256.0f) - mean * mean, rstd = 1.0f / sqrtf(fmaxf(var, 0.f) + LN_EPS);
#pragma unroll
            for (int et = 0; et < 2; ++et) { const f32x4 o = (O[et][ti] - mean) * rstd;
                u32x2 wv; wv.x = cvt_pk_bf16(o[0], o[1]); wv.y = cvt_pk_bf16(o[2], o[3]);
                *(LAS u32x2*)(L + R_OT + (16 * ti + l15) * RO_STRIDE + (es + 16 * et + 4 * rq) * 2) = wv; } }
        __syncthreads();
#pragma unroll
        for (int k = 0; k < 4; ++k) { f32x4 o0, o1, g0, g1; unpack8(*(const LAS u32x4*)(L + R_OT + olds + k * 16 * RO_STRIDE), o0, o1); unpack8(gp[k], g0, g1);
            *(u32x4*)(Yc + (t0 + 16 * k) * DM * 2 + yoff) = pack8(o0 * g0, o1 * g1); }
    }
#undef RET_LOAD
#undef RET_STORE
}


__device__ __forceinline__ void ret_prepass(Frame& F, int b, int h, int seg) {
    LAS unsigned char* L = F.lds;
    __syncthreads();
    const int tid = F.tid, lane = F.lane, w = F.wave, l15 = lane & 15, rq = lane >> 4, tq = l15 >> 2, tp = lane & 3, es = 32 * w;
    const float gam = __builtin_amdgcn_exp2f(lg2_gamma(h)), g63 = __builtin_amdgcn_exp2f(63.0f * lg2_gamma(h));
    const unsigned qoff = (unsigned)((tid >> 4) * INW + h * 128 + (tid & 15) * 8) * 2u, voffv = (unsigned)((tid >> 5) * INW + C_V + h * 256 + (tid & 31) * 8) * 2u;
    const unsigned qlds = (unsigned)((tid >> 4) * RQ_STRIDE + (tid & 15) * 16), vlds = (unsigned)((tid >> 5) * RV_STRIDE + (tid & 31) * 16);
    u32x4 pk[2], pv[4];
    const size_t tb = (size_t)b * SEQ; const char* Pc = (const char*)WSP(bf16, WS_P);
#define RPP_LOAD(c) do { const char* ub_ = Pc + (tb + (size_t)(c) * 64) * INW * 2; \
        _Pragma("unroll") for (int i = 0; i < 2; ++i) pk[i] = __builtin_nontemporal_load((const u32x4*)(ub_ + (size_t)(32 * i) * INW * 2 + qoff + C_K * 2)); \
        _Pragma("unroll") for (int i = 0; i < 4; ++i) pv[i] = __builtin_nontemporal_load((const u32x4*)(ub_ + (size_t)(16 * i) * INW * 2 + voffv)); } while (0)
#define RPP_STORE() do { \
        _Pragma("unroll") for (int i = 0; i < 2; ++i) *(LAS u32x4*)(L + R_K + qlds + i * 32 * RQ_STRIDE) = pk[i]; \
        _Pragma("unroll") for (int i = 0; i < 4; ++i) *(LAS u32x4*)(L + R_V + vlds + i * 16 * RV_STRIDE) = pv[i]; } while (0)
    const int c0 = seg * RCPS;
    RPP_LOAD(c0); RPP_STORE(); RPP_LOAD(c0 + 1);
    f32x4 St[8][2];
#pragma unroll
    for (int dt = 0; dt < 8; ++dt) { St[dt][0] = (f32x4){0.f, 0.f, 0.f, 0.f}; St[dt][1] = (f32x4){0.f, 0.f, 0.f, 0.f}; }
    __syncthreads();
    for (int cc = 0; cc < RCPS; ++cc) {
#pragma unroll
        for (int dt = 0; dt < 8; ++dt) { St[dt][0] *= gam; St[dt][1] *= gam; }
#pragma unroll
        for (int kb = 0; kb < 2; ++kb) {
            bf16x8 Bv[2];
#pragma unroll
            for (int et = 0; et < 2; ++et) { const LAS unsigned char* vp = L + R_V + (32 * kb + 8 * rq + tq) * RV_STRIDE + (es + 16 * et + 4 * tp) * 2;
                Bv[et] = cat8(tr_read(vp), tr_read(vp + 4 * RV_STRIDE)); }
#pragma unroll
            for (int dt = 0; dt < 8; ++dt) { const LAS unsigned char* kp = L + R_K + (32 * kb + 8 * rq + tq) * RQ_STRIDE + (16 * dt + 4 * tp) * 2;
                const bf16x8 Ak = cat8(tr_read(kp), tr_read(kp + 4 * RQ_STRIDE));
#pragma unroll
                for (int et = 0; et < 2; ++et) St[dt][et] = __builtin_amdgcn_mfma_f32_16x16x32_bf16(Ak, Bv[et], St[dt][et], 0, 0, 0);
                if (dt & 1) __builtin_amdgcn_sched_barrier(0); }
        }
#pragma unroll
        for (int dt = 0; dt < 8; ++dt) { St[dt][0] *= g63; St[dt][1] *= g63; }
        __syncthreads();
        if (cc + 1 < RCPS) { RPP_STORE(); if (cc + 2 < RCPS) RPP_LOAD(c0 + cc + 2); }
        __syncthreads();
    }
    float* sp = sloc_ptr(F, b * 4 + h, seg, w) + lane;
#pragma unroll
    for (int dt = 0; dt < 8; ++dt)
#pragma unroll
        for (int et = 0; et < 2; ++et)
#pragma unroll
            for (int r = 0; r < 4; ++r) sp[((dt * 2 + et) * 4 + r) * 64] = St[dt][et][r];
#undef RPP_LOAD
#undef RPP_STORE
}

__device__ __forceinline__ float wave_sum_dpp(float v);
constexpr int SGT_STRIDE = 272;
constexpr int SG4_ST = 0, SG4_T = 1024, SG4_U = SG4_T + 128 * SGT_STRIDE, SG4_W = SG4_U + 128 * SGT_STRIDE, SG4_END = SG4_W + 24 * 1024;
static_assert(SG4_END <= RING_BYTES, "SGU LDS");
__device__ __forceinline__ void sgu_unit(Frame& F, int blk, int l, const float* sg_b, const float* sg_ln_g, const float* sg_ln_b) {
    LAS unsigned char* L = F.lds;
    const int tid = F.tid, lane = F.lane, w = F.wave, l15 = lane & 15, rq = lane >> 4, tq = l15 >> 2, tp = lane & 3;
    const size_t t0 = (size_t)blk * 128;
    const char* Pc = (const char*)WSP(bf16, WS_P); char* Yc = (char*)WSP(bf16, WS_YSG);
    const bf16* Wl = WSP(bf16, WS_SGW) + (size_t)l * 8 * 128 * 128;
    __syncthreads();
    const int srow = tid >> 4, sch = tid & 15;
    const unsigned soff = (unsigned)(srow * INW + sch * 8) * 2u, slds = (unsigned)(srow * SGT_STRIDE + sch * 16), yoff = (unsigned)(srow * DM + sch * 8) * 2u;
    unsigned wsrc[3];
#pragma unroll
    for (int i = 0; i < 3; ++i) { const int p = tid + 512 * i, f = p >> 6, ln = p & 63, qt = f < 8 ? (f >> 1) : 4 + ((f - 8) >> 2), kb = f < 8 ? (f & 1) : ((f - 8) & 3);
        wsrc[i] = (unsigned)((16 * qt + (ln & 15)) * 128 + 32 * kb + 8 * (ln >> 4)) * 2u; }
    u32x4 xv[4], xu[4], wreg[3]; f32x4 lnp[4]; float bq[8], bqn[8];
#define SG_LOAD(g_) do { _Pragma("unroll") for (int i = 0; i < 4; ++i) { const char* rp = Pc + ((t0 + 32 * i) * INW + (g_) * 128) * 2 + soff; xv[i] = __builtin_nontemporal_load((const u32x4*)(rp + C_VS * 2)); xu[i] = __builtin_nontemporal_load((const u32x4*)(rp + C_U * 2)); } \
        { const float* lng = sg_ln_g + (size_t)l * DM + (g_) * 128 + sch * 8; const float* lnb = sg_ln_b + (size_t)l * DM + (g_) * 128 + sch * 8; lnp[0] = *(const f32x4*)lng; lnp[1] = *(const f32x4*)(lng + 4); lnp[2] = *(const f32x4*)lnb; lnp[3] = *(const f32x4*)(lnb + 4); } \
        _Pragma("unroll") for (int qt = 0; qt < 8; ++qt) bqn[qt] = sg_b[((size_t)l * 8 + (g_)) * 128 + 16 * qt + l15]; \
        _Pragma("unroll") for (int i = 0; i < 3; ++i) wreg[i] = *(const u32x4*)((const char*)(Wl + (size_t)(g_) * 128 * 128) + wsrc[i]); } while (0)
#define SG_WPUT() do { _Pragma("unroll") for (int i = 0; i < 3; ++i) *(LAS u32x4*)(L + SG4_W + (tid + 512 * i) * 16) = wreg[i]; } while (0)
    SG_LOAD(0);
#pragma unroll 1
    for (int r8 = 0; r8 < 2; ++r8) { u32x4 a[8], b2[8];
#pragma unroll
        for (int r = 0; r < 8; ++r) { const char* rp = Pc + ((t0 + 16 * w + 8 * r8 + r) * INW + C_VS) * 2 + lane * 32; a[r] = *(const u32x4*)rp; b2[r] = *(const u32x4*)(rp + 16); }
#pragma unroll
        for (int r = 0; r < 8; ++r) { f32x4 x0, x1, x2, x3; unpack8(a[r], x0, x1); unpack8(b2[r], x2, x3);
            float s = 0.f, ss = 0.f;
#pragma unroll
            for (int j = 0; j < 4; ++j) { s += x0[j] + x1[j] + x2[j] + x3[j]; ss += x0[j] * x0[j] + x1[j] * x1[j] + x2[j] * x2[j] + x3[j] * x3[j]; }
            s = wave_sum_dpp(s); ss = wave_sum_dpp(ss);
            const float mean = s * (1.0f / 1024.0f), var = ss * (1.0f / 1024.0f) - mean * mean;
            if (lane == 0) *(LAS f32x2*)(L + SG4_ST + (16 * w + 8 * r8 + r) * 8) = (f32x2){mean, 1.0f / sqrtf(fmaxf(var, 0.f) + LN_EPS)}; } }
    SG_WPUT();
    __syncthreads();
#pragma unroll 1
    for (int g = 0; g < 8; ++g) {
#pragma unroll
        for (int qt = 0; qt < 8; ++qt) bq[qt] = bqn[qt];
#pragma unroll
        for (int i = 0; i < 4; ++i) { f32x4 x0, x1; unpack8(xv[i], x0, x1);
            const f32x2 st = *(const LAS f32x2*)(L + SG4_ST + (srow + 32 * i) * 8);
            x0 = (x0 - st.x) * st.y * lnp[0] + lnp[2]; x1 = (x1 - st.x) * st.y * lnp[1] + lnp[3];
            *(LAS u32x4*)(L + SG4_T + slds + i * 32 * SGT_STRIDE) = pack8(x0, x1);
            *(LAS u32x4*)(L + SG4_U + slds + i * 32 * SGT_STRIDE) = xu[i]; }
        if (g < 7) SG_LOAD(g + 1);
        __syncthreads();
        bf16x8 Av[4];
#pragma unroll
        for (int kb = 0; kb < 4; ++kb) { const LAS unsigned char* vp = L + SG4_T + (32 * kb + 8 * rq + tq) * SGT_STRIDE + (16 * w + 4 * tp) * 2; Av[kb] = cat8(tr_read(vp), tr_read(vp + 4 * SGT_STRIDE)); }
#pragma unroll
        for (int qt = 0; qt < 8; ++qt) {
            f32x4 a0 = (f32x4){0.f, 0.f, 0.f, 0.f};
#pragma unroll
            for (int kb = 0; kb < 4; ++kb) { if (qt < 4 && kb >= 2) continue;
                const int f = qt < 4 ? 2 * qt + kb : 8 + 4 * (qt - 4) + kb;
                const bf16x8 Bw = *(const LAS bf16x8*)(L + SG4_W + f * 1024 + lane * 16);
                a0 = __builtin_amdgcn_mfma_f32_16x16x32_bf16(Av[kb], Bw, a0, 0, 0, 0); }
            const f32x4 a = a0 + bq[qt];
            LAS u32x2* up = (LAS u32x2*)(L + SG4_U + (16 * qt + l15) * SGT_STRIDE + (16 * w + 4 * rq) * 2);
            const u32x2 u2 = *up;
            u32x2 wv; wv.x = cvt_pk_bf16(a[0] * bf_lo(u2.x), a[1] * bf_hi(u2.x)); wv.y = cvt_pk_bf16(a[2] * bf_lo(u2.y), a[3] * bf_hi(u2.y));
            *up = wv;
        }
        __syncthreads();
        if (g < 7) SG_WPUT();
#pragma unroll
        for (int i = 0; i < 4; ++i) *(u32x4*)(Yc + ((t0 + 32 * i) * DM + g * 128) * 2 + yoff) = *(const LAS u32x4*)(L + SG4_U + slds + i * 32 * SGT_STRIDE);
    }
#undef SG_LOAD
#undef SG_WPUT
}

__device__ __forceinline__ float wave_sum_dpp(float v) {
    v += __builtin_bit_cast(float, __builtin_amdgcn_update_dpp(0, __builtin_bit_cast(int, v), 0xB1, 0xF, 0xF, true));
    v += __builtin_bit_cast(float, __builtin_amdgcn_update_dpp(0, __builtin_bit_cast(int, v), 0x4E, 0xF, 0xF, true));
    v += __builtin_bit_cast(float, __builtin_amdgcn_update_dpp(0, __builtin_bit_cast(int, v), 0x141, 0xF, 0xF, true));
    v += __builtin_bit_cast(float, __builtin_amdgcn_update_dpp(0, __builtin_bit_cast(int, v), 0x140, 0xF, 0xF, true));
    const int iv = __builtin_bit_cast(int, v);
    return (__builtin_bit_cast(float, __builtin_amdgcn_readlane(iv, 0)) + __builtin_bit_cast(float, __builtin_amdgcn_readlane(iv, 16))) +
           (__builtin_bit_cast(float, __builtin_amdgcn_readlane(iv, 32)) + __builtin_bit_cast(float, __builtin_amdgcn_readlane(iv, 48)));
}
constexpr int RX_STRIDE = 2064, RX_H = 0, RX_L = 16 * RX_STRIDE, RX_PART = 2 * 16 * RX_STRIDE, RX_LOG = RX_PART + 8 * 2 * 1024, RX_END = RX_LOG + 2048;
static_assert(RX_END <= RING_BYTES, "router LDS");
__device__ __forceinline__ void ln_router_phase(Frame& F, int l, int cnt_off, const float* router_w, const float* router_b, const float* ln1_g, const float* ln1_b) {
    LAS unsigned char* L = F.lds;
    LAS int* LCNT = (LAS int*)(F.lds + LCNT_OFF); LAS int* LBASE = (LAS int*)(F.lds + LBASE_OFF); LAS int* LSEL = (LAS int*)(F.lds + LSEL_OFF);
    const int tid = F.tid, lane = F.lane, w = F.wave, l15 = lane & 15, rq = lane >> 4;
    const bf16* Z = WSP(bf16, WS_Z); bf16* X1b = WSP(bf16, WS_X1B); float* st1 = WSP(float, WS_ST1);
    int* selinfo = WSP(int, WS_SEL); float* gates = (float*)(selinfo + (size_t)T * 4); int* tok_list = WSP(int, WS_TOK);
    unsigned* cnt = F.ctl + CW_CNT + cnt_off + l * NE;
    const float* lg = ln1_g + (size_t)l * DM; const float* lb = ln1_b + (size_t)l * DM;
    f32x4 gv[4], bv[4];
#pragma unroll
    for (int j = 0; j < 4; ++j) { gv[j] = *(const f32x4*)(lg + 4 * lane + 256 * j); bv[j] = *(const f32x4*)(lb + 4 * lane + 256 * j); }
    bf16x8 Bh[4][2], Bl[4][2];
    { const float* rw = router_w + (size_t)l * DM * NE;
#pragma unroll
      for (int ks = 0; ks < 4; ++ks)
#pragma unroll
          for (int et = 0; et < 2; ++et) { float x[8];
#pragma unroll
              for (int j = 0; j < 8; ++j) x[j] = rw[(size_t)(128 * w + 32 * ks + 8 * rq + j) * NE + 16 * et + l15];
              u32x4 h, lo;
#pragma unroll
              for (int p = 0; p < 4; ++p) { const unsigned hp = cvt_pk_bf16(x[2 * p], x[2 * p + 1]); h[p] = hp; lo[p] = cvt_pk_bf16(x[2 * p] - bf_lo(hp), x[2 * p + 1] - bf_hi(hp)); }
              Bh[ks][et] = __builtin_bit_cast(bf16x8, h); Bl[ks][et] = __builtin_bit_cast(bf16x8, lo); } }
    const float rbias = router_b[(size_t)l * NE + (lane & 31)];
    for (int chunk = F.bid; chunk < T / 128; chunk += F.G) {
        if (tid < 32) LCNT[tid] = 0;
        __syncthreads();
        const size_t cbase = (size_t)chunk * 128;
        u32x2 nx[4];
#pragma unroll
        for (int j = 0; j < 4; ++j) nx[j] = *(const u32x2*)(Z + (cbase + 2 * w) * DM + 4 * lane + 256 * j);
#pragma unroll 1
        for (int r = 0; r < 8; ++r) {
#pragma unroll
            for (int q = 0; q < 2; ++q) { const int tl = 16 * r + 2 * w + q; const size_t t = cbase + tl;
                f32x4 v[4]; float s = 0.f;
#pragma unroll
                for (int j = 0; j < 4; ++j) { v[j] = (f32x4){bf_lo(nx[j].x), bf_hi(nx[j].x), bf_lo(nx[j].y), bf_hi(nx[j].y)}; s += (v[j][0] + v[j][1]) + (v[j][2] + v[j][3]); }
                { const int tn = q == 0 ? tl + 1 : (r < 7 ? tl + 15 : tl);
#pragma unroll
                  for (int j = 0; j < 4; ++j) nx[j] = *(const u32x2*)(Z + (cbase + tn) * DM + 4 * lane + 256 * j); }
                const float mean = wave_sum_dpp(s) * (1.0f / DM); float s2 = 0.f;
#pragma unroll
                for (int j = 0; j < 4; ++j) { v[j] = v[j] - mean; s2 += (v[j][0] * v[j][0] + v[j][1] * v[j][1]) + (v[j][2] * v[j][2] + v[j][3] * v[j][3]); }
                const float rstd = 1.0f / sqrtf(wave_sum_dpp(s2) * (1.0f / DM) + LN_EPS);
                if (lane == 0) *(f32x2*)(st1 + t * 2) = (f32x2){mean, rstd};
#pragma unroll
                for (int j = 0; j < 4; ++j) { v[j] = v[j] * rstd * gv[j] + bv[j];
                    if (MOE_FP8) *(unsigned*)((unsigned char*)X1b + t * DM + 4 * lane + 256 * j) = cvt4_fp8(v[j][0] * 4.0f, v[j][1] * 4.0f, v[j][2] * 4.0f, v[j][3] * 4.0f);
                    else { u32x2 wv; wv.x = cvt_pk_bf16(v[j][0], v[j][1]); wv.y = cvt_pk_bf16(v[j][2], v[j][3]); *(u32x2*)(X1b + t * DM + 4 * lane + 256 * j) = wv; }
                    u32x2 h, lo; h.x = cvt_pk_bf16(v[j][0], v[j][1]); h.y = cvt_pk_bf16(v[j][2], v[j][3]);
                    lo.x = cvt_pk_bf16(v[j][0] - bf_lo(h.x), v[j][1] - bf_hi(h.x)); lo.y = cvt_pk_bf16(v[j][2] - bf_lo(h.y), v[j][3] - bf_hi(h.y));
                    *(LAS u32x2*)(L + RX_H + (2 * w + q) * RX_STRIDE + (4 * lane + 256 * j) * 2) = h; *(LAS u32x2*)(L + RX_L + (2 * w + q) * RX_STRIDE + (4 * lane + 256 * j) * 2) = lo; } }
            __syncthreads();
            f32x4 acc[2] = {(f32x4){0.f, 0.f, 0.f, 0.f}, (f32x4){0.f, 0.f, 0.f, 0.f}};
#pragma unroll
            for (int ks = 0; ks < 4; ++ks) {
                const bf16x8 ah = *(const LAS bf16x8*)(L + RX_H + l15 * RX_STRIDE + (128 * w + 32 * ks + 8 * rq) * 2), al = *(const LAS bf16x8*)(L + RX_L + l15 * RX_STRIDE + (128 * w + 32 * ks + 8 * rq) * 2);
#pragma unroll
                for (int et = 0; et < 2; ++et) { acc[et] = __builtin_amdgcn_mfma_f32_16x16x32_bf16(ah, Bh[ks][et], acc[et], 0, 0, 0); acc[et] = __builtin_amdgcn_mfma_f32_16x16x32_bf16(ah, Bl[ks][et], acc[et], 0, 0, 0);
                    acc[et] = __builtin_amdgcn_mfma_f32_16x16x32_bf16(al, Bh[ks][et], acc[et], 0, 0, 0); } }
            *(LAS f32x4*)(L + RX_PART + ((w * 2 + 0) * 64 + lane) * 16) = acc[0]; *(LAS f32x4*)(L + RX_PART + ((w * 2 + 1) * 64 + lane) * 16) = acc[1];
            __syncthreads();
            { const int tk = 2 * w + (lane >> 5), e = lane & 31, src = ((e >> 4) * 64 + (tk >> 2) * 16 + (e & 15)) * 16 + (tk & 3) * 4; float sum = rbias;
#pragma unroll
              for (int v8 = 0; v8 < 8; ++v8) sum += *(const LAS float*)(L + RX_PART + v8 * 2048 + src);
              *(LAS float*)(L + RX_LOG + (tk * 32 + e) * 4) = sum; }
            LDS_WAIT();
            if ((lane & 31) == 0) {
                const int tk = 2 * w + (lane >> 5), tl = 16 * r + tk; const size_t t = cbase + tl;
                float v0 = -INFINITY, v1 = -INFINITY, v2 = -INFINITY, v3 = -INFINITY; int e0 = 0, e1 = 0, e2 = 0, e3 = 0;
#pragma unroll
                for (int q4 = 0; q4 < 8; ++q4) { const f32x4 lv = *(const LAS f32x4*)(L + RX_LOG + (tk * 32 + 4 * q4) * 4);
#pragma unroll
                    for (int jj = 0; jj < 4; ++jj) { const float x = lv[jj]; const int e = 4 * q4 + jj;
                        const bool c0 = x > v0, c1 = x > v1, c2 = x > v2, c3 = x > v3;
                        v3 = c2 ? v2 : (c3 ? x : v3); e3 = c2 ? e2 : (c3 ? e : e3);
                        v2 = c1 ? v1 : (c2 ? x : v2); e2 = c1 ? e1 : (c2 ? e : e2);
                        v1 = c0 ? v0 : (c1 ? x : v1); e1 = c0 ? e0 : (c1 ? e : e1);
                        v0 = c0 ? x : v0; e0 = c0 ? e : e0; } }
                const float p1 = __expf(v1 - v0), p2 = __expf(v2 - v0), p3 = __expf(v3 - v0), inv = 1.0f / (1.0f + p1 + p2 + p3);
                const int te[4] = {e0, e1, e2, e3};
#pragma unroll
                for (int k = 0; k < 4; ++k) { const int lp = __hip_atomic_fetch_add(&LCNT[te[k]], 1, __ATOMIC_RELAXED, __HIP_MEMORY_SCOPE_WORKGROUP); LSEL[tl * 4 + k] = (te[k] << 16) | lp; }
                *(f32x4*)(gates + t * 4) = (f32x4){inv, p1 * inv, p2 * inv, p3 * inv};
            }
        }
        __syncthreads();
        if (tid < 32) LBASE[tid] = (int)__hip_atomic_fetch_add(cnt + tid, (unsigned)LCNT[tid], __ATOMIC_RELAXED, __HIP_MEMORY_SCOPE_AGENT);
        __syncthreads();
        { const int sidx = tid, v = LSEL[sidx], e = v >> 16, pos = LBASE[e] + (v & 0xffff); const int t = chunk * 128 + (sidx >> 2);
          tok_list[(size_t)e * T + pos] = t; selinfo[(size_t)t * 4 + (sidx & 3)] = (e << 16) | pos; }
        __syncthreads();
    }
}

__device__ __forceinline__ void moe_tables(Frame& F, int l, bool fill_idx, int nN) {
    LAS int* TS = (LAS int*)(F.lds + TSTART_OFF); LAS int* LC = (LAS int*)(F.lds + LCNT_OFF); LAS int* IDX = (LAS int*)(F.lds + IDX_OFF);
    const unsigned* cnt = F.ctl + CW_CNT + l * NE;
    __syncthreads();
    if (F.tid < 64) {
        const int e = F.tid & 31; const int c = (int)__hip_atomic_load(cnt + e, __ATOMIC_RELAXED, __HIP_MEMORY_SCOPE_AGENT); const int tl = (c + 255) >> 8;
        int inc = tl;
#pragma unroll
        for (int o = 1; o < 32; o <<= 1) { const int y = __shfl_up(inc, o, 32); if (e >= o) inc += y; }
        if (F.tid < 32) { LC[e] = c; TS[e] = inc - tl; if (e == 31) TS[32] = inc; } }
    __syncthreads();
    if (fill_idx) {
        const int* tok_list = WSP(int, WS_TOK); const int ntile = TS[32];
        int tv[IDX_SLOTS];
#pragma unroll
        for (int s = 0; s < IDX_SLOTS; ++s) { int mtg, pn_; pg8::moe_unit_map(s, F.bid, nN, F.G, mtg, pn_); tv[s] = 0;
            if (mtg < ntile && F.tid < 256) { int e = 0; for (int k = 1; k < 32; ++k) e += (TS[k] <= mtg) ? 1 : 0;
                const int r = (mtg - TS[e]) * 256 + F.tid; if (r < LC[e]) tv[s] = tok_list[(size_t)e * T + r]; } }
        if (F.tid < 256) {
#pragma unroll
            for (int s = 0; s < IDX_SLOTS; ++s) IDX[s * 256 + F.tid] = tv[s]; }
        __syncthreads();
    }
}

#if MOE_FP8
typedef unsigned YR_T;
#define YR_LOAD(row_, j_) __builtin_nontemporal_load((const unsigned*)((const unsigned char*)Yr + (row_) * DM + 4 * lane + 256 * (j_)))
#else
typedef u32x2 YR_T;
#define YR_LOAD(row_, j_) (*(const u32x2*)(Yr + (row_) * DM + 4 * lane + 256 * (j_)))
#endif
__device__ __forceinline__ void combine_phase(Frame& F, int l, float* Xo, const float* ln1_g, const float* ln1_b, const float* ln2_g, const float* ln2_b) {
    LAS int* TS = (LAS int*)(F.lds + TSTART_OFF);
    const int lane = F.lane;
    const bf16* Z = WSP(bf16, WS_Z); const float* st1 = WSP(float, WS_ST1); const bf16* Yr = WSP(bf16, WS_YRAW);
    const int* selinfo = WSP(int, WS_SEL); const float* gates = (const float*)(selinfo + (size_t)T * 4);
    bf16* Xb = WSP(bf16, WS_XB);
    const float* lg1 = ln1_g + (size_t)l * DM; const float* lb1 = ln1_b + (size_t)l * DM; const float* lg = ln2_g + (size_t)l * DM; const float* lb = ln2_b + (size_t)l * DM;
    f32x4 gv[4], bv[4], g1v[4], b1v[4];
#pragma unroll
    for (int j = 0; j < 4; ++j) { gv[j] = *(const f32x4*)(lg + 4 * lane + 256 * j); bv[j] = *(const f32x4*)(lb + 4 * lane + 256 * j); g1v[j] = *(const f32x4*)(lg1 + 4 * lane + 256 * j); b1v[j] = *(const f32x4*)(lb1 + 4 * lane + 256 * j); }
    const int tfirst = F.bid * NWAVES + F.wave, tstep = F.G * NWAVES;
    const int ntok = (T - tfirst + tstep - 1) / tstep;
    i32x4 si_n; f32x4 gt_n;
    u32x2 zr[4]; YR_T yr[4][4]; f32x2 ms; f32x4 gt_c;
    { const i32x4 s0 = *(const i32x4*)(selinfo + (size_t)tfirst * 4); gt_c = *(const f32x4*)(gates + (size_t)tfirst * 4); ms = *(const f32x2*)(st1 + (size_t)tfirst * 2);
#pragma unroll
      for (int j = 0; j < 4; ++j) zr[j] = __builtin_nontemporal_load((const u32x2*)(Z + (size_t)tfirst * DM + 4 * lane + 256 * j));
#pragma unroll
      for (int k = 0; k < 4; ++k) { const size_t row = (size_t)TS[s0[k] >> 16] * 256 + (s0[k] & 0xffff);
#pragma unroll
          for (int j = 0; j < 4; ++j) yr[k][j] = YR_LOAD(row, j); }
      const int t1 = tfirst + tstep < T ? tfirst + tstep : tfirst; si_n = *(const i32x4*)(selinfo + (size_t)t1 * 4); gt_n = *(const f32x4*)(gates + (size_t)t1 * 4); }
    for (int i = 0; i < ntok; ++i) {
        const int t = tfirst + i * tstep;
        f32x4 v[4];
#pragma unroll
        for (int j = 0; j < 4; ++j) { const f32x4 zf = (f32x4){bf_lo(zr[j].x), bf_hi(zr[j].x), bf_lo(zr[j].y), bf_hi(zr[j].y)};
            v[j] = ((zf - ms.x) * ms.y * g1v[j] + b1v[j]) * DN_ALPHA; }
#pragma unroll
        for (int k = 0; k < 4; ++k)
#pragma unroll
            for (int j = 0; j < 4; ++j) {
#if MOE_FP8
                const int y = (int)yr[k][j]; const float gt = gt_c[k] * (1.0f / 16.0f);
                v[j][0] += gt * __builtin_amdgcn_cvt_f32_fp8(y, 0); v[j][1] += gt * __builtin_amdgcn_cvt_f32_fp8(y, 1); v[j][2] += gt * __builtin_amdgcn_cvt_f32_fp8(y, 2); v[j][3] += gt * __builtin_amdgcn_cvt_f32_fp8(y, 3);
#else
                const u32x2 y = yr[k][j]; const float gt = gt_c[k];
                v[j][0] += gt * bf_lo(y.x); v[j][1] += gt * bf_hi(y.x); v[j][2] += gt * bf_lo(y.y); v[j][3] += gt * bf_hi(y.y);
#endif
            }
        if (i + 1 < ntok) { const int tn = t + tstep; const i32x4 s1 = si_n; gt_c = gt_n; ms = *(const f32x2*)(st1 + (size_t)tn * 2);
#pragma unroll
            for (int j = 0; j < 4; ++j) zr[j] = __builtin_nontemporal_load((const u32x2*)(Z + (size_t)tn * DM + 4 * lane + 256 * j));
#pragma unroll
            for (int k = 0; k < 4; ++k) { const size_t row = (size_t)TS[s1[k] >> 16] * 256 + (s1[k] & 0xffff);
#pragma unroll
                for (int j = 0; j < 4; ++j) yr[k][j] = YR_LOAD(row, j); }
            const int t2 = tn + tstep < T ? tn + tstep : tn; si_n = *(const i32x4*)(selinfo + (size_t)t2 * 4); gt_n = *(const f32x4*)(gates + (size_t)t2 * 4); }
        float s = 0.f;
#pragma unroll
        for (int j = 0; j < 4; ++j) s += (v[j][0] + v[j][1]) + (v[j][2] + v[j][3]);
        const float mean = wave_sum_dpp(s) * (1.0f / DM); float s2 = 0.f;
#pragma unroll
        for (int j = 0; j < 4; ++j) { v[j] = v[j] - mean; s2 += (v[j][0] * v[j][0] + v[j][1] * v[j][1]) + (v[j][2] * v[j][2] + v[j][3] * v[j][3]); }
        const float rstd = 1.0f / sqrtf(wave_sum_dpp(s2) * (1.0f / DM) + LN_EPS);
#pragma unroll
        for (int j = 0; j < 4; ++j) { v[j] = v[j] * rstd * gv[j] + bv[j];
            if (Xo) *(f32x4*)(Xo + (size_t)t * DM + 4 * lane + 256 * j) = v[j];
            if (!Xo) { u32x2 wv; wv.x = cvt_pk_bf16(v[j][0], v[j][1]); wv.y = cvt_pk_bf16(v[j][2], v[j][3]); *(u32x2*)(Xb + (size_t)t * DM + 4 * lane + 256 * j) = wv; }
            if (INPROJ_FP8 && !Xo) *(unsigned*)(WSP(unsigned char, WS_XQ) + (size_t)t * DM + 4 * lane + 256 * j) = cvt4_fp8(v[j][0] * 4.0f, v[j][1] * 4.0f, v[j][2] * 4.0f, v[j][3] * 4.0f); }
    }
}

constexpr int NPH = 8, N_PHASES = 1 + NL * NPH;
struct Args { const float* in[19]; float* out; unsigned char* ws; int ph_lo, ph_hi; };
static_assert(sizeof(Args) == 19 * 8 + 8 + 8 + 8, "Args has no padding");

__global__ void __launch_bounds__(NTHREADS, 2) mk_fwd(Args args) {
    extern __shared__ __attribute__((aligned(16))) unsigned char lds_raw[];
    Frame F;
    F.lds = (LAS unsigned char*)lds_raw; F.MISC = (volatile LAS unsigned*)(F.lds + MISC_OFF);
    F.tid = threadIdx.x; F.lane = F.tid & 63; F.wave = __builtin_amdgcn_readfirstlane(F.tid >> 6); F.G = gridDim.x; F.bid = blockIdx.x;
    F.ws = args.ws; F.ctl = (unsigned*)(args.ws + WS_CTL);
    if (F.tid < 16) F.MISC[F.tid] = 0u;
    __syncthreads();
    XcdBarrier bar; bar.bar = F.ctl + CW_BAR; bar.x = 0; bar.st = nullptr;
    if (MK_N_LAUNCHES == 1) bar = xcd_barrier_post(F.ctl + CW_BAR, F.MISC + 8);
    const int lo = args.ph_lo, hi = args.ph_hi;
#ifndef PH_MASK
#define PH_MASK 0x1ff
#endif
#define PHON(p) ((PH_MASK >> (p)) & 1)
#ifndef PROBE_DUP
#define PROBE_DUP 0
#endif
#define DUP(p) for (int rep_ = 0; rep_ < 1 + ((PROBE_DUP >> (p)) & 1); ++rep_, frame_refresh(F))
#define IN(k) (lo <= (k) && (k) < hi)
#define REFRESH() frame_refresh(F)
#ifndef PROBE_BAR2
#define PROBE_BAR2 0
#endif
#define SEAM(k) do { if (IN((k) + 1)) { if (MK_N_LAUNCHES == 1) { xcd_barrier(bar); if (PROBE_BAR2) xcd_barrier(bar); } } } while (0)

    if (PHON(8) && IN(0)) { REFRESH(); DUP(8) p0_prologue(F, args.in[0], args.in[1], args.in[2], args.in[7], args.in[8], args.in[5], args.in[13], args.in[15]); SEAM(0); }

    for (int l = 0; l < NL; ++l) {
        const int pb = 1 + l * NPH;
        int z = 0; asm volatile("" : "+s"(z));
#define ARGP(i) (args.in[(i) + z])
        if (PHON(0) && IN(pb + 0)) { REFRESH(); DUP(0) {
            pg8::InProjSched S{INPROJ_FP8 ? (const char*)WSP(unsigned char, WS_XQ) : (const char*)WSP(bf16, WS_XB), (const char*)WSP(unsigned char, WS_WIN) + (size_t)l * INW * DM * (INPROJ_FP8 ? 1 : 2), INPROJ_FP8 ? DM : 2 * DM, F.G, F.bid};
            EpiInProj E{WSP(bf16, WS_P), WSP(bf16, WS_ROPEB), WSP(unsigned char, WS_PG8)};
            pg8::gemm_phase<EpiInProj, pg8::InProjSched, false, true, F8_SP2 != 0, INPROJ_FP8 != 0>(F.lds, INPROJ_FP8 ? DM : 2 * DM, S, E); }
            SEAM(pb + 0);
        }
        if (PHON(1) && IN(pb + 1)) { REFRESH();
            DUP(1) {
#ifndef NO_RET
                if (F.bid < 192) for (int r2 = 0; r2 < 1 + ((PROBE_DUP >> 10) & 1); ++r2, frame_refresh(F)) ret_prepass(F, (F.bid / 3) >> 2, (F.bid / 3) & 3, F.bid % 3);
#endif
#ifndef NO_SGU
                for (int r2 = 0; r2 < 1 + ((PROBE_DUP >> 9) & 1); ++r2, frame_refresh(F)) sgu_unit(F, F.bid, l, ARGP(6), ARGP(3), ARGP(4));
#endif
                if (MK_N_LAUNCHES == 1) xcd_barrier(bar);
                REFRESH();
#ifndef NO_RET
                for (int r2 = 0; r2 < 1 + ((PROBE_DUP >> 11) & 1); ++r2, frame_refresh(F)) ret_unit(F, F.bid >> 4, (F.bid >> 2) & 3, F.bid & 3);
#endif
            }
            SEAM(pb + 1);
        }
        if (PHON(2) && IN(pb + 2)) { REFRESH(); DUP(2) {
            { pg8::DenseSched S; S.init(WSP(bf16, WS_YRET), WSP(bf16, WS_PRET) + (size_t)l * DM * DM, T, DM, DM, F.G, F.bid);
              EpiGate1 E{WSP(bf16, WS_P), WSP(bf16, WS_HF), WSP(unsigned char, WS_PG8)};
              pg8::gemm_phase<EpiGate1, pg8::DenseSched, false, true, true>(F.lds, 2 * DM, S, E); }
            { pg8::DenseSched S; S.init(WSP(bf16, WS_YSG), WSP(bf16, WS_PSG) + (size_t)l * DM * DM, T, DM, DM, F.G, F.bid);
              EpiGate2 E{WSP(bf16, WS_P), WSP(bf16, WS_HF), WSP(bf16, WS_HB), WSP(unsigned char, WS_PG8)};
              pg8::gemm_phase<EpiGate2, pg8::DenseSched, false, true, true>(F.lds, 2 * DM, S, E); } }
            SEAM(pb + 2);
        }
        if (PHON(3) && IN(pb + 3)) { REFRESH(); DUP(3) {
            pg8::DenseSched S; S.init(WSP(bf16, WS_HB), WSP(bf16, WS_WO) + (size_t)l * DM * DM, T, DM, DM, F.G, F.bid);
            EpiResid E{(l == 0) ? ARGP(0) : (const float*)nullptr, WSP(bf16, WS_XB), WSP(bf16, WS_Z)};
            pg8::gemm_phase<EpiResid, pg8::DenseSched, false, true, true>(F.lds, 2 * DM, S, E); }
            SEAM(pb + 3);
        }
        if (PHON(4) && IN(pb + 4)) { REFRESH();
#if (PROBE_DUP >> 4) & 1
            ln_router_phase(F, l, 128, ARGP(11), ARGP(12), ARGP(9), ARGP(10)); xcd_barrier(bar); REFRESH();
#endif
            ln_router_phase(F, l, 0, ARGP(11), ARGP(12), ARGP(9), ARGP(10)); SEAM(pb + 4); }
        if (PHON(5) && IN(pb + 5)) { REFRESH(); DUP(5) {
            moe_tables(F, l, true, 2 * DEXP / 256);
            constexpr int EB = MOE_FP8 ? 1 : 2;
            pg8::MoeSched<true> S{(const char*)WSP(bf16, WS_X1B), (const char*)WSP(unsigned char, WS_W1) + (size_t)l * NE * 2 * DEXP * DM * EB, DM * EB, 2 * DEXP, 2 * DEXP / 256, F.G, F.bid,
                                  (const LAS int*)(F.lds + TSTART_OFF), (const LAS int*)(F.lds + IDX_OFF)};
            EpiSwiglu E{WSP(bf16, WS_ACT), ARGP(14) + (size_t)l * NE * 2 * DEXP, F.lds};
            pg8::gemm_phase<EpiSwiglu, pg8::MoeSched<true>, true, true, F8_SP2 != 0, MOE_FP8 != 0>(F.lds, DM * EB, S, E); }
            SEAM(pb + 5);
        }
        if (PHON(6) && IN(pb + 6)) { REFRESH(); DUP(6) {
            moe_tables(F, l, false, DM / 256);
            constexpr int EB = MOE_FP8 ? 1 : 2;
            pg8::MoeSched<false> S{(const char*)WSP(bf16, WS_ACT), (const char*)WSP(unsigned char, WS_W2) + (size_t)l * NE * DM * DEXP * EB, DEXP * EB, DM, DM / 256, F.G, F.bid,
                                   (const LAS int*)(F.lds + TSTART_OFF), (const LAS int*)(F.lds + IDX_OFF)};
            EpiBias E{WSP(bf16, WS_YRAW), ARGP(16) + (size_t)l * NE * DM, F.lds};
            pg8::gemm_phase<EpiBias, pg8::MoeSched<false>, false, true, F8_SP2 != 0, MOE_FP8 != 0>(F.lds, DEXP * EB, S, E); }
            SEAM(pb + 6);
        }
        if (PHON(7) && IN(pb + 7)) { REFRESH(); moe_tables(F, l, false, 1); DUP(7) combine_phase(F, l, (l == NL - 1) ? args.out : (float*)nullptr, ARGP(9), ARGP(10), ARGP(17), ARGP(18)); SEAM(pb + 7); }
    }
#undef IN
#undef SEAM
#undef ARGP
#undef REFRESH
}

extern "C" void kernel_launch(void* const* d_in, const int* in_sizes, int n_in, void* d_out, int out_size, void* d_ws, size_t ws_size, hipStream_t stream) {
    static int grid = 0;
    if (grid == 0) {
        if (n_in != 19 || in_sizes[0] != T * DM || out_size != T * DM || ws_size < WS_END) { fprintf(stderr, "kernel_launch: unexpected shapes (n_in %d, in0 %d, out %d, ws %zu)\n", n_in, n_in > 0 ? in_sizes[0] : -1, out_size, ws_size); grid = -1; return; }
        int dev = 0, cus = 0, per_cu = 0;
        if (hipGetDevice(&dev) != hipSuccess || hipDeviceGetAttribute(&cus, hipDeviceAttributeMultiprocessorCount, dev) != hipSuccess) { fprintf(stderr, "kernel_launch: device query failed\n"); grid = -1; return; }
        if (hipFuncSetAttribute((const void*)mk_fwd, hipFuncAttributeMaxDynamicSharedMemorySize, LDS_BYTES) != hipSuccess) { fprintf(stderr, "kernel_launch: hipFuncSetAttribute failed\n"); grid = -1; return; }
        if (hipOccupancyMaxActiveBlocksPerMultiprocessor(&per_cu, (const void*)mk_fwd, NTHREADS, LDS_BYTES) != hipSuccess || per_cu < 1) fprintf(stderr, "kernel_launch: occupancy query reports %d blocks per CU\n", per_cu);
        (void)hipGetLastError();
        grid = cus < 256 ? cus : 256;
        if (grid != 256) fprintf(stderr, "kernel_launch: %d CUs; the MoE row tables assume 256 workgroups\n", grid);
    }
    if (grid < 0) return;
    (void)hipMemsetAsync((char*)d_ws + WS_CTL, 0, CTL_ZERO_BYTES, stream);
    Args a{};
    for (int i = 0; i < 19; ++i) a.in[i] = (const float*)d_in[i];
    a.out = (float*)d_out; a.ws = (unsigned char*)d_ws;
    if (MK_N_LAUNCHES == 1) {
        a.ph_lo = 0; a.ph_hi = N_PHASES;
        hipLaunchKernelGGL(mk_fwd, dim3(grid), dim3(NTHREADS), LDS_BYTES, stream, a);
    } else {
        for (int p = 0; p < N_PHASES; ++p) { a.ph_lo = p; a.ph_hi = p + 1; hipLaunchKernelGGL(mk_fwd, dim3(grid), dim3(NTHREADS), LDS_BYTES, stream, a); }
    }
    const hipError_t le = hipPeekAtLastError();
    if (le != hipSuccess) fprintf(stderr, "kernel_launch: launch failed: %s\n", hipGetErrorName(le));
}
```

```cpp
#include <hip/hip_runtime.h>
#include <cstdio>
#include <cstdint>

#ifndef MK_N_LAUNCHES
#define MK_N_LAUNCHES 1
#endif

#ifndef INPROJ_FP8
#define INPROJ_FP8 1
#endif
#ifndef GATE_U8
#define GATE_U8 1
#endif
#ifndef F8_SP2B
#define F8_SP2B 1
#endif
#ifndef F8_SP2
#define F8_SP2 0
#endif
#ifndef MOE_FP8
#define MOE_FP8 1
#endif
#define LAS __attribute__((address_space(3)))
#define GAS __attribute__((address_space(1)))
typedef unsigned short bf16;
typedef short bf16x8 __attribute__((ext_vector_type(8)));
typedef short s16x4 __attribute__((ext_vector_type(4)));
typedef float f32x4 __attribute__((ext_vector_type(4)));
typedef float f32x2 __attribute__((ext_vector_type(2)));
typedef unsigned u32x4 __attribute__((ext_vector_type(4)));
typedef unsigned u32x2 __attribute__((ext_vector_type(2)));
typedef int i32x4 __attribute__((ext_vector_type(4)));
typedef GAS unsigned gu32;

constexpr int DM = 1024, NBATCH = 16, SEQ = 2048, T = NBATCH * SEQ, NL = 4;
constexpr int INW = 7168, NE = 32, TOPK = 4, DEXP = 1024;
constexpr int C_Q = 0, C_K = 512, C_V = 1024, C_G = 2048, C_U = 3072, C_VS = 4096, C_GA = 5120, C_GB = 6144;
constexpr float LN_EPS = 1e-5f, DN_ALPHA = 1.681792830507429f;
constexpr int AROWS = T * TOPK + NE * 256;
constexpr int NWAVES = 8, NTHREADS = 512;

constexpr size_t MiB = 1u << 20;
constexpr size_t WS_CTL = 0, CTL_ZERO_BYTES = 65536;
constexpr size_t WS_ST1 = 256 * 1024;
constexpr size_t WS_ROPE = 1 * MiB;
constexpr size_t WS_ROPEB = (1944 + 100) * MiB;
constexpr size_t WS_SEL = 2 * MiB;
constexpr size_t WS_TOK = 3 * MiB;
constexpr size_t WS_SGW = 7 * MiB;
constexpr size_t WS_WIN = 8 * MiB;
constexpr size_t WS_PRET = 64 * MiB, WS_PSG = 72 * MiB, WS_WO = 80 * MiB;
constexpr size_t WS_W1 = 88 * MiB;
constexpr size_t WS_W2 = 600 * MiB;
constexpr size_t WS_XF = 856 * MiB;
constexpr size_t WS_XB = 984 * MiB;
constexpr size_t WS_XQ = 856 * MiB;
constexpr size_t WS_P = 1048 * MiB;
constexpr size_t WS_YRET = 1496 * MiB, WS_YSG = 1560 * MiB;
constexpr size_t WS_HF = 1624 * MiB;
constexpr size_t WS_HB = 1752 * MiB;
constexpr size_t WS_Z = 1816 * MiB;
constexpr size_t WS_X1F = 1944 * MiB;
constexpr size_t WS_PG8 = (1944 + 32) * MiB;
constexpr size_t WS_X1B = 2072 * MiB;
constexpr size_t WS_ACT = 2136 * MiB;
constexpr size_t WS_YRAW = 2408 * MiB;
constexpr size_t WS_END = 2680 * MiB;
static_assert((size_t)AROWS * 1024 * 2 <= 272 * MiB, "expert row buffers");
constexpr int CW_TMO = 0, CW_CODE = 1, CW_BAR = 4096, CW_CNT = 8192;

constexpr int RING_BYTES = 131072;
constexpr int IDX_OFF = RING_BYTES, IDX_SLOTS = 18;
constexpr int TSTART_OFF = IDX_OFF + IDX_SLOTS * 1024;
constexpr int LCNT_OFF = TSTART_OFF + 256, LBASE_OFF = LCNT_OFF + 128, LSEL_OFF = LBASE_OFF + 128;
constexpr int MISC_OFF = LSEL_OFF + 2048;
constexpr int LDS_BYTES = 163840;
static_assert(MISC_OFF + 64 <= LDS_BYTES, "LDS map");

#define RLX_AGENT __ATOMIC_RELAXED, __HIP_MEMORY_SCOPE_AGENT
#define LDS_WAIT() asm volatile("s_waitcnt lgkmcnt(0)" ::: "memory")
#define VM_WAIT() asm volatile("s_waitcnt vmcnt(0)" ::: "memory")
__device__ __forceinline__ unsigned cvt_pk_bf16(float lo, float hi) { unsigned r; asm volatile("v_cvt_pk_bf16_f32 %0, %1, %2" : "=v"(r) : "v"(lo), "v"(hi)); return r; }
__device__ __forceinline__ unsigned cvt4_fp8(float a, float b, float c, float d) { int w = __builtin_amdgcn_cvt_pk_fp8_f32(a, b, 0, false); w = __builtin_amdgcn_cvt_pk_fp8_f32(c, d, w, true); return (unsigned)w; }
__device__ __forceinline__ void unpack8_u8(const u32x2 w, f32x4& a, f32x4& b) {
    a = (f32x4){(float)(w.x & 0xffu), (float)((w.x >> 8) & 0xffu), (float)((w.x >> 16) & 0xffu), (float)(w.x >> 24)} * (1.0f / 255.0f);
    b = (f32x4){(float)(w.y & 0xffu), (float)((w.y >> 8) & 0xffu), (float)((w.y >> 16) & 0xffu), (float)(w.y >> 24)} * (1.0f / 255.0f); }
__device__ __forceinline__ unsigned pack4_u8(const f32x4 s) { return (unsigned)(s[0] * 255.0f + 0.5f) | ((unsigned)(s[1] * 255.0f + 0.5f) << 8) | ((unsigned)(s[2] * 255.0f + 0.5f) << 16) | ((unsigned)(s[3] * 255.0f + 0.5f) << 24); }
__device__ __forceinline__ float bf_lo(unsigned w) { return __uint_as_float(w << 16); }
__device__ __forceinline__ float bf_hi(unsigned w) { return __uint_as_float(w & 0xffff0000u); }
__device__ __forceinline__ float sigmoidf_(float x) { return __builtin_amdgcn_rcpf(1.0f + __builtin_amdgcn_exp2f(x * -1.4426950408889634f)); }
__device__ __forceinline__ float siluf_(float x) { return x * sigmoidf_(x); }
__device__ __forceinline__ float geluf_(float x) { return x * sigmoidf_(1.5957691216057308f * (x + 0.044715f * x * x * x)); }
__device__ __forceinline__ float lg2_gamma(int h) { return h == 0 ? -0.04580368961312479f : h == 1 ? -0.018003552928331026f : h == 2 ? -0.007117849617096985f : -0.0028205190623786626f; }
__device__ __forceinline__ int opaque_tid() { int t = threadIdx.x; asm volatile("" : "+v"(t)); return t; }
__device__ __forceinline__ float wave_sum(float v) {
#pragma unroll
    for (int o = 1; o < 64; o <<= 1) v += __shfl_xor(v, o);
    return v;
}

#define XB_TMO      128
#define XB_XCNT(j)  (256  + 64 * (j))
#define XB_XSUB(j)  (1280 + 64 * (j))
#define XB_XGEN(j)  (2304 + 64 * (j))
#define XB_TOP      3328
#define XB_TOPGEN   3392
#define XCD_BAR_WORDS 3456
#define XB_SPIN_CAP (1u << 18)
__device__ __forceinline__ unsigned xb_ld(unsigned* p)              { return __hip_atomic_load(p, __ATOMIC_RELAXED, __HIP_MEMORY_SCOPE_AGENT); }
__device__ __forceinline__ unsigned xb_add(unsigned* p, unsigned v) { return __hip_atomic_fetch_add(p, v, __ATOMIC_RELAXED, __HIP_MEMORY_SCOPE_AGENT); }
__device__ __forceinline__ unsigned xb_xcc_id() { return (unsigned)__builtin_amdgcn_s_getreg((3 << 11) | 20) & 0xFu; }
#define XB_SPIN(cond, bar) do { unsigned _sp = 0; while (cond) { __builtin_amdgcn_s_sleep(1); \
    if ((++_sp & 255u) == 0u) { if (xb_ld(&(bar)[XB_TMO])) break; if (_sp > XB_SPIN_CAP) { atomicAdd(&(bar)[XB_TMO], 1u); break; } } } } while (0)
struct XcdBarrier { unsigned* bar; unsigned x; volatile LAS unsigned* st; };
__device__ __forceinline__ XcdBarrier xcd_barrier_post(unsigned* bar, volatile LAS unsigned* st) {
    XcdBarrier b; b.bar = bar; b.x = xb_xcc_id(); b.st = st;
    if (threadIdx.x == 0) (void)xb_add(&bar[XB_XCNT(b.x)], 1u);
    return b;
}
__device__ __forceinline__ void xcd_barrier_complete(unsigned* bar, unsigned x, unsigned& nloc, unsigned& nx) {
    const unsigned G = gridDim.x * gridDim.y * gridDim.z;
    unsigned sum, cnt, mine, sp = 0u;
    for (;;) {
        sum = 0u; cnt = 0u; mine = 0u;
#pragma unroll
        for (unsigned j = 0; j < 16; ++j) { const unsigned c = xb_ld(&bar[XB_XCNT(j)]); sum += c; cnt += (c > 0u) ? 1u : 0u; mine = (j == x) ? c : mine; }
        if (sum == G) break;
        __builtin_amdgcn_s_sleep(1);
        if ((++sp & 255u) == 0u) { if (xb_ld(&bar[XB_TMO])) break; if (sp > XB_SPIN_CAP) { atomicAdd(&bar[XB_TMO], 1u); break; } }
    }
    nloc = mine > 0u ? mine : 1u; nx = cnt > 0u ? cnt : 1u;
}
__device__ __forceinline__ void xcd_barrier(const XcdBarrier& b) {
    asm volatile("s_waitcnt vmcnt(0)" ::: "memory");
    __syncthreads();
    if (threadIdx.x == 0) {
        unsigned* bar = b.bar;
        __builtin_amdgcn_s_waitcnt(0);
        unsigned nloc = b.st[0], nx = b.st[1];
        if (nloc == 0u) { xcd_barrier_complete(bar, b.x, nloc, nx); b.st[0] = nloc; b.st[1] = nx; }
        const unsigned old = xb_add(&bar[XB_XSUB(b.x)], 1u);
        const unsigned gen = old / nloc;
        if (old + 1u == (gen + 1u) * nloc) {
            __builtin_amdgcn_fence(__ATOMIC_RELEASE, "agent");
            asm volatile("s_waitcnt vmcnt(0)" ::: "memory");
            const unsigned og = xb_add(&bar[XB_TOP], 1u);
            const unsigned tg = og / nx;
            if (og + 1u == (tg + 1u) * nx) xb_add(&bar[XB_TOPGEN], 1u);
            else XB_SPIN(xb_ld(&bar[XB_TOPGEN]) == tg, bar);
            __builtin_amdgcn_fence(__ATOMIC_ACQUIRE, "agent");
            xb_add(&bar[XB_XGEN(b.x)], 1u);
            asm volatile("s_waitcnt vmcnt(0)" ::: "memory");
        } else {
            XB_SPIN(xb_ld(&bar[XB_XGEN(b.x)]) == gen, bar);
            __builtin_amdgcn_fence(__ATOMIC_ACQUIRE, "agent");
            asm volatile("s_waitcnt vmcnt(0)" ::: "memory");
        }
    }
    __syncthreads();
}

namespace pg8 {
constexpr int BM = 256, BK = 64, HALF = 128, HTB = HALF * BK * 2, STAGE_BYTES = 8 * HTB, NXCD = 8, WGM = 8;
__host__ __device__ __forceinline__ int lds_byte(int r, int c) { const int st = (r >> 4) * 2 + (c >> 5), rr = r & 15, cc = c & 31, ob = rr * 64 + cc * 2; return st * 1024 + (ob ^ (((ob >> 9) & 1) << 5)); }
__host__ __device__ __forceinline__ void stage_rc(int b, int& R, int& C) { const int st = b / 1024, sb = b % 1024, swz = sb ^ (((sb >> 9) & 1) << 5); R = (st >> 1) * 16 + swz / 64; C = (st & 1) * 32 + (swz % 64) / 2; }
__host__ __device__ __forceinline__ int perm32(int rho) { const int n = rho >> 4, i = rho & 15; return 8 * (i >> 2) + 4 * n + (i & 3); }

struct Unit { const char* a; const char* b; int r0, c0, e, slot; };

struct StaticOrder {
    int nM, nN, nwg, G, c;
    __device__ void init(int M, int N, int G_, int c_) { nM = M / BM; nN = N / BM; nwg = nM * nN; G = G_; c = c_; }
    __device__ bool next(int i, int& pm, int& pn) const {
        const long L = (long)i * G + c; if (L >= nwg) return false;
        int wgid = (int)L; { const int q = nwg / NXCD, r = nwg % NXCD, xcd = wgid % NXCD, off = wgid / NXCD; wgid = (xcd < r ? xcd * (q + 1) : r * (q + 1) + (xcd - r) * q) + off; }
        const int nig = WGM * nN, gid = wgid / nig, fm = gid * WGM, gsz = (nM - fm) < WGM ? (nM - fm) : WGM;
        pm = fm + ((wgid % nig) % gsz); pn = (wgid % nig) / gsz; return true;
    }
};
struct DenseSched {
    const char* A; const char* Bt; int KB; StaticOrder so;
    __device__ void init(const bf16* A_, const bf16* Bt_, int M, int N, int K_, int G, int c) { A = (const char*)A_; Bt = (const char*)Bt_; KB = 2 * K_; so.init(M, N, G, c); }
    __device__ __forceinline__ bool next(int i, Unit& u) const { int pm, pn; if (!so.next(i, pm, pn)) return false;
        u.a = A + (size_t)pm * BM * KB; u.b = Bt + (size_t)pn * BM * KB; u.r0 = pm * BM; u.c0 = pn * BM; u.e = 0; u.slot = i; return true; }
    __device__ __forceinline__ void aoff(const Unit&, const int (&R)[2], const int (&C)[2], unsigned (&v)[2][2]) const {
#pragma unroll
        for (int h = 0; h < 2; ++h)
#pragma unroll
            for (int i = 0; i < 2; ++i) v[h][i] = (unsigned)((h * HALF + R[i]) * KB + C[i] * 2); }
};
struct InProjSched {
    const char* A; const char* Bt; int KB, G, c;
    __device__ __forceinline__ bool next(int i, Unit& u) const {
        const int L = i * G + c; if (L >= 128 * 28) return false;
        const int x = L & 7, off = L >> 3, blk = off >> 6, r = off & 63;
        const int pm = 16 * x + (r & 7) + 8 * (r >> 5), ob = blk == 0 ? 6 : blk == 1 ? 5 : blk == 2 ? 2 : blk == 3 ? 3 : blk == 4 ? 4 : blk == 5 ? 0 : 1, pn = 4 * ob + ((r >> 3) & 3);
        u.a = A + (size_t)pm * BM * KB; u.b = Bt + (size_t)pn * BM * KB; u.r0 = pm * BM; u.c0 = pn * BM; u.e = 0; u.slot = i; return true; }
    __device__ __forceinline__ void aoff(const Unit&, const int (&R)[2], const int (&C)[2], unsigned (&v)[2][2]) const {
#pragma unroll
        for (int h = 0; h < 2; ++h)
#pragma unroll
            for (int i = 0; i < 2; ++i) v[h][i] = (unsigned)((h * HALF + R[i]) * KB + C[i] * 2); }
};
__device__ __forceinline__ void moe_unit_map(int i, int c, int nN, int G, int& mtg, int& pn) {
    if (G == 256) { const int x = c & 7, r = c >> 3, mpx = 32 / nN; mtg = i * (256 / nN) + x * mpx + r / nN; pn = r % nN; }
    else { const int U = i * G + c; mtg = U / nN; pn = U - mtg * nN; } }
template <bool GATHER> struct MoeSched {
    const char* A; const char* Wt; int KB, N, nN, G, c; const LAS int* tstart; const LAS int* idx;
    __device__ __forceinline__ bool next(int i, Unit& u) const {
        int mtg, pn; moe_unit_map(i, c, nN, G, mtg, pn); if (mtg >= __builtin_amdgcn_readfirstlane(tstart[32])) return false;
        int e = 0;
#pragma unroll
        for (int k = 1; k < 32; ++k) e += (tstart[k] <= mtg) ? 1 : 0;
        e = __builtin_amdgcn_readfirstlane(e);
        u.e = e; u.r0 = mtg * BM; u.c0 = pn * BM; u.slot = i;
        u.a = GATHER ? A : A + (size_t)mtg * BM * KB; u.b = Wt + ((size_t)e * N + (size_t)pn * BM) * KB; return true; }
    __device__ __forceinline__ void aoff(const Unit& u, const int (&R)[2], const int (&C)[2], unsigned (&v)[2][2]) const {
#pragma unroll
        for (int h = 0; h < 2; ++h)
#pragma unroll
            for (int i = 0; i < 2; ++i) { const int row = GATHER ? idx[u.slot * 256 + h * HALF + R[i]] : (h * HALF + R[i]); v[h][i] = (unsigned)(row * KB + C[i] * 2); } }
};

typedef int v8i32 __attribute__((ext_vector_type(8)));
template <class E, class = void> struct has_probe2 { static constexpr bool value = false; };
template <class E> struct has_probe2<E, decltype((void)E::PROBE2)> { static constexpr bool value = true; };
template <class Epi, class Sched, bool GATHER, bool ALIGN_EPI, bool SP2, bool F8 = false>
__device__ __forceinline__ void gemm_phase(LAS unsigned char* lds, const int KB, const Sched& S, const Epi& E) {
    const int tid = opaque_tid(), wid = __builtin_amdgcn_readfirstlane(tid >> 6), lane = tid & 63, wr = wid >> 2, wc = wid & 3, fr = lane & 15, fq = lane >> 4;
    const int nt = KB / (2 * BK);
    int Rr[2], Cc[2]; unsigned voffB[2], voffB1[2];
#pragma unroll
    for (int i = 0; i < 2; ++i) { int R, C; stage_rc(tid * 16 + i * 8192, R, C); Rr[i] = R; Cc[i] = C; const int Rb = (R >> 5) * 64 + ((R & 15) >> 2) * 16 + ((R >> 4) & 1) * 4 + (R & 3);
        voffB[i] = (unsigned)(Rb * KB + C * 2); voffB1[i] = (unsigned)((Rb + 8) * KB + C * 2); }
    const size_t kstep = (size_t)(BK * 2);
    const size_t hstep = (size_t)HALF * KB;
    const unsigned ldsw = (unsigned)wid * 1024u;
    const int aoff = lds_byte(wr * 64 + fr, fq * 8), boff = lds_byte(wc * 32 + fr, fq * 8);
#define PG8_SA(b, h) (((b) * 2 + (h)) * HTB)
#define PG8_SB(b, h) ((4 + (b) * 2 + (h)) * HTB)
#define PG8_STAGE(bufoff, gbase, voff) do { _Pragma("unroll") for (int _i = 0; _i < 2; ++_i) \
        __builtin_amdgcn_global_load_lds((const unsigned*)((const char*)(gbase) + (voff)[_i]), (LAS unsigned*)(lds + (bufoff) + ldsw + _i * 8192), 16, 0, 0); } while (0)
#define PG8_CAT8(lo, hi) __builtin_bit_cast(v8i32, __builtin_shufflevector((lo), (hi), 0, 1, 2, 3, 4, 5, 6, 7, 8, 9, 10, 11, 12, 13, 14, 15))
#define PG8_LDA(dst, b, h) do { if constexpr (F8) { _Pragma("unroll") for (int m = 0; m < 4; ++m) dst##8[m] = PG8_CAT8(*(const LAS bf16x8*)(lds + PG8_SA(b, h) + aoff + m * 2048), *(const LAS bf16x8*)(lds + PG8_SA(b, h) + aoff + m * 2048 + 1024)); } \
        else { _Pragma("unroll") for (int m = 0; m < 4; ++m) _Pragma("unroll") for (int k = 0; k < 2; ++k) dst[m][k] = *(const LAS bf16x8*)(lds + PG8_SA(b, h) + aoff + m * 2048 + k * 1024); } } while (0)
#define PG8_LDB(dst, b, h) do { if constexpr (F8) { _Pragma("unroll") for (int n = 0; n < 2; ++n) dst##8[n] = PG8_CAT8(*(const LAS bf16x8*)(lds + PG8_SB(b, h) + boff + n * 2048), *(const LAS bf16x8*)(lds + PG8_SB(b, h) + boff + n * 2048 + 1024)); } \
        else { _Pragma("unroll") for (int n = 0; n < 2; ++n) _Pragma("unroll") for (int k = 0; k < 2; ++k) dst[n][k] = *(const LAS bf16x8*)(lds + PG8_SB(b, h) + boff + n * 2048 + k * 1024); } } while (0)
#define PG8_MMA(ai, bj, At, Bt) do { __builtin_amdgcn_s_setprio(1); \
        if constexpr (F8) { _Pragma("unroll") for (int m = 0; m < 4; ++m) _Pragma("unroll") for (int n = 0; n < 2; ++n) \
            asm volatile("v_mfma_f32_16x16x128_f8f6f4 %0, %1, %2, %0" : "+v"(acc[ai][bj][m][n]) : "v"(Bt##8[n]), "v"(At##8[m])); } \
        else { _Pragma("unroll") for (int m = 0; m < 4; ++m) _Pragma("unroll") for (int n = 0; n < 2; ++n) _Pragma("unroll") for (int k = 0; k < 2; ++k) \
            acc[ai][bj][m][n] = __builtin_amdgcn_mfma_f32_16x16x32_bf16(Bt[n][k], At[m][k], acc[ai][bj][m][n], 0, 0, 0); } \
        __builtin_amdgcn_s_setprio(0); } while (0)
#define PG8_WAIT_V(n) asm volatile("s_waitcnt vmcnt(" #n ")" ::: "memory")
#define PG8_WAIT_L(n) asm volatile("s_waitcnt lgkmcnt(" #n ")" ::: "memory")
#define PG8_BAR __builtin_amdgcn_s_barrier()
#define PG8_SCHED __builtin_amdgcn_sched_barrier(0)
    Unit cur, nxt; int ui = 0;
    if (!S.next(0, cur)) return;
    unsigned vA[2][2], vN[2][2];
    S.aoff(cur, Rr, Cc, vA);
    f32x4 acc[2][2][4][2];
#pragma unroll
    for (int a = 0; a < 2; ++a)
#pragma unroll
        for (int b = 0; b < 2; ++b)
#pragma unroll
            for (int m = 0; m < 4; ++m)
#pragma unroll
                for (int n = 0; n < 2; ++n) acc[a][b][m][n] = (f32x4){0.f, 0.f, 0.f, 0.f};
    bf16x8 At[4][2], B0[2][2], B1[2][2];
    v8i32 At8[4], B08[2], B18[2];
    const char* cA = cur.a; const char* cB = cur.b;
    if constexpr (SP2) {
        PG8_STAGE(PG8_SB(0, 0), cB, voffB); PG8_STAGE(PG8_SB(0, 1), cB, voffB1); PG8_STAGE(PG8_SA(0, 0), cA, vA[0]); PG8_STAGE(PG8_SA(0, 1), cA, vA[1]);
        if (wr == 1) PG8_BAR;
        PG8_WAIT_V(2); PG8_BAR;
        PG8_STAGE(PG8_SB(1, 0), cB + kstep, voffB); PG8_STAGE(PG8_SA(1, 0), cA + kstep, vA[0]); PG8_STAGE(PG8_SB(1, 1), cB + kstep, voffB1);
        PG8_WAIT_V(6); PG8_BAR;
    } else if constexpr (F8 && F8_SP2B) {
        PG8_STAGE(PG8_SB(0, 0), cB, voffB); PG8_STAGE(PG8_SA(0, 0), cA, vA[0]); PG8_STAGE(PG8_SB(0, 1), cB, voffB1); PG8_STAGE(PG8_SA(0, 1), cA, vA[1]);
        if (wr == 1) PG8_BAR;
        PG8_STAGE(PG8_SB(1, 0), cB + kstep, voffB); PG8_STAGE(PG8_SB(1, 1), cB + kstep, voffB1);
        PG8_WAIT_V(4); PG8_BAR;
        PG8_BAR;
    } else {
        PG8_STAGE(PG8_SB(0, 0), cB, voffB); PG8_STAGE(PG8_SA(0, 0), cA, vA[0]); PG8_STAGE(PG8_SB(0, 1), cB, voffB1); PG8_STAGE(PG8_SA(0, 1), cA, vA[1]);
        if (wr == 1) PG8_BAR;
        PG8_WAIT_V(4); PG8_BAR;
        PG8_STAGE(PG8_SB(1, 0), cB + kstep, voffB); PG8_STAGE(PG8_SA(1, 0), cA + kstep, vA[0]); PG8_STAGE(PG8_SB(1, 1), cB + kstep, voffB1);
        PG8_WAIT_V(6); PG8_BAR;
    }
    for (;;) {
        const bool has_next = S.next(ui + 1, nxt);
        const char* nA = has_next ? nxt.a : cA; const char* nB = has_next ? nxt.b : cB;
        if (GATHER && has_next) S.aoff(nxt, Rr, Cc, vN);
        else {
#pragma unroll
            for (int h = 0; h < 2; ++h)
#pragma unroll
                for (int i = 0; i < 2; ++i) vN[h][i] = vA[h][i]; }
#pragma unroll 1
        for (int t = 0; t < nt; t += 2) {
            const bool last = (t == nt - 2);
            const char* a1 = cA + (size_t)(t + 1) * kstep;
            const char* a2 = last ? nA : cA + (size_t)(t + 2) * kstep; const char* b2 = last ? nB : cB + (size_t)(t + 2) * kstep;
            const char* a3 = a2 + kstep; const char* b3 = b2 + kstep;
            unsigned v2[2][2];
#pragma unroll
            for (int h = 0; h < 2; ++h)
#pragma unroll
                for (int i = 0; i < 2; ++i) v2[h][i] = last ? vN[h][i] : vA[h][i];
            if constexpr (SP2) {
            PG8_LDB(B0, 0, 0); PG8_LDB(B1, 0, 1); PG8_SCHED; PG8_LDA(At, 0, 0); PG8_STAGE(PG8_SA(1, 1), a1, vA[1]);
            PG8_WAIT_V(8); PG8_WAIT_L(0); PG8_BAR; PG8_MMA(0, 0, At, B0); PG8_MMA(0, 1, At, B1); PG8_BAR; PG8_SCHED;
            PG8_LDA(At, 0, 1); PG8_STAGE(PG8_SB(0, 0), b2, voffB); PG8_STAGE(PG8_SB(0, 1), b2, voffB1); PG8_STAGE(PG8_SA(0, 0), a2, v2[0]);
            PG8_WAIT_V(8); PG8_WAIT_L(0); PG8_BAR; PG8_MMA(1, 0, At, B0); PG8_MMA(1, 1, At, B1); PG8_BAR; PG8_SCHED;
            PG8_LDB(B0, 1, 0); PG8_LDB(B1, 1, 1); PG8_SCHED; PG8_LDA(At, 1, 0); PG8_STAGE(PG8_SA(0, 1), a2, v2[1]);
            PG8_WAIT_V(8); PG8_WAIT_L(0); PG8_BAR; PG8_MMA(0, 0, At, B0); PG8_MMA(0, 1, At, B1); PG8_BAR; PG8_SCHED;
            PG8_LDA(At, 1, 1); PG8_STAGE(PG8_SB(1, 0), b3, voffB); PG8_STAGE(PG8_SB(1, 1), b3, voffB1); PG8_STAGE(PG8_SA(1, 0), a3, v2[0]);
            PG8_WAIT_V(8); PG8_WAIT_L(0); PG8_BAR; PG8_MMA(1, 0, At, B0); PG8_MMA(1, 1, At, B1); PG8_BAR; PG8_SCHED;
            } else if constexpr (F8 && F8_SP2B) {
            PG8_LDB(B0, 0, 0); PG8_LDB(B1, 0, 1); PG8_SCHED; PG8_LDA(At, 0, 0); PG8_STAGE(PG8_SA(1, 0), a1, vA[0]); PG8_STAGE(PG8_SA(1, 1), a1, vA[1]);
            PG8_WAIT_L(0); PG8_BAR; PG8_MMA(0, 0, At, B0); PG8_MMA(0, 1, At, B1); PG8_BAR; PG8_SCHED;
            PG8_LDA(At, 0, 1); PG8_STAGE(PG8_SB(0, 0), b2, voffB); PG8_STAGE(PG8_SB(0, 1), b2, voffB1);
            PG8_WAIT_V(4); PG8_WAIT_L(0); PG8_BAR; PG8_MMA(1, 0, At, B0); PG8_MMA(1, 1, At, B1); PG8_BAR; PG8_SCHED;
            PG8_LDB(B0, 1, 0); PG8_LDB(B1, 1, 1); PG8_SCHED; PG8_LDA(At, 1, 0); PG8_STAGE(PG8_SA(0, 0), a2, v2[0]); PG8_STAGE(PG8_SA(0, 1), a2, v2[1]);
            PG8_WAIT_L(0); PG8_BAR; PG8_MMA(0, 0, At, B0); PG8_MMA(0, 1, At, B1); PG8_BAR; PG8_SCHED;
            PG8_LDA(At, 1, 1); PG8_STAGE(PG8_SB(1, 0), b3, voffB); PG8_STAGE(PG8_SB(1, 1), b3, voffB1);
            PG8_WAIT_V(4); PG8_WAIT_L(0); PG8_BAR; PG8_MMA(1, 0, At, B0); PG8_MMA(1, 1, At, B1); PG8_BAR; PG8_SCHED;
            } else {
            PG8_LDB(B0, 0, 0); PG8_SCHED; PG8_LDA(At, 0, 0); PG8_STAGE(PG8_SA(1, 1), a1, vA[1]);
            PG8_WAIT_L(8); PG8_BAR; PG8_WAIT_L(0); PG8_MMA(0, 0, At, B0); PG8_BAR; PG8_SCHED;
            PG8_LDB(B1, 0, 1); PG8_STAGE(PG8_SB(0, 0), b2, voffB);
            PG8_BAR; PG8_WAIT_L(0); PG8_MMA(0, 1, At, B1); PG8_BAR;
            PG8_LDA(At, 0, 1); PG8_STAGE(PG8_SA(0, 0), a2, v2[0]);
            PG8_BAR; PG8_WAIT_L(0); PG8_MMA(1, 0, At, B0); PG8_BAR; PG8_SCHED;
            PG8_STAGE(PG8_SB(0, 1), b2, voffB1);
            PG8_WAIT_V(6); PG8_BAR; PG8_MMA(1, 1, At, B1); PG8_BAR;
            PG8_LDB(B0, 1, 0); PG8_SCHED; PG8_LDA(At, 1, 0); PG8_STAGE(PG8_SA(0, 1), a2, v2[1]);
            PG8_WAIT_L(8); PG8_BAR; PG8_WAIT_L(0); PG8_MMA(0, 0, At, B0); PG8_BAR; PG8_SCHED;
            PG8_LDB(B1, 1, 1); PG8_STAGE(PG8_SB(1, 0), b3, voffB);
            PG8_BAR; PG8_WAIT_L(0); PG8_MMA(0, 1, At, B1); PG8_BAR;
            PG8_LDA(At, 1, 1); PG8_STAGE(PG8_SA(1, 0), a3, v2[0]);
            PG8_BAR; PG8_WAIT_L(0); PG8_MMA(1, 0, At, B0); PG8_BAR; PG8_SCHED;
            PG8_STAGE(PG8_SB(1, 1), b3, voffB1);
            PG8_WAIT_V(6); PG8_BAR; PG8_MMA(1, 1, At, B1); PG8_BAR;
            }
        }
        if constexpr (ALIGN_EPI) { if (wr == 0) PG8_BAR; }
        if constexpr (F8) asm volatile("s_nop 15\n\ts_nop 15" ::: "memory");
        { int fr_e = fr, fq_e = fq; asm volatile("" : "+v"(fr_e), "+v"(fq_e));
          E(acc, cur, wr, wc, fr_e, fq_e);
#if defined(PROBE_EPI2)
          if constexpr (has_probe2<Epi>::value) { asm volatile("" : "+v"(fr_e), "+v"(fq_e)); E(acc, cur, wr, wc, fr_e, fq_e); }
#endif
        }
        if (!has_next) break;
#pragma unroll
        for (int a = 0; a < 2; ++a)
#pragma unroll
            for (int b = 0; b < 2; ++b)
#pragma unroll
                for (int m = 0; m < 4; ++m)
#pragma unroll
                    for (int n = 0; n < 2; ++n) acc[a][b][m][n] = (f32x4){0.f, 0.f, 0.f, 0.f};
        cur = nxt; cA = nA; cB = nB; ++ui;
#pragma unroll
        for (int h = 0; h < 2; ++h)
#pragma unroll
            for (int i = 0; i < 2; ++i) vA[h][i] = vN[h][i];
        if constexpr (ALIGN_EPI) { if (wr == 1) PG8_BAR; }
    }
    PG8_WAIT_V(0);
    if constexpr (!ALIGN_EPI) { if (wr == 0) PG8_BAR; }
    PG8_BAR;
#undef PG8_SA
#undef PG8_SB
#undef PG8_STAGE
#undef PG8_LDA
#undef PG8_LDB
#undef PG8_MMA
#undef PG8_CAT8
#undef PG8_WAIT_V
#undef PG8_WAIT_L
#undef PG8_BAR
#undef PG8_SCHED
}
}
typedef f32x4 AccT[2][2][4][2];

#define EPI_LOOP(...) \
    _Pragma("unroll") for (int ai = 0; ai < 2; ++ai) _Pragma("unroll") for (int m = 0; m < 4; ++m) { const int row = u.r0 + ai * 128 + wr * 64 + m * 16 + fr; u32x4 ow[2]; \
    _Pragma("unroll") for (int bj = 0; bj < 2; ++bj) { const int col = u.c0 + wc * 64 + 16 * fq + 8 * bj; const f32x4 v0 = acc[ai][bj][m][0], v1 = acc[ai][bj][m][1]; __VA_ARGS__ } \
    EPI_STORE(u.r0 + ai * 128 + wr * 64 + m * 16, u.c0 + wc * 64 + 16 * fq, ow); }
#ifndef EPI_PIPE_A
#define EPI_PIPE_A 1
#endif
#ifndef EPI_PIPE_C1
#define EPI_PIPE_C1 1
#endif
#ifndef EPI_PIPE_C2
#define EPI_PIPE_C2 1
#endif
#ifndef EPI_PIPE_D
#define EPI_PIPE_D 1
#endif
#define EPI_LD_BATCH_(LD) _Pragma("unroll") for (int mm = 0; mm < 2; ++mm) { const int row = u.r0 + ai * 128 + wr * 64 + (2 * mp + mm) * 16 + fr; \
    _Pragma("unroll") for (int bj = 0; bj < 2; ++bj) { const int col = u.c0 + wc * 64 + 16 * fq + 8 * bj; LD } }
#define EPI_LOOP_LD(NLD, LD, ...) { u32x4 ldq[2][2][2][NLD]; \
    { constexpr int ai = 0, mp = 0; auto& ld = ldq[0]; EPI_LD_BATCH_(LD) } \
    _Pragma("unroll") for (int q = 0; q < 4; ++q) { \
    if (EPI_PIPE && q < 3) { const int ai = (q + 1) >> 1, mp = (q + 1) & 1; auto& ld = ldq[(q + 1) & 1]; EPI_LD_BATCH_(LD) } \
    { const int ai = q >> 1, mp = q & 1; auto& ld = ldq[EPI_PIPE ? (q & 1) : 0]; if (!EPI_PIPE && q > 0) { EPI_LD_BATCH_(LD) } \
    _Pragma("unroll") for (int mm = 0; mm < 2; ++mm) { const int m = 2 * mp + mm; const int row = u.r0 + ai * 128 + wr * 64 + m * 16 + fr; u32x4 ow[2]; \
    _Pragma("unroll") for (int bj = 0; bj < 2; ++bj) { const int col = u.c0 + wc * 64 + 16 * fq + 8 * bj; const f32x4 v0 = acc[ai][bj][m][0] * EPI_SCALE, v1 = acc[ai][bj][m][1] * EPI_SCALE; __VA_ARGS__ } \
    EPI_STORE(u.r0 + ai * 128 + wr * 64 + m * 16, u.c0 + wc * 64 + 16 * fq, ow); } } } }
__device__ __forceinline__ void store_pair16(bf16* base, int ld, int R0, int fr, int col16, const u32x4 (&ow)[2]) {
    const bool lo = fr < 8; u32x4 recv;
#pragma unroll
    for (int j = 0; j < 4; ++j) { const unsigned snd = lo ? ow[1][j] : ow[0][j]; recv[j] = (unsigned)__builtin_amdgcn_update_dpp(0, (int)snd, 0x128, 0xF, 0xF, true); }
    u32x4 d1, d2;
#pragma unroll
    for (int j = 0; j < 4; ++j) { d1[j] = lo ? ow[0][j] : recv[j]; d2[j] = lo ? recv[j] : ow[1][j]; }
    bf16* p = base + (size_t)(R0 + (fr & 7)) * ld + col16 + (lo ? 0 : 8);
    *(u32x4*)p = d1; *(u32x4*)(p + (size_t)8 * ld) = d2;
}
__device__ __forceinline__ u32x4 pack8(const f32x4 a, const f32x4 b) { u32x4 w; w.x = cvt_pk_bf16(a[0], a[1]); w.y = cvt_pk_bf16(a[2], a[3]); w.z = cvt_pk_bf16(b[0], b[1]); w.w = cvt_pk_bf16(b[2], b[3]); return w; }
__device__ __forceinline__ void unpack8(const u32x4 w, f32x4& a, f32x4& b) { a = (f32x4){bf_lo(w.x), bf_hi(w.x), bf_lo(w.y), bf_hi(w.y)}; b = (f32x4){bf_lo(w.z), bf_hi(w.z), bf_lo(w.w), bf_hi(w.w)}; }

#define EPI_STORE(R0_, C16_, OW_) do { if (ST_G8) *(u32x4*)(ST_G8 + (size_t)((R0_) + fr) * (2 * DM) + ((C16_) - C_GA)) = (u32x4){OW_[0].x, OW_[0].y, OW_[1].x, OW_[1].y}; else store_pair16(ST_BASE, ST_LD, R0_, fr, C16_, OW_); } while (0)
struct EpiInProj {
#if defined(PROBE_EPI2) && PROBE_EPI2 == 1
    static constexpr bool PROBE2 = true;
#endif
    bf16* P; const bf16* rcs; unsigned char* PG8;
    __device__ __forceinline__ void operator()(const AccT& acc, const pg8::Unit& u, int wr, int wc, int fr, int fq) const {
        const int c0 = __builtin_amdgcn_readfirstlane(u.c0);
        const int mode = c0 < C_K ? 0 : c0 < C_V ? 1 : c0 < C_G ? 2 : c0 < C_U ? 3 : c0 < C_GA ? 4 : 5;
        switch (mode) { case 0: run<0>(acc, u, wr, wc, fr, fq); break; case 1: run<1>(acc, u, wr, wc, fr, fq); break; case 2: run<2>(acc, u, wr, wc, fr, fq); break;
                        case 3: run<3>(acc, u, wr, wc, fr, fq); break; case 4: run<4>(acc, u, wr, wc, fr, fq); break; default: run<5>(acc, u, wr, wc, fr, fq); break; }
    }
    template <int mode> __device__ __forceinline__ void run(const AccT& acc, const pg8::Unit& u, int wr, int wc, int fr, int fq) const {
        bf16* const ST_BASE = P; constexpr int ST_LD = INW; constexpr float EPI_SCALE = INPROJ_FP8 ? 1.0f / 256.0f : 1.0f; constexpr bool EPI_PIPE = EPI_PIPE_A != 0;
        unsigned char* const ST_G8 = (GATE_U8 && mode == 5) ? PG8 : nullptr;
        EPI_LOOP_LD(1, if (mode <= 1) { const int pos = row & (SEQ - 1); const int jg = (col & 127) >> 3; ld[mm][bj][0] = *(const u32x4*)(rcs + (pos * 16 + jg) * 8); } ,
            f32x4 o0, o1;
            if (mode <= 1) {
                const int pos = row & (SEQ - 1), h = (col & 511) >> 7;
                f32x4 cs, sn; unpack8(ld[mm][bj][0], cs, sn);
                const float lg = lg2_gamma(h) * (float)(pos & 63);
                const float sc = mode == 0 ? __builtin_amdgcn_exp2f(lg) : __builtin_amdgcn_exp2f(-lg) * 0.08838834764831845f;
                o0 = (v0 * cs - v1 * sn) * sc; o1 = (v0 * sn + v1 * cs) * sc;
            } else if (mode == 2) { o0 = v0; o1 = v1; }
            else if (mode == 3) { _Pragma("unroll") for (int j = 0; j < 4; ++j) { o0[j] = siluf_(v0[j]); o1[j] = siluf_(v1[j]); } }
            else if (mode == 4) { _Pragma("unroll") for (int j = 0; j < 4; ++j) { o0[j] = geluf_(v0[j]); o1[j] = geluf_(v1[j]); } }
            else { _Pragma("unroll") for (int j = 0; j < 4; ++j) { o0[j] = sigmoidf_(v0[j]); o1[j] = sigmoidf_(v1[j]); } }
            if (GATE_U8 && mode == 5) { ow[bj].x = pack4_u8(o0); ow[bj].y = pack4_u8(o1); } else
            ow[bj] = pack8(o0, o1);
        )
    }
};
struct EpiGate1 {
    const bf16* P; bf16* H1; const unsigned char* PG8;
    __device__ __forceinline__ void operator()(const AccT& acc, const pg8::Unit& u, int wr, int wc, int fr, int fq) const {
        bf16* const ST_BASE = H1; constexpr int ST_LD = DM; constexpr float EPI_SCALE = 1.0f; unsigned char* const ST_G8 = nullptr; constexpr bool EPI_PIPE = EPI_PIPE_C1 != 0;
        EPI_LOOP_LD(1, if (GATE_U8) { const u32x2 q8 = *(const u32x2*)(PG8 + (size_t)row * (2 * DM) + col); ld[mm][bj][0].x = q8.x; ld[mm][bj][0].y = q8.y; } else ld[mm][bj][0] = *(const u32x4*)(P + (size_t)row * INW + C_GA + col); ,
            f32x4 g0, g1; if (GATE_U8) unpack8_u8((u32x2){ld[mm][bj][0].x, ld[mm][bj][0].y}, g0, g1); else unpack8(ld[mm][bj][0], g0, g1);
            ow[bj] = pack8(v0 * g0, v1 * g1);
        )
    }
};
struct EpiGate2 {
    const bf16* P; const bf16* H1; bf16* Hb; const unsigned char* PG8;
    __device__ __forceinline__ void operator()(const AccT& acc, const pg8::Unit& u, int wr, int wc, int fr, int fq) const {
        bf16* const ST_BASE = Hb; constexpr int ST_LD = DM; constexpr float EPI_SCALE = 1.0f; unsigned char* const ST_G8 = nullptr; constexpr bool EPI_PIPE = EPI_PIPE_C2 != 0;
        EPI_LOOP_LD(2, if (GATE_U8) { const u32x2 q8 = *(const u32x2*)(PG8 + (size_t)row * (2 * DM) + DM + col); ld[mm][bj][0].x = q8.x; ld[mm][bj][0].y = q8.y; } else ld[mm][bj][0] = *(const u32x4*)(P + (size_t)row * INW + C_GB + col); ld[mm][bj][1] = *(const u32x4*)(H1 + (size_t)row * DM + col); ,
            f32x4 g0, g1, h0, h1; if (GATE_U8) unpack8_u8((u32x2){ld[mm][bj][0].x, ld[mm][bj][0].y}, g0, g1); else unpack8(ld[mm][bj][0], g0, g1); unpack8(ld[mm][bj][1], h0, h1);
            ow[bj] = pack8(h0 + v0 * g0, h1 + v1 * g1);
        )
    }
};
struct EpiResid {
    const float* Xf; const bf16* Xb; bf16* Z;
    __device__ __forceinline__ void operator()(const AccT& acc, const pg8::Unit& u, int wr, int wc, int fr, int fq) const {
        bf16* const ST_BASE = Z; constexpr int ST_LD = DM; constexpr float EPI_SCALE = 1.0f; unsigned char* const ST_G8 = nullptr; constexpr bool EPI_PIPE = EPI_PIPE_D != 0;
        EPI_LOOP_LD(2, if (Xf) { ld[mm][bj][0] = *(const u32x4*)(Xf + (size_t)row * DM + col); ld[mm][bj][1] = *(const u32x4*)(Xf + (size_t)row * DM + col + 4); } else ld[mm][bj][0] = *(const u32x4*)(Xb + (size_t)row * DM + col); ,
            f32x4 x0, x1;
            if (Xf) { x0 = __builtin_bit_cast(f32x4, ld[mm][bj][0]); x1 = __builtin_bit_cast(f32x4, ld[mm][bj][1]); }
            else unpack8(ld[mm][bj][0], x0, x1);
            ow[bj] = pack8(x0 * DN_ALPHA + v0, x1 * DN_ALPHA + v1);
        )
    }
};
struct EpiSwiglu {
#if defined(PROBE_EPI2) && PROBE_EPI2 == 3
    static constexpr bool PROBE2 = true;
#endif
    bf16* Act; const float* b1;
    __device__ __forceinline__ void operator()(const AccT& acc, const pg8::Unit& u, int wr, int wc, int fr, int fq) const {
        const int j0 = (u.c0 >> 1) + wc * 32 + 8 * fq;
        const float* be = b1 + (size_t)u.e * 2 * DEXP + j0;
        const f32x4 bg0 = *(const f32x4*)be, bg1 = *(const f32x4*)(be + 4), bu0 = *(const f32x4*)(be + DEXP), bu1 = *(const f32x4*)(be + DEXP + 4);
        constexpr float sc = MOE_FP8 ? 1.0f / 256.0f : 1.0f;
#pragma unroll
        for (int ai = 0; ai < 2; ++ai)
#pragma unroll
            for (int m = 0; m < 4; ++m) { const int row = u.r0 + ai * 128 + wr * 64 + m * 16 + fr;
                const f32x4 hg0 = acc[ai][0][m][0] * sc + bg0, hg1 = acc[ai][0][m][1] * sc + bg1, hu0 = acc[ai][1][m][0] * sc + bu0, hu1 = acc[ai][1][m][1] * sc + bu1; float a[8];
#pragma unroll
                for (int j = 0; j < 4; ++j) { const float g0 = fminf(hg0[j], 7.0f), u0 = fminf(fmaxf(hu0[j], -7.0f), 7.0f), g1 = fminf(hg1[j], 7.0f), u1 = fminf(fmaxf(hu1[j], -7.0f), 7.0f);
                    a[j] = g0 * sigmoidf_(1.702f * g0) * (u0 + 1.0f); a[4 + j] = g1 * sigmoidf_(1.702f * g1) * (u1 + 1.0f); }
                if (MOE_FP8) { u32x2 w; w.x = cvt4_fp8(a[0] * 4.0f, a[1] * 4.0f, a[2] * 4.0f, a[3] * 4.0f); w.y = cvt4_fp8(a[4] * 4.0f, a[5] * 4.0f, a[6] * 4.0f, a[7] * 4.0f); *(u32x2*)((unsigned char*)Act + (size_t)row * DEXP + j0) = w; }
                else { u32x4 w; w.x = cvt_pk_bf16(a[0], a[1]); w.y = cvt_pk_bf16(a[2], a[3]); w.z = cvt_pk_bf16(a[4], a[5]); w.w = cvt_pk_bf16(a[6], a[7]); *(u32x4*)(Act + (size_t)row * DEXP + j0) = w; } }
    }
};
struct EpiBias {
    bf16* Y; const float* b2;
    __device__ __forceinline__ void operator()(const AccT& acc, const pg8::Unit& u, int wr, int wc, int fr, int fq) const {
        const float* be = b2 + (size_t)u.e * DM; f32x4 b0a[2], b1a[2];
#pragma unroll
        for (int bj = 0; bj < 2; ++bj) { const int cc = u.c0 + wc * 64 + 16 * fq + 8 * bj; b0a[bj] = *(const f32x4*)(be + cc); b1a[bj] = *(const f32x4*)(be + cc + 4); }
        bf16* const ST_BASE = Y; constexpr int ST_LD = DM; unsigned char* const ST_G8 = nullptr;
        if (MOE_FP8) {
#pragma unroll
            for (int ai = 0; ai < 2; ++ai)
#pragma unroll
                for (int m = 0; m < 4; ++m) { const int row = u.r0 + ai * 128 + wr * 64 + m * 16 + fr; u32x4 w;
#pragma unroll
                    for (int bj = 0; bj < 2; ++bj) { const f32x4 y0 = (acc[ai][bj][m][0] * (1.0f / 512.0f) + b0a[bj]) * 16.0f, y1 = (acc[ai][bj][m][1] * (1.0f / 512.0f) + b1a[bj]) * 16.0f;
                        w[2 * bj] = cvt4_fp8(y0[0], y0[1], y0[2], y0[3]); w[2 * bj + 1] = cvt4_fp8(y1[0], y1[1], y1[2], y1[3]); }
                    *(u32x4*)((unsigned char*)Y + (size_t)row * DM + u.c0 + wc * 64 + 16 * fq) = w; }
        } else {
        EPI_LOOP(
            const f32x4 b0v = b0a[bj], b1v = b1a[bj];
            ow[bj] = pack8(v0 + b0v, v1 + b1v);
        )
        }
    }
};

struct Frame {
    LAS unsigned char* lds; volatile LAS unsigned* MISC; unsigned* ctl;
    int tid, lane, wave, G, bid;
    unsigned char* ws;
};
#define WSP(T_, off) ((T_*)(F.ws + (off)))
__device__ __forceinline__ void frame_refresh(Frame& F) { F.tid = opaque_tid(); F.lane = F.tid & 63; F.wave = __builtin_amdgcn_readfirstlane(F.tid >> 6);
    int b_ = blockIdx.x, g_ = gridDim.x; asm volatile("" : "+s"(b_), "+s"(g_)); F.bid = b_; F.G = g_; }

template <class FN>
__device__ __forceinline__ void transpose_item(const float* __restrict__ W, int N, bf16* __restrict__ WT, int K, int k0, int n0, FN srccol, LAS float* scr, int lane) {
    const int dq = lane & 15, ks = lane >> 4; const int sc = srccol(n0 + 4 * dq);
    f32x4 v[16];
#pragma unroll
    for (int it = 0; it < 16; ++it) v[it] = *(const f32x4*)(W + (size_t)(k0 + 4 * it + ks) * N + sc);
#pragma unroll
    for (int it = 0; it < 16; ++it) { LAS float* d = scr + (4 * it + ks) * 65 + 4 * dq; d[0] = v[it][0]; d[1] = v[it][1]; d[2] = v[it][2]; d[3] = v[it][3]; }
    LDS_WAIT();
    const int c = lane >> 3, ns = lane & 7;
#pragma unroll
    for (int j = 0; j < 8; ++j) { const int n = 8 * j + ns; const LAS float* s = scr + (8 * c) * 65 + n;
        u32x4 o; o.x = cvt_pk_bf16(s[0], s[65]); o.y = cvt_pk_bf16(s[2 * 65], s[3 * 65]); o.z = cvt_pk_bf16(s[4 * 65], s[5 * 65]); o.w = cvt_pk_bf16(s[6 * 65], s[7 * 65]);
        *(u32x4*)(WT + (size_t)(n0 + n) * K + k0 + 8 * c) = o; }
    LDS_WAIT();
}
template <class FN>
__device__ __forceinline__ void transpose_item_f8(const float* __restrict__ W, int N, unsigned char* __restrict__ WT, int K, int k0, int n0, FN srccol, float scale, LAS float* scr, int lane) {
    const int dq = lane & 7, ks = lane >> 3; const int sc = srccol(n0 + 4 * dq);
    f32x4 v[16];
#pragma unroll
    for (int it = 0; it < 16; ++it) v[it] = *(const f32x4*)(W + (size_t)(k0 + 8 * it + ks) * N + sc);
#pragma unroll
    for (int it = 0; it < 16; ++it) { LAS float* d = scr + (8 * it + ks) * 33 + 4 * dq; d[0] = v[it][0] * scale; d[1] = v[it][1] * scale; d[2] = v[it][2] * scale; d[3] = v[it][3] * scale; }
    LDS_WAIT();
    const int c = lane & 7, ns = lane >> 3;
#pragma unroll
    for (int j = 0; j < 4; ++j) { const int n = 8 * j + ns; const LAS float* s = scr + (16 * c) * 33 + n;
        u32x4 o; o.x = cvt4_fp8(s[0], s[33], s[2 * 33], s[3 * 33]); o.y = cvt4_fp8(s[4 * 33], s[5 * 33], s[6 * 33], s[7 * 33]);
        o.z = cvt4_fp8(s[8 * 33], s[9 * 33], s[10 * 33], s[11 * 33]); o.w = cvt4_fp8(s[12 * 33], s[13 * 33], s[14 * 33], s[15 * 33]);
        *(u32x4*)(WT + (size_t)(n0 + n) * K + k0 + 16 * c) = o; }
    LDS_WAIT();
}
struct ColId { __device__ int operator()(int n) const { return n; } };
struct ColQK { __device__ int operator()(int n) const { if (n >= C_V) return n; const int cl = n & 127, g8 = cl >> 3, i = cl & 7; return (n & ~127) + (i < 4 ? 4 * g8 + i : 64 + 4 * g8 + (i - 4)); } };
struct ColGU { __device__ int operator()(int n) const { const int pn = n >> 8, wi = n & 255, hid = pn * 128 + (wi >> 4) * 8 + (wi & 7); return (wi & 8) ? DEXP + hid : hid; } };

__device__ __forceinline__ void p0_prologue(Frame& F, const float* x, const float* w_in, const float* p_ret, const float* p_sg, const float* w_o, const float* sg_w, const float* e_w1, const float* e_w2) {
    LAS float* scr = (LAS float*)(F.lds + F.wave * 16896);
    const int gw = F.bid * NWAVES + F.wave, NGW = F.G * NWAVES;
    constexpr int I_IN = (DM / 64) * (INW / 64), I_SQ = (DM / 64) * (DM / 64), I_W1 = NE * (DM / 64) * (2 * DEXP / 64), I_W2 = NE * (DEXP / 64) * (DM / 64);
    constexpr int I_LAYER = I_IN + 3 * I_SQ + I_W1 + I_W2;
    for (int it = gw; it < NL * I_LAYER; it += NGW) {
        const int l = it / I_LAYER; int r = it - l * I_LAYER;
        if (r < I_IN) { const int nb = INW / 64, kb = r / nb, nn = r - kb * nb;
            if (INPROJ_FP8) { const int nb8 = INW / 32, kb8 = r / nb8, nn8 = r - kb8 * nb8; transpose_item_f8(w_in + (size_t)l * DM * INW, INW, WSP(unsigned char, WS_WIN) + (size_t)l * INW * DM, DM, 128 * kb8, 32 * nn8, ColQK(), 64.0f, scr, F.lane); }
            else transpose_item(w_in + (size_t)l * DM * INW, INW, WSP(bf16, WS_WIN) + (size_t)l * INW * DM, DM, 64 * kb, 64 * nn, ColQK(), scr, F.lane);
            continue; } r -= I_IN;
        if (r < 3 * I_SQ) { const int which = r / I_SQ; r -= which * I_SQ; const int kb = r / 16, nn = r & 15;
            const float* src = (which == 0 ? p_ret : which == 1 ? p_sg : w_o) + (size_t)l * DM * DM;
            bf16* dst = WSP(bf16, which == 0 ? WS_PRET : which == 1 ? WS_PSG : WS_WO) + (size_t)l * DM * DM;
            transpose_item(src, DM, dst, DM, 64 * kb, 64 * nn, ColId(), scr, F.lane); continue; } r -= 3 * I_SQ;
        if (r < I_W1) { const int e = r / 512; r -= e * 512; const int kb = r / 32, nn = r & 31;
            if (MOE_FP8) transpose_item_f8(e_w1 + ((size_t)l * NE + e) * DM * 2 * DEXP, 2 * DEXP, WSP(unsigned char, WS_W1) + ((size_t)l * NE + e) * 2 * DEXP * DM, DM, 128 * (r >> 6), 32 * (r & 63), ColGU(), 64.0f, scr, F.lane);
            else transpose_item(e_w1 + ((size_t)l * NE + e) * DM * 2 * DEXP, 2 * DEXP, WSP(bf16, WS_W1) + ((size_t)l * NE + e) * 2 * DEXP * DM, DM, 64 * kb, 64 * nn, ColGU(), scr, F.lane);
            continue; } r -= I_W1;
        { const int e = r / 256; r -= e * 256; const int kb = r / 16, nn = r & 15;
            if (MOE_FP8) transpose_item_f8(e_w2 + ((size_t)l * NE + e) * DEXP * DM, DM, WSP(unsigned char, WS_W2) + ((size_t)l * NE + e) * DM * DEXP, DEXP, 128 * (r >> 5), 32 * (r & 31), ColId(), 128.0f, scr, F.lane);
            else transpose_item(e_w2 + ((size_t)l * NE + e) * DEXP * DM, DM, WSP(bf16, WS_W2) + ((size_t)l * NE + e) * DM * DEXP, DEXP, 64 * kb, 64 * nn, ColId(), scr, F.lane); }
    }
    const size_t gt = (size_t)F.bid * NTHREADS + F.tid, NT = (size_t)F.G * NTHREADS;
    { const f32x4* s = (const f32x4*)sg_w; u32x2* d = WSP(u32x2, WS_SGW);
      for (size_t i = gt; i < (size_t)NL * 8 * 128 * 128 / 4; i += NT) { const f32x4 v = s[i]; u32x2 w; w.x = cvt_pk_bf16(v[0], v[1]); w.y = cvt_pk_bf16(v[2], v[3]); d[i] = w; } }
    { const f32x4* s = (const f32x4*)x; u32x2* d = WSP(u32x2, WS_XB);
      unsigned* dq = WSP(unsigned, WS_XQ);
      for (size_t i = gt; i < (size_t)T * DM / 4; i += NT) { const f32x4 v = s[i]; if (INPROJ_FP8) dq[i] = cvt4_fp8(v[0] * 4.0f, v[1] * 4.0f, v[2] * 4.0f, v[3] * 4.0f); else { u32x2 w; w.x = cvt_pk_bf16(v[0], v[1]); w.y = cvt_pk_bf16(v[2], v[3]); d[i] = w; } } }
    { float* rc = WSP(float, WS_ROPE); float* rs = rc + SEQ * 64;
      for (size_t i = gt; i < (size_t)SEQ * 64; i += NT) { const int pos = (int)(i >> 6), j = (int)(i & 63);
          const double inv = exp2(-(double)j * (13.287712379549449 / 64.0)), ang = (double)pos * inv;
          const double qd = rint(ang * 0.6366197723675814); const int qi = (int)qd;
          const double r = (ang - qd * 1.5707963267341256) - qd * 6.077100506506192e-11, r2 = r * r;
          const double sn = r * (1.0 + r2 * (-1.0 / 6 + r2 * (1.0 / 120 + r2 * (-1.0 / 5040 + r2 * (1.0 / 362880 + r2 * (-1.0 / 39916800 + r2 * (1.0 / 6227020800.0)))))));
          const double cs = 1.0 + r2 * (-0.5 + r2 * (1.0 / 24 + r2 * (-1.0 / 720 + r2 * (1.0 / 40320 + r2 * (-1.0 / 3628800 + r2 * (1.0 / 479001600.0 + r2 * (-1.0 / 87178291200.0)))))));
          const int qm = qi & 3; const double c = qm == 0 ? cs : qm == 1 ? -sn : qm == 2 ? -cs : sn, sv = qm == 0 ? sn : qm == 1 ? cs : qm == 2 ? -sn : -cs;
          rc[i] = (float)c; rs[i] = (float)sv;
          unsigned short* rcs = WSP(unsigned short, WS_ROPEB); const size_t o = ((size_t)pos * 16 + (j >> 2)) * 8 + (j & 3);
          rcs[o] = (unsigned short)(cvt_pk_bf16((float)c, 0.0f) & 0xffffu); rcs[o + 4] = (unsigned short)(cvt_pk_bf16((float)sv, 0.0f) & 0xffffu); } }
}

typedef short v4i16_t __attribute__((ext_vector_type(4)));
__device__ __forceinline__ s16x4 tr_read(const LAS unsigned char* p) { return __builtin_bit_cast(s16x4, __builtin_amdgcn_ds_read_tr16_b64_v4i16((LAS v4i16_t*)p)); }
__device__ __forceinline__ bf16x8 cat8(s16x4 a, s16x4 b) { return __builtin_shufflevector(a, b, 0, 1, 2, 3, 4, 5, 6, 7); }
constexpr int RQ_STRIDE = 272, RV_STRIDE = 544;
constexpr int RO_STRIDE = 528;
constexpr int R_Q = 0, R_K = 64 * RQ_STRIDE, R_V = 2 * 64 * RQ_STRIDE, R_SF = R_V + 64 * RV_STRIDE, R_ST = R_SF + 8192, R_OT = R_ST + 4096, R_END = R_OT + 64 * RO_STRIDE;
static_assert(R_END <= RING_BYTES, "retention LDS");

constexpr int RSEG = 4, RCPS = SEQ / 64 / RSEG;
__device__ __forceinline__ float* sloc_ptr(Frame& F, int bh, int seg, int w) { return WSP(float, WS_X1F) + ((size_t)((bh * 3 + seg) * 8 + w)) * 4096; }
__device__ __forceinline__ void ret_unit(Frame& F, int b, int h, int seg) {
    LAS unsigned char* L = F.lds;
    __syncthreads();
    const int tid = F.tid, lane = F.lane, w = F.wave, l15 = lane & 15, rq = lane >> 4, tq = l15 >> 2, tp = lane & 3, es = 32 * w;
    const bf16* P = WSP(bf16, WS_P); bf16* Y = WSP(bf16, WS_YRET);
    const float gam = __builtin_amdgcn_exp2f(lg2_gamma(h)), g63 = __builtin_amdgcn_exp2f(63.0f * lg2_gamma(h));
    const unsigned qoff = (unsigned)((tid >> 4) * INW + h * 128 + (tid & 15) * 8) * 2u, voffv = (unsigned)((tid >> 5) * INW + C_V + h * 256 + (tid & 31) * 8) * 2u;
    const unsigned qlds = (unsigned)((tid >> 4) * RQ_STRIDE + (tid & 15) * 16), vlds = (unsigned)((tid >> 5) * RV_STRIDE + (tid & 31) * 16);
    const unsigned goff = (unsigned)((tid >> 5) * INW + C_G + h * 256 + (tid & 31) * 8) * 2u, yoff = (unsigned)((tid >> 5) * DM + h * 256 + (tid & 31) * 8) * 2u, olds = (unsigned)((tid >> 5) * RO_STRIDE + (tid & 31) * 16);
    u32x4 pq[2], pk[2], pv[4];
    const size_t tb = (size_t)b * SEQ;
    const char* Pc = (const char*)P; char* Yc = (char*)Y;
#define RET_LOAD(c) do { const char* ub_ = Pc + (tb + (size_t)(c) * 64) * INW * 2; \
        _Pragma("unroll") for (int i = 0; i < 2; ++i) { const char* rp = ub_ + (size_t)(32 * i) * INW * 2 + qoff; pq[i] = __builtin_nontemporal_load((const u32x4*)(rp + C_Q * 2)); pk[i] = __builtin_nontemporal_load((const u32x4*)(rp + C_K * 2)); } \
        _Pragma("unroll") for (int i = 0; i < 4; ++i) pv[i] = __builtin_nontemporal_load((const u32x4*)(ub_ + (size_t)(16 * i) * INW * 2 + voffv)); } while (0)
#define RET_STORE() do { \
        _Pragma("unroll") for (int i = 0; i < 2; ++i) { *(LAS u32x4*)(L + R_Q + qlds + i * 32 * RQ_STRIDE) = pq[i]; *(LAS u32x4*)(L + R_K + qlds + i * 32 * RQ_STRIDE) = pk[i]; } \
        _Pragma("unroll") for (int i = 0; i < 4; ++i) *(LAS u32x4*)(L + R_V + vlds + i * 16 * RV_STRIDE) = pv[i]; } while (0)
    if (tid < 64) { *(LAS u32x2*)(L + R_SF + ((0 * 2 + 0) * 64 + tid) * 16 + 8) = (u32x2){0u, 0u}; *(LAS u32x2*)(L + R_SF + ((2 * 2 + 1) * 64 + tid) * 16 + 8) = (u32x2){0u, 0u}; }
    const int c0 = seg * RCPS;
    RET_LOAD(c0); RET_STORE(); RET_LOAD(c0 + 1);
    f32x4 St[8][2];
#pragma unroll
    for (int dt = 0; dt < 8; ++dt) { St[dt][0] = (f32x4){0.f, 0.f, 0.f, 0.f}; St[dt][1] = (f32x4){0.f, 0.f, 0.f, 0.f}; }
    if (seg > 0) {
        const float fseg = __builtin_amdgcn_exp2f((float)(64 * RCPS) * lg2_gamma(h));
        for (int sg = 0; sg < seg; ++sg) { const float* sp = sloc_ptr(F, b * 4 + h, sg, w) + lane;
#pragma unroll
            for (int dt = 0; dt < 8; ++dt)
#pragma unroll
                for (int et = 0; et < 2; ++et)
#pragma unroll
                    for (int r = 0; r < 4; ++r) St[dt][et][r] = St[dt][et][r] * fseg + sp[((dt * 2 + et) * 4 + r) * 64]; } }
    __syncthreads();
    for (int cc = 0; cc < RCPS; ++cc) {
        const int c = c0 + cc;
        const size_t t0 = tb + (size_t)c * 64;
        u32x4 gp[4];
#pragma unroll
        for (int k = 0; k < 4; ++k) gp[k] = __builtin_nontemporal_load((const u32x4*)(Pc + (t0 + 16 * k) * INW * 2 + goff));
#pragma unroll
        for (int rep = 0; rep < 2; ++rep) {
            const int id = w + 8 * rep;
            if (id < 10) {
                const int tj = id < 4 ? 0 : id < 7 ? 1 : id < 9 ? 2 : 3, ti = id < 4 ? id : id < 7 ? id - 3 : id < 9 ? id - 5 : 3;
                f32x4 s = (f32x4){0.f, 0.f, 0.f, 0.f};
#pragma unroll
                for (int kb = 0; kb < 4; ++kb) {
                    const bf16x8 a = *(const LAS bf16x8*)(L + R_K + (16 * tj + l15) * RQ_STRIDE + (32 * kb + 8 * rq) * 2);
                    const bf16x8 q = *(const LAS bf16x8*)(L + R_Q + (16 * ti + l15) * RQ_STRIDE + (32 * kb + 8 * rq) * 2);
                    s = __builtin_amdgcn_mfma_f32_16x16x32_bf16(a, q, s, 0, 0, 0); }
                if (tj == ti) {
#pragma unroll
                    for (int r = 0; r < 4; ++r) s[r] = (l15 >= 4 * rq + r) ? s[r] : 0.f; }
                u32x2 wv; wv.x = cvt_pk_bf16(s[0], s[1]); wv.y = cvt_pk_bf16(s[2], s[3]);
                *(LAS u32x2*)(L + R_SF + ((ti * 2 + (tj >> 1)) * 64 + lane) * 16 + (tj & 1) * 8) = wv;
            }
        }
        __syncthreads();
        f32x4 O[2][4];
#pragma unroll
        for (int et = 0; et < 2; ++et)
#pragma unroll
            for (int ti = 0; ti < 4; ++ti) O[et][ti] = (f32x4){0.f, 0.f, 0.f, 0.f};
#pragma unroll
        for (int kb = 0; kb < 4; ++kb) {
            bf16x8 A[2];
#pragma unroll
            for (int et = 0; et < 2; ++et) { const f32x4 s0 = St[2 * kb][et], s1 = St[2 * kb + 1][et];
                u32x4 p; p.x = cvt_pk_bf16(s0[0], s0[1]); p.y = cvt_pk_bf16(s0[2], s0[3]); p.z = cvt_pk_bf16(s1[0], s1[1]); p.w = cvt_pk_bf16(s1[2], s1[3]); A[et] = __builtin_bit_cast(bf16x8, p); }
#pragma unroll
            for (int ti = 0; ti < 4; ++ti) {
                const LAS unsigned char* qp = L + R_Q + (16 * ti + l15) * RQ_STRIDE + (32 * kb + 4 * rq) * 2;
                const bf16x8 Bq = cat8(*(const LAS s16x4*)qp, *(const LAS s16x4*)(qp + 32));
#pragma unroll
                for (int et = 0; et < 2; ++et) O[et][ti] = __builtin_amdgcn_mfma_f32_16x16x32_bf16(A[et], Bq, O[et][ti], 0, 0, 0); }
            __builtin_amdgcn_sched_barrier(0);
        }
#pragma unroll
        for (int et = 0; et < 2; ++et)
#pragma unroll
            for (int ti = 0; ti < 4; ++ti) O[et][ti] *= gam;
#pragma unroll
        for (int kb = 0; kb < 2; ++kb) {
            bf16x8 Av[2];
#pragma unroll
            for (int et = 0; et < 2; ++et) { const LAS unsigned char* vp = L + R_V + (32 * kb + 4 * rq + tq) * RV_STRIDE + (es + 16 * et + 4 * tp) * 2;
                Av[et] = cat8(tr_read(vp), tr_read(vp + 16 * RV_STRIDE)); }
#pragma unroll
            for (int ti = 2 * kb; ti < 4; ++ti) {
                const bf16x8 Bs = *(const LAS bf16x8*)(L + R_SF + ((ti * 2 + kb) * 64 + lane) * 16);
#pragma unroll
                for (int et = 0; et < 2; ++et) O[et][ti] = __builtin_amdgcn_mfma_f32_16x16x32_bf16(Av[et], Bs, O[et][ti], 0, 0, 0); }
            __builtin_amdgcn_sched_barrier(0);
        }
#pragma unroll
        for (int dt = 0; dt < 8; ++dt) { St[dt][0] *= gam; St[dt][1] *= gam; }
#pragma unroll
        for (int kb = 0; kb < 2; ++kb) {
            bf16x8 Bv[2];
#pragma unroll
            for (int et = 0; et < 2; ++et) { const LAS unsigned char* vp = L + R_V + (32 * kb + 8 * rq + tq) * RV_STRIDE + (es + 16 * et + 4 * tp) * 2;
                Bv[et] = cat8(tr_read(vp), tr_read(vp + 4 * RV_STRIDE)); }
#pragma unroll
            for (int dt = 0; dt < 8; ++dt) { const LAS unsigned char* kp = L + R_K + (32 * kb + 8 * rq + tq) * RQ_STRIDE + (16 * dt + 4 * tp) * 2;
                const bf16x8 Ak = cat8(tr_read(kp), tr_read(kp + 4 * RQ_STRIDE));
#pragma unroll
                for (int et = 0; et < 2; ++et) St[dt][et] = __builtin_amdgcn_mfma_f32_16x16x32_bf16(Ak, Bv[et], St[dt][et], 0, 0, 0);
                if (dt & 1) __builtin_amdgcn_sched_barrier(0); }
        }
#pragma unroll
        for (int dt = 0; dt < 8; ++dt) { St[dt][0] *= g63; St[dt][1] *= g63; }
#pragma unroll
        for (int ti = 0; ti < 4; ++ti) { float s = 0.f, ss = 0.f;
#pragma unroll
            for (int et = 0; et < 2; ++et)
#pragma unroll
                for (int r = 0; r < 4; ++r) { const float v = O[et][ti][r]; s += v; ss += v * v; }
            s += __shfl_xor(s, 16); s += __shfl_xor(s, 32); ss += __shfl_xor(ss, 16); ss += __shfl_xor(ss, 32);
            if (lane < 16) *(LAS f32x2*)(L + R_ST + ((16 * ti + lane) * 8 + w) * 8) = (f32x2){s, ss}; }
        __syncthreads();
        if (cc + 1 < RCPS) { RET_STORE(); if (cc + 2 < RCPS) RET_LOAD(c + 2); }
#pragma unroll
        for (int ti = 0; ti < 4; ++ti) { float s = 0.f, ss = 0.f;
            const LAS f32x4* sp = (const LAS f32x4*)(L + R_ST + (16 * ti + l15) * 64);
#pragma unroll
            for (int k = 0; k < 4; ++k) { const f32x4 v = sp[k]; s += v[0] + v[2]; ss += v[1] + v[3]; }
            const float mean = s * (1.0f / 256.0f), var = ss * (1.0f / 256.0f) - mean * mean, rstd = 1.0f / sqrtf(fmaxf(var, 0.f) + LN_EPS);
#pragma unroll
            for (int et = 0; et < 2; ++et) { const f32x4 o = (O[et][ti] - mean) * rstd;
                u32x2 wv; wv.x = cvt_pk_bf16(o[0], o[1]); wv.y = cvt_pk_bf16(o[2], o[3]);
                *(LAS u32x2*)(L + R_OT + (16 * ti + l15) * RO_STRIDE + (es + 16 * et + 4 * rq) * 2) = wv; } }
        __syncthreads();
#pragma unroll
        for (int k = 0; k < 4; ++k) { f32x4 o0, o1, g0, g1; unpack8(*(const LAS u32x4*)(L + R_OT + olds + k * 16 * RO_STRIDE), o0, o1); unpack8(gp[k], g0, g1);
            *(u32x4*)(Yc + (t0 + 16 * k) * DM * 2 + yoff) = pack8(o0 * g0, o1 * g1); }
    }
#undef RET_LOAD
#undef RET_STORE
}


__device__ __forceinline__ void ret_prepass(Frame& F, int b, int h, int seg) {
    LAS unsigned char* L = F.lds;
    __syncthreads();
    const int tid = F.tid, lane = F.lane, w = F.wave, l15 = lane & 15, rq = lane >> 4, tq = l15 >> 2, tp = lane & 3, es = 32 * w;
    const float gam = __builtin_amdgcn_exp2f(lg2_gamma(h)), g63 = __builtin_amdgcn_exp2f(63.0f * lg2_gamma(h));
    const unsigned qoff = (unsigned)((tid >> 4) * INW + h * 128 + (tid & 15) * 8) * 2u, voffv = (unsigned)((tid >> 5) * INW + C_V + h * 256 + (tid & 31) * 8) * 2u;
    const unsigned qlds = (unsigned)((tid >> 4) * RQ_STRIDE + (tid & 15) * 16), vlds = (unsigned)((tid >> 5) * RV_STRIDE + (tid & 31) * 16);
    u32x4 pk[2], pv[4];
    const size_t tb = (size_t)b * SEQ; const char* Pc = (const char*)WSP(bf16, WS_P);
#define RPP_LOAD(c) do { const char* ub_ = Pc + (tb + (size_t)(c) * 64) * INW * 2; \
        _Pragma("unroll") for (int i = 0; i < 2; ++i) pk[i] = __builtin_nontemporal_load((const u32x4*)(ub_ + (size_t)(32 * i) * INW * 2 + qoff + C_K * 2)); \
        _Pragma("unroll") for (int i = 0; i < 4; ++i) pv[i] = __builtin_nontemporal_load((const u32x4*)(ub_ + (size_t)(16 * i) * INW * 2 + voffv)); } while (0)
#define RPP_STORE() do { \
        _Pragma("unroll") for (int i = 0; i < 2; ++i) *(LAS u32x4*)(L + R_K + qlds + i * 32 * RQ_STRIDE) = pk[i]; \
        _Pragma("unroll") for (int i = 0; i < 4; ++i) *(LAS u32x4*)(L + R_V + vlds + i * 16 * RV_STRIDE) = pv[i]; } while (0)
    const int c0 = seg * RCPS;
    RPP_LOAD(c0); RPP_STORE(); RPP_LOAD(c0 + 1);
    f32x4 St[8][2];
#pragma unroll
    for (int dt = 0; dt < 8; ++dt) { St[dt][0] = (f32x4){0.f, 0.f, 0.f, 0.f}; St[dt][1] = (f32x4){0.f, 0.f, 0.f, 0.f}; }
    __syncthreads();
    for (int cc = 0; cc < RCPS; ++cc) {
#pragma unroll
        for (int dt = 0; dt < 8; ++dt) { St[dt][0] *= gam; St[dt][1] *= gam; }
#pragma unroll
        for (int kb = 0; kb < 2; ++kb) {
            bf16x8 Bv[2];
#pragma unroll
            for (int et = 0; et < 2; ++et) { const LAS unsigned char* vp = L + R_V + (32 * kb + 8 * rq + tq) * RV_STRIDE + (es + 16 * et + 4 * tp) * 2;
                Bv[et] = cat8(tr_read(vp), tr_read(vp + 4 * RV_STRIDE)); }
#pragma unroll
            for (int dt = 0; dt < 8; ++dt) { const LAS unsigned char* kp = L + R_K + (32 * kb + 8 * rq + tq) * RQ_STRIDE + (16 * dt + 4 * tp) * 2;
                const bf16x8 Ak = cat8(tr_read(kp), tr_read(kp + 4 * RQ_STRIDE));
#pragma unroll
                for (int et = 0; et < 2; ++et) St[dt][et] = __builtin_amdgcn_mfma_f32_16x16x32_bf16(Ak, Bv[et], St[dt][et], 0, 0, 0);
                if (dt & 1) __builtin_amdgcn_sched_barrier(0); }
        }
#pragma unroll
        for (int dt = 0; dt < 8; ++dt) { St[dt][0] *= g63; St[dt][1] *= g63; }
        __syncthreads();
        if (cc + 1 < RCPS) { RPP_STORE(); if (cc + 2 < RCPS) RPP_LOAD(c0 + cc + 2); }
        __syncthreads();
    }
    float* sp = sloc_ptr(F, b * 4 + h, seg, w) + lane;
#pragma unroll
    for (int dt = 0; dt < 8; ++dt)
#pragma unroll
        for (int et = 0; et < 2; ++et)
#pragma unroll
            for (int r = 0; r < 4; ++r) sp[((dt * 2 + et) * 4 + r) * 64] = St[dt][et][r];
#undef RPP_LOAD
#undef RPP_STORE
}

__device__ __forceinline__ float wave_sum_dpp(float v);
constexpr int SGT_STRIDE = 272;
constexpr int SG4_ST = 0, SG4_T = 1024, SG4_U = SG4_T + 128 * SGT_STRIDE, SG4_W = SG4_U + 128 * SGT_STRIDE, SG4_END = SG4_W + 24 * 1024;
static_assert(SG4_END <= RING_BYTES, "SGU LDS");
__device__ __forceinline__ void sgu_unit(Frame& F, int blk, int l, const float* sg_b, const float* sg_ln_g, const float* sg_ln_b) {
    LAS unsigned char* L = F.lds;
    const int tid = F.tid, lane = F.lane, w = F.wave, l15 = lane & 15, rq = lane >> 4, tq = l15 >> 2, tp = lane & 3;
    const size_t t0 = (size_t)blk * 128;
    const char* Pc = (const char*)WSP(bf16, WS_P); char* Yc = (char*)WSP(bf16, WS_YSG);
    const bf16* Wl = WSP(bf16, WS_SGW) + (size_t)l * 8 * 128 * 128;
    __syncthreads();
    const int srow = tid >> 4, sch = tid & 15;
    const unsigned soff = (unsigned)(srow * INW + sch * 8) * 2u, slds = (unsigned)(srow * SGT_STRIDE + sch * 16), yoff = (unsigned)(srow * DM + sch * 8) * 2u;
    unsigned wsrc[3];
#pragma unroll
    for (int i = 0; i < 3; ++i) { const int p = tid + 512 * i, f = p >> 6, ln = p & 63, qt = f < 8 ? (f >> 1) : 4 + ((f - 8) >> 2), kb = f < 8 ? (f & 1) : ((f - 8) & 3);
        wsrc[i] = (unsigned)((16 * qt + (ln & 15)) * 128 + 32 * kb + 8 * (ln >> 4)) * 2u; }
    u32x4 xv[4], xu[4], wreg[3]; f32x4 lnp[4]; float bq[8], bqn[8];
#define SG_LOAD(g_) do { _Pragma("unroll") for (int i = 0; i < 4; ++i) { const char* rp = Pc + ((t0 + 32 * i) * INW + (g_) * 128) * 2 + soff; xv[i] = __builtin_nontemporal_load((const u32x4*)(rp + C_VS * 2)); xu[i] = __builtin_nontemporal_load((const u32x4*)(rp + C_U * 2)); } \
        { const float* lng = sg_ln_g + (size_t)l * DM + (g_) * 128 + sch * 8; const float* lnb = sg_ln_b + (size_t)l * DM + (g_) * 128 + sch * 8; lnp[0] = *(const f32x4*)lng; lnp[1] = *(const f32x4*)(lng + 4); lnp[2] = *(const f32x4*)lnb; lnp[3] = *(const f32x4*)(lnb + 4); } \
        _Pragma("unroll") for (int qt = 0; qt < 8; ++qt) bqn[qt] = sg_b[((size_t)l * 8 + (g_)) * 128 + 16 * qt + l15]; \
        _Pragma("unroll") for (int i = 0; i < 3; ++i) wreg[i] = *(const u32x4*)((const char*)(Wl + (size_t)(g_) * 128 * 128) + wsrc[i]); } while (0)
#define SG_WPUT() do { _Pragma("unroll") for (int i = 0; i < 3; ++i) *(LAS u32x4*)(L + SG4_W + (tid + 512 * i) * 16) = wreg[i]; } while (0)
    SG_LOAD(0);
#pragma unroll 1
    for (int r8 = 0; r8 < 2; ++r8) { u32x4 a[8], b2[8];
#pragma unroll
        for (int r = 0; r < 8; ++r) { const char* rp = Pc + ((t0 + 16 * w + 8 * r8 + r) * INW + C_VS) * 2 + lane * 32; a[r] = *(const u32x4*)rp; b2[r] = *(const u32x4*)(rp + 16); }
#pragma unroll
        for (int r = 0; r < 8; ++r) { f32x4 x0, x1, x2, x3; unpack8(a[r], x0, x1); unpack8(b2[r], x2, x3);
            float s = 0.f, ss = 0.f;
#pragma unroll
            for (int j = 0; j < 4; ++j) { s += x0[j] + x1[j] + x2[j] + x3[j]; ss += x0[j] * x0[j] + x1[j] * x1[j] + x2[j] * x2[j] + x3[j] * x3[j]; }
            s = wave_sum_dpp(s); ss = wave_sum_dpp(ss);
            const float mean = s * (1.0f / 1024.0f), var = ss * (1.0f / 1024.0f) - mean * mean;
            if (lane == 0) *(LAS f32x2*)(L + SG4_ST + (16 * w + 8 * r8 + r) * 8) = (f32x2){mean, 1.0f / sqrtf(fmaxf(var, 0.f) + LN_EPS)}; } }
    SG_WPUT();
    __syncthreads();
#pragma unroll 1
    for (int g = 0; g < 8; ++g) {
#pragma unroll
        for (int qt = 0; qt < 8; ++qt) bq[qt] = bqn[qt];
#pragma unroll
        for (int i = 0; i < 4; ++i) { f32x4 x0, x1; unpack8(xv[i], x0, x1);
            const f32x2 st = *(const LAS f32x2*)(L + SG4_ST + (srow + 32 * i) * 8);
            x0 = (x0 - st.x) * st.y * lnp[0] + lnp[2]; x1 = (x1 - st.x) * st.y * lnp[1] + lnp[3];
            *(LAS u32x4*)(L + SG4_T + slds + i * 32 * SGT_STRIDE) = pack8(x0, x1);
            *(LAS u32x4*)(L + SG4_U + slds + i * 32 * SGT_STRIDE) = xu[i]; }
        if (g < 7) SG_LOAD(g + 1);
        __syncthreads();
        bf16x8 Av[4];
#pragma unroll
        for (int kb = 0; kb < 4; ++kb) { const LAS unsigned char* vp = L + SG4_T + (32 * kb + 8 * rq + tq) * SGT_STRIDE + (16 * w + 4 * tp) * 2; Av[kb] = cat8(tr_read(vp), tr_read(vp + 4 * SGT_STRIDE)); }
#pragma unroll
        for (int qt = 0; qt < 8; ++qt) {
            f32x4 a0 = (f32x4){0.f, 0.f, 0.f, 0.f};
#pragma unroll
            for (int kb = 0; kb < 4; ++kb) { if (qt < 4 && kb >= 2) continue;
                const int f = qt < 4 ? 2 * qt + kb : 8 + 4 * (qt - 4) + kb;
                const bf16x8 Bw = *(const LAS bf16x8*)(L + SG4_W + f * 1024 + lane * 16);
                a0 = __builtin_amdgcn_mfma_f32_16x16x32_bf16(Av[kb], Bw, a0, 0, 0, 0); }
            const f32x4 a = a0 + bq[qt];
            LAS u32x2* up = (LAS u32x2*)(L + SG4_U + (16 * qt + l15) * SGT_STRIDE + (16 * w + 4 * rq) * 2);
            const u32x2 u2 = *up;
            u32x2 wv; wv.x = cvt_pk_bf16(a[0] * bf_lo(u2.x), a[1] * bf_hi(u2.x)); wv.y = cvt_pk_bf16(a[2] * bf_lo(u2.y), a[3] * bf_hi(u2.y));
            *up = wv;
        }
        __syncthreads();
        if (g < 7) SG_WPUT();
#pragma unroll
        for (int i = 0; i < 4; ++i) *(u32x4*)(Yc + ((t0 + 32 * i) * DM + g * 128) * 2 + yoff) = *(const LAS u32x4*)(L + SG4_U + slds + i * 32 * SGT_STRIDE);
    }
#undef SG_LOAD
#undef SG_WPUT
}

__device__ __forceinline__ float wave_sum_dpp(float v) {
    v += __builtin_bit_cast(float, __builtin_amdgcn_update_dpp(0, __builtin_bit_cast(int, v), 0xB1, 0xF, 0xF, true));
    v += __builtin_bit_cast(float, __builtin_amdgcn_update_dpp(0, __builtin_bit_cast(int, v), 0x4E, 0xF, 0xF, true));
    v += __builtin_bit_cast(float, __builtin_amdgcn_update_dpp(0, __builtin_bit_cast(int, v), 0x141, 0xF, 0xF, true));
    v += __builtin_bit_cast(float, __builtin_amdgcn_update_dpp(0, __builtin_bit_cast(int, v), 0x140, 0xF, 0xF, true));
    const int iv = __builtin_bit_cast(int, v);
    return (__builtin_bit_cast(float, __builtin_amdgcn_readlane(iv, 0)) + __builtin_bit_cast(float, __builtin_amdgcn_readlane(iv, 16))) +
           (__builtin_bit_cast(float, __builtin_amdgcn_readlane(iv, 32)) + __builtin_bit_cast(float, __builtin_amdgcn_readlane(iv, 48)));
}
constexpr int RX_STRIDE = 2064, RX_H = 0, RX_L = 16 * RX_STRIDE, RX_PART = 2 * 16 * RX_STRIDE, RX_LOG = RX_PART + 8 * 2 * 1024, RX_END = RX_LOG + 2048;
static_assert(RX_END <= RING_BYTES, "router LDS");
__device__ __forceinline__ void ln_router_phase(Frame& F, int l, int cnt_off, const float* router_w, const float* router_b, const float* ln1_g, const float* ln1_b) {
    LAS unsigned char* L = F.lds;
    LAS int* LCNT = (LAS int*)(F.lds + LCNT_OFF); LAS int* LBASE = (LAS int*)(F.lds + LBASE_OFF); LAS int* LSEL = (LAS int*)(F.lds + LSEL_OFF);
    const int tid = F.tid, lane = F.lane, w = F.wave, l15 = lane & 15, rq = lane >> 4;
    const bf16* Z = WSP(bf16, WS_Z); bf16* X1b = WSP(bf16, WS_X1B); float* st1 = WSP(float, WS_ST1);
    int* selinfo = WSP(int, WS_SEL); float* gates = (float*)(selinfo + (size_t)T * 4); int* tok_list = WSP(int, WS_TOK);
    unsigned* cnt = F.ctl + CW_CNT + cnt_off + l * NE;
    const float* lg = ln1_g + (size_t)l * DM; const float* lb = ln1_b + (size_t)l * DM;
    f32x4 gv[4], bv[4];
#pragma unroll
    for (int j = 0; j < 4; ++j) { gv[j] = *(const f32x4*)(lg + 4 * lane + 256 * j); bv[j] = *(const f32x4*)(lb + 4 * lane + 256 * j); }
    bf16x8 Bh[4][2], Bl[4][2];
    { const float* rw = router_w + (size_t)l * DM * NE;
#pragma unroll
      for (int ks = 0; ks < 4; ++ks)
#pragma unroll
          for (int et = 0; et < 2; ++et) { float x[8];
#pragma unroll
              for (int j = 0; j < 8; ++j) x[j] = rw[(size_t)(128 * w + 32 * ks + 8 * rq + j) * NE + 16 * et + l15];
              u32x4 h, lo;
#pragma unroll
              for (int p = 0; p < 4; ++p) { const unsigned hp = cvt_pk_bf16(x[2 * p], x[2 * p + 1]); h[p] = hp; lo[p] = cvt_pk_bf16(x[2 * p] - bf_lo(hp), x[2 * p + 1] - bf_hi(hp)); }
              Bh[ks][et] = __builtin_bit_cast(bf16x8, h); Bl[ks][et] = __builtin_bit_cast(bf16x8, lo); } }
    const float rbias = router_b[(size_t)l * NE + (lane & 31)];
    for (int chunk = F.bid; chunk < T / 128; chunk += F.G) {
        if (tid < 32) LCNT[tid] = 0;
        __syncthreads();
        const size_t cbase = (size_t)chunk * 128;
        u32x2 nx[4];
#pragma unroll
        for (int j = 0; j < 4; ++j) nx[j] = *(const u32x2*)(Z + (cbase + 2 * w) * DM + 4 * lane + 256 * j);
#pragma unroll 1
        for (int r = 0; r < 8; ++r) {
#pragma unroll
            for (int q = 0; q < 2; ++q) { const int tl = 16 * r + 2 * w + q; const size_t t = cbase + tl;
                f32x4 v[4]; float s = 0.f;
#pragma unroll
                for (int j = 0; j < 4; ++j) { v[j] = (f32x4){bf_lo(nx[j].x), bf_hi(nx[j].x), bf_lo(nx[j].y), bf_hi(nx[j].y)}; s += (v[j][0] + v[j][1]) + (v[j][2] + v[j][3]); }
                { const int tn = q == 0 ? tl + 1 : (r < 7 ? tl + 15 : tl);
#pragma unroll
                  for (int j = 0; j < 4; ++j) nx[j] = *(const u32x2*)(Z + (cbase + tn) * DM + 4 * lane + 256 * j); }
                const float mean = wave_sum_dpp(s) * (1.0f / DM); float s2 = 0.f;
#pragma unroll
                for (int j = 0; j < 4; ++j) { v[j] = v[j] - mean; s2 += (v[j][0] * v[j][0] + v[j][1] * v[j][1]) + (v[j][2] * v[j][2] + v[j][3] * v[j][3]); }
                const float rstd = 1.0f / sqrtf(wave_sum_dpp(s2) * (1.0f / DM) + LN_EPS);
                if (lane == 0) *(f32x2*)(st1 + t * 2) = (f32x2){mean, rstd};
#pragma unroll
                for (int j = 0; j < 4; ++j) { v[j] = v[j] * rstd * gv[j] + bv[j];
                    if (MOE_FP8) *(unsigned*)((unsigned char*)X1b + t * DM + 4 * lane + 256 * j) = cvt4_fp8(v[j][0] * 4.0f, v[j][1] * 4.0f, v[j][2] * 4.0f, v[j][3] * 4.0f);
                    else { u32x2 wv; wv.x = cvt_pk_bf16(v[j][0], v[j][1]); wv.y = cvt_pk_bf16(v[j][2], v[j][3]); *(u32x2*)(X1b + t * DM + 4 * lane + 256 * j) = wv; }
                    u32x2 h, lo; h.x = cvt_pk_bf16(v[j][0], v[j][1]); h.y = cvt_pk_bf16(v[j][2], v[j][3]);
                    lo.x = cvt_pk_bf16(v[j][0] - bf_lo(h.x), v[j][1] - bf_hi(h.x)); lo.y = cvt_pk_bf16(v[j][2] - bf_lo(h.y), v[j][3] - bf_hi(h.y));
                    *(LAS u32x2*)(L + RX_H + (2 * w + q) * RX_STRIDE + (4 * lane + 256 * j) * 2) = h; *(LAS u32x2*)(L + RX_L + (2 * w + q) * RX_STRIDE + (4 * lane + 256 * j) * 2) = lo; } }
            __syncthreads();
            f32x4 acc[2] = {(f32x4){0.f, 0.f, 0.f, 0.f}, (f32x4){0.f, 0.f, 0.f, 0.f}};
#pragma unroll
            for (int ks = 0; ks < 4; ++ks) {
                const bf16x8 ah = *(const LAS bf16x8*)(L + RX_H + l15 * RX_STRIDE + (128 * w + 32 * ks + 8 * rq) * 2), al = *(const LAS bf16x8*)(L + RX_L + l15 * RX_STRIDE + (128 * w + 32 * ks + 8 * rq) * 2);
#pragma unroll
                for (int et = 0; et < 2; ++et) { acc[et] = __builtin_amdgcn_mfma_f32_16x16x32_bf16(ah, Bh[ks][et], acc[et], 0, 0, 0); acc[et] = __builtin_amdgcn_mfma_f32_16x16x32_bf16(ah, Bl[ks][et], acc[et], 0, 0, 0);
                    acc[et] = __builtin_amdgcn_mfma_f32_16x16x32_bf16(al, Bh[ks][et], acc[et], 0, 0, 0); } }
            *(LAS f32x4*)(L + RX_PART + ((w * 2 + 0) * 64 + lane) * 16) = acc[0]; *(LAS f32x4*)(L + RX_PART + ((w * 2 + 1) * 64 + lane) * 16) = acc[1];
            __syncthreads();
            { const int tk = 2 * w + (lane >> 5), e = lane & 31, src = ((e >> 4) * 64 + (tk >> 2) * 16 + (e & 15)) * 16 + (tk & 3) * 4; float sum = rbias;
#pragma unroll
              for (int v8 = 0; v8 < 8; ++v8) sum += *(const LAS float*)(L + RX_PART + v8 * 2048 + src);
              *(LAS float*)(L + RX_LOG + (tk * 32 + e) * 4) = sum; }
            LDS_WAIT();
            if ((lane & 31) == 0) {
                const int tk = 2 * w + (lane >> 5), tl = 16 * r + tk; const size_t t = cbase + tl;
                float v0 = -INFINITY, v1 = -INFINITY, v2 = -INFINITY, v3 = -INFINITY; int e0 = 0, e1 = 0, e2 = 0, e3 = 0;
#pragma unroll
                for (int q4 = 0; q4 < 8; ++q4) { const f32x4 lv = *(const LAS f32x4*)(L + RX_LOG + (tk * 32 + 4 * q4) * 4);
#pragma unroll
                    for (int jj = 0; jj < 4; ++jj) { const float x = lv[jj]; const int e = 4 * q4 + jj;
                        const bool c0 = x > v0, c1 = x > v1, c2 = x > v2, c3 = x > v3;
                        v3 = c2 ? v2 : (c3 ? x : v3); e3 = c2 ? e2 : (c3 ? e : e3);
                        v2 = c1 ? v1 : (c2 ? x : v2); e2 = c1 ? e1 : (c2 ? e : e2);
                        v1 = c0 ? v0 : (c1 ? x : v1); e1 = c0 ? e0 : (c1 ? e : e1);
                        v0 = c0 ? x : v0; e0 = c0 ? e : e0; } }
                const float p1 = __expf(v1 - v0), p2 = __expf(v2 - v0), p3 = __expf(v3 - v0), inv = 1.0f / (1.0f + p1 + p2 + p3);
                const int te[4] = {e0, e1, e2, e3};
#pragma unroll
                for (int k = 0; k < 4; ++k) { const int lp = __hip_atomic_fetch_add(&LCNT[te[k]], 1, __ATOMIC_RELAXED, __HIP_MEMORY_SCOPE_WORKGROUP); LSEL[tl * 4 + k] = (te[k] << 16) | lp; }
                *(f32x4*)(gates + t * 4) = (f32x4){inv, p1 * inv, p2 * inv, p3 * inv};
            }
        }
        __syncthreads();
        if (tid < 32) LBASE[tid] = (int)__hip_atomic_fetch_add(cnt + tid, (unsigned)LCNT[tid], __ATOMIC_RELAXED, __HIP_MEMORY_SCOPE_AGENT);
        __syncthreads();
        { const int sidx = tid, v = LSEL[sidx], e = v >> 16, pos = LBASE[e] + (v & 0xffff); const int t = chunk * 128 + (sidx >> 2);
          tok_list[(size_t)e * T + pos] = t; selinfo[(size_t)t * 4 + (sidx & 3)] = (e << 16) | pos; }
        __syncthreads();
    }
}

__device__ __forceinline__ void moe_tables(Frame& F, int l, bool fill_idx, int nN) {
    LAS int* TS = (LAS int*)(F.lds + TSTART_OFF); LAS int* LC = (LAS int*)(F.lds + LCNT_OFF); LAS int* IDX = (LAS int*)(F.lds + IDX_OFF);
    const unsigned* cnt = F.ctl + CW_CNT + l * NE;
    __syncthreads();
    if (F.tid < 64) {
        const int e = F.tid & 31; const int c = (int)__hip_atomic_load(cnt + e, __ATOMIC_RELAXED, __HIP_MEMORY_SCOPE_AGENT); const int tl = (c + 255) >> 8;
        int inc = tl;
#pragma unroll
        for (int o = 1; o < 32; o <<= 1) { const int y = __shfl_up(inc, o, 32); if (e >= o) inc += y; }
        if (F.tid < 32) { LC[e] = c; TS[e] = inc - tl; if (e == 31) TS[32] = inc; } }
    __syncthreads();
    if (fill_idx) {
        const int* tok_list = WSP(int, WS_TOK); const int ntile = TS[32];
        int tv[IDX_SLOTS];
#pragma unroll
        for (int s = 0; s < IDX_SLOTS; ++s) { int mtg, pn_; pg8::moe_unit_map(s, F.bid, nN, F.G, mtg, pn_); tv[s] = 0;
            if (mtg < ntile && F.tid < 256) { int e = 0; for (int k = 1; k < 32; ++k) e += (TS[k] <= mtg) ? 1 : 0;
                const int r = (mtg - TS[e]) * 256 + F.tid; if (r < LC[e]) tv[s] = tok_list[(size_t)e * T + r]; } }
        if (F.tid < 256) {
#pragma unroll
            for (int s = 0; s < IDX_SLOTS; ++s) IDX[s * 256 + F.tid] = tv[s]; }
        __syncthreads();
    }
}

#if MOE_FP8
typedef unsigned YR_T;
#define YR_LOAD(row_, j_) __builtin_nontemporal_load((const unsigned*)((const unsigned char*)Yr + (row_) * DM + 4 * lane + 256 * (j_)))
#else
typedef u32x2 YR_T;
#define YR_LOAD(row_, j_) (*(const u32x2*)(Yr + (row_) * DM + 4 * lane + 256 * (j_)))
#endif
__device__ __forceinline__ void combine_phase(Frame& F, int l, float* Xo, const float* ln1_g, const float* ln1_b, const float* ln2_g, const float* ln2_b) {
    LAS int* TS = (LAS int*)(F.lds + TSTART_OFF);
    const int lane = F.lane;
    const bf16* Z = WSP(bf16, WS_Z); const float* st1 = WSP(float, WS_ST1); const bf16* Yr = WSP(bf16, WS_YRAW);
    const int* selinfo = WSP(int, WS_SEL); const float* gates = (const float*)(selinfo + (size_t)T * 4);
    bf16* Xb = WSP(bf16, WS_XB);
    const float* lg1 = ln1_g + (size_t)l * DM; const float* lb1 = ln1_b + (size_t)l * DM; const float* lg = ln2_g + (size_t)l * DM; const float* lb = ln2_b + (size_t)l * DM;
    f32x4 gv[4], bv[4], g1v[4], b1v[4];
#pragma unroll
    for (int j = 0; j < 4; ++j) { gv[j] = *(const f32x4*)(lg + 4 * lane + 256 * j); bv[j] = *(const f32x4*)(lb + 4 * lane + 256 * j); g1v[j] = *(const f32x4*)(lg1 + 4 * lane + 256 * j); b1v[j] = *(const f32x4*)(lb1 + 4 * lane + 256 * j); }
    const int tfirst = F.bid * NWAVES + F.wave, tstep = F.G * NWAVES;
    const int ntok = (T - tfirst + tstep - 1) / tstep;
    i32x4 si_n; f32x4 gt_n;
    u32x2 zr[4]; YR_T yr[4][4]; f32x2 ms; f32x4 gt_c;
    { const i32x4 s0 = *(const i32x4*)(selinfo + (size_t)tfirst * 4); gt_c = *(const f32x4*)(gates + (size_t)tfirst * 4); ms = *(const f32x2*)(st1 + (size_t)tfirst * 2);
#pragma unroll
      for (int j = 0; j < 4; ++j) zr[j] = __builtin_nontemporal_load((const u32x2*)(Z + (size_t)tfirst * DM + 4 * lane + 256 * j));
#pragma unroll
      for (int k = 0; k < 4; ++k) { const size_t row = (size_t)TS[s0[k] >> 16] * 256 + (s0[k] & 0xffff);
#pragma unroll
          for (int j = 0; j < 4; ++j) yr[k][j] = YR_LOAD(row, j); }
      const int t1 = tfirst + tstep < T ? tfirst + tstep : tfirst; si_n = *(const i32x4*)(selinfo + (size_t)t1 * 4); gt_n = *(const f32x4*)(gates + (size_t)t1 * 4); }
    for (int i = 0; i < ntok; ++i) {
        const int t = tfirst + i * tstep;
        f32x4 v[4];
#pragma unroll
        for (int j = 0; j < 4; ++j) { const f32x4 zf = (f32x4){bf_lo(zr[j].x), bf_hi(zr[j].x), bf_lo(zr[j].y), bf_hi(zr[j].y)};
            v[j] = ((zf - ms.x) * ms.y * g1v[j] + b1v[j]) * DN_ALPHA; }
#pragma unroll
        for (int k = 0; k < 4; ++k)
#pragma unroll
            for (int j = 0; j < 4; ++j) {
#if MOE_FP8
                const int y = (int)yr[k][j]; const float gt = gt_c[k] * (1.0f / 16.0f);
                v[j][0] += gt * __builtin_amdgcn_cvt_f32_fp8(y, 0); v[j][1] += gt * __builtin_amdgcn_cvt_f32_fp8(y, 1); v[j][2] += gt * __builtin_amdgcn_cvt_f32_fp8(y, 2); v[j][3] += gt * __builtin_amdgcn_cvt_f32_fp8(y, 3);
#else
                const u32x2 y = yr[k][j]; const float gt = gt_c[k];
                v[j][0] += gt * bf_lo(y.x); v[j][1] += gt * bf_hi(y.x); v[j][2] += gt * bf_lo(y.y); v[j][3] += gt * bf_hi(y.y);
#endif
            }
        if (i + 1 < ntok) { const int tn = t + tstep; const i32x4 s1 = si_n; gt_c = gt_n; ms = *(const f32x2*)(st1 + (size_t)tn * 2);
#pragma unroll
            for (int j = 0; j < 4; ++j) zr[j] = __builtin_nontemporal_load((const u32x2*)(Z + (size_t)tn * DM + 4 * lane + 256 * j));
#pragma unroll
            for (int k = 0; k < 4; ++k) { const size_t row = (size_t)TS[s1[k] >> 16] * 256 + (s1[k] & 0xffff);
#pragma unroll
                for (int j = 0; j < 4; ++j) yr[k][j] = YR_LOAD(row, j); }
            const int t2 = tn + tstep < T ? tn + tstep : tn; si_n = *(const i32x4*)(selinfo + (size_t)t2 * 4); gt_n = *(const f32x4*)(gates + (size_t)t2 * 4); }
        float s = 0.f;
#pragma unroll
        for (int j = 0; j < 4; ++j) s += (v[j][0] + v[j][1]) + (v[j][2] + v[j][3]);
        const float mean = wave_sum_dpp(s) * (1.0f / DM); float s2 = 0.f;
#pragma unroll
        for (int j = 0; j < 4; ++j) { v[j] = v[j] - mean; s2 += (v[j][0] * v[j][0] + v[j][1] * v[j][1]) + (v[j][2] * v[j][2] + v[j][3] * v[j][3]); }
        const float rstd = 1.0f / sqrtf(wave_sum_dpp(s2) * (1.0f / DM) + LN_EPS);
#pragma unroll
        for (int j = 0; j < 4; ++j) { v[j] = v[j] * rstd * gv[j] + bv[j];
            if (Xo) *(f32x4*)(Xo + (size_t)t * DM + 4 * lane + 256 * j) = v[j];
            if (!Xo) { u32x2 wv; wv.x = cvt_pk_bf16(v[j][0], v[j][1]); wv.y = cvt_pk_bf16(v[j][2], v[j][3]); *(u32x2*)(Xb + (size_t)t * DM + 4 * lane + 256 * j) = wv; }
            if (INPROJ_FP8 && !Xo) *(unsigned*)(WSP(unsigned char, WS_XQ) + (size_t)t * DM + 4 * lane + 256 * j) = cvt4_fp8(v[j][0] * 4.0f, v[j][1] * 4.0f, v[j][2] * 4.0f, v[j][3] * 4.0f); }
    }
}

constexpr int NPH = 8, N_PHASES = 1 + NL * NPH;
struct Args { const float* in[19]; float* out; unsigned char* ws; int ph_lo, ph_hi; };
static_assert(sizeof(Args) == 19 * 8 + 8 + 8 + 8, "Args has no padding");

__global__ void __launch_bounds__(NTHREADS, 2) mk_fwd(Args args) {
    extern __shared__ __attribute__((aligned(16))) unsigned char lds_raw[];
    Frame F;
    F.lds = (LAS unsigned char*)lds_raw; F.MISC = (volatile LAS unsigned*)(F.lds + MISC_OFF);
    F.tid = threadIdx.x; F.lane = F.tid & 63; F.wave = __builtin_amdgcn_readfirstlane(F.tid >> 6); F.G = gridDim.x; F.bid = blockIdx.x;
    F.ws = args.ws; F.ctl = (unsigned*)(args.ws + WS_CTL);
    if (F.tid < 16) F.MISC[F.tid] = 0u;
    __syncthreads();
    XcdBarrier bar; bar.bar = F.ctl + CW_BAR; bar.x = 0; bar.st = nullptr;
    if (MK_N_LAUNCHES == 1) bar = xcd_barrier_post(F.ctl + CW_BAR, F.MISC + 8);
    const int lo = args.ph_lo, hi = args.ph_hi;
#ifndef PH_MASK
#define PH_MASK 0x1ff
#endif
#define PHON(p) ((PH_MASK >> (p)) & 1)
#ifndef PROBE_DUP
#define PROBE_DUP 0
#endif
#define DUP(p) for (int rep_ = 0; rep_ < 1 + ((PROBE_DUP >> (p)) & 1); ++rep_, frame_refresh(F))
#define IN(k) (lo <= (k) && (k) < hi)
#define REFRESH() frame_refresh(F)
#ifndef PROBE_BAR2
#define PROBE_BAR2 0
#endif
#define SEAM(k) do { if (IN((k) + 1)) { if (MK_N_LAUNCHES == 1) { xcd_barrier(bar); if (PROBE_BAR2) xcd_barrier(bar); } } } while (0)

    if (PHON(8) && IN(0)) { REFRESH(); DUP(8) p0_prologue(F, args.in[0], args.in[1], args.in[2], args.in[7], args.in[8], args.in[5], args.in[13], args.in[15]); SEAM(0); }

    for (int l = 0; l < NL; ++l) {
        const int pb = 1 + l * NPH;
        int z = 0; asm volatile("" : "+s"(z));
#define ARGP(i) (args.in[(i) + z])
        if (PHON(0) && IN(pb + 0)) { REFRESH(); DUP(0) {
            pg8::InProjSched S{INPROJ_FP8 ? (const char*)WSP(unsigned char, WS_XQ) : (const char*)WSP(bf16, WS_XB), (const char*)WSP(unsigned char, WS_WIN) + (size_t)l * INW * DM * (INPROJ_FP8 ? 1 : 2), INPROJ_FP8 ? DM : 2 * DM, F.G, F.bid};
            EpiInProj E{WSP(bf16, WS_P), WSP(bf16, WS_ROPEB), WSP(unsigned char, WS_PG8)};
            pg8::gemm_phase<EpiInProj, pg8::InProjSched, false, true, F8_SP2 != 0, INPROJ_FP8 != 0>(F.lds, INPROJ_FP8 ? DM : 2 * DM, S, E); }
            SEAM(pb + 0);
        }
        if (PHON(1) && IN(pb + 1)) { REFRESH();
            DUP(1) {
#ifndef NO_RET
                if (F.bid < 192) for (int r2 = 0; r2 < 1 + ((PROBE_DUP >> 10) & 1); ++r2, frame_refresh(F)) ret_prepass(F, (F.bid / 3) >> 2, (F.bid / 3) & 3, F.bid % 3);
#endif
#ifndef NO_SGU
                for (int r2 = 0; r2 < 1 + ((PROBE_DUP >> 9) & 1); ++r2, frame_refresh(F)) sgu_unit(F, F.bid, l, ARGP(6), ARGP(3), ARGP(4));
#endif
                if (MK_N_LAUNCHES == 1) xcd_barrier(bar);
                REFRESH();
#ifndef NO_RET
                for (int r2 = 0; r2 < 1 + ((PROBE_DUP >> 11) & 1); ++r2, frame_refresh(F)) ret_unit(F, F.bid >> 4, (F.bid >> 2) & 3, F.bid & 3);
#endif
            }
            SEAM(pb + 1);
        }
        if (PHON(2) && IN(pb + 2)) { REFRESH(); DUP(2) {
            { pg8::DenseSched S; S.init(WSP(bf16, WS_YRET), WSP(bf16, WS_PRET) + (size_t)l * DM * DM, T, DM, DM, F.G, F.bid);
              EpiGate1 E{WSP(bf16, WS_P), WSP(bf16, WS_HF), WSP(unsigned char, WS_PG8)};
              pg8::gemm_phase<EpiGate1, pg8::DenseSched, false, true, true>(F.lds, 2 * DM, S, E); }
            { pg8::DenseSched S; S.init(WSP(bf16, WS_YSG), WSP(bf16, WS_PSG) + (size_t)l * DM * DM, T, DM, DM, F.G, F.bid);
              EpiGate2 E{WSP(bf16, WS_P), WSP(bf16, WS_HF), WSP(bf16, WS_HB), WSP(unsigned char, WS_PG8)};
              pg8::gemm_phase<EpiGate2, pg8::DenseSched, false, true, true>(F.lds, 2 * DM, S, E); } }
            SEAM(pb + 2);
        }
        if (PHON(3) && IN(pb + 3)) { REFRESH(); DUP(3) {
            pg8::DenseSched S; S.init(WSP(bf16, WS_HB), WSP(bf16, WS_WO) + (size_t)l * DM * DM, T, DM, DM, F.G, F.bid);
            EpiResid E{(l == 0) ? ARGP(0) : (const float*)nullptr, WSP(bf16, WS_XB), WSP(bf16, WS_Z)};
            pg8::gemm_phase<EpiResid, pg8::DenseSched, false, true, true>(F.lds, 2 * DM, S, E); }
            SEAM(pb + 3);
        }
        if (PHON(4) && IN(pb + 4)) { REFRESH();
#if (PROBE_DUP >> 4) & 1
            ln_router_phase(F, l, 128, ARGP(11), ARGP(12), ARGP(9), ARGP(10)); xcd_barrier(bar); REFRESH();
#endif
            ln_router_phase(F, l, 0, ARGP(11), ARGP(12), ARGP(9), ARGP(10)); SEAM(pb + 4); }
        if (PHON(5) && IN(pb + 5)) { REFRESH(); DUP(5) {
            moe_tables(F, l, true, 2 * DEXP / 256);
            constexpr int EB = MOE_FP8 ? 1 : 2;
            pg8::MoeSched<true> S{(const char*)WSP(bf16, WS_X1B), (const char*)WSP(unsigned char, WS_W1) + (size_t)l * NE * 2 * DEXP * DM * EB, DM * EB, 2 * DEXP, 2 * DEXP / 256, F.G, F.bid,
                                  (const LAS int*)(F.lds + TSTART_OFF), (const LAS int*)(F.lds + IDX_OFF)};
            EpiSwiglu E{WSP(bf16, WS_ACT), ARGP(14) + (size_t)l * NE * 2 * DEXP};
            pg8::gemm_phase<EpiSwiglu, pg8::MoeSched<true>, true, true, F8_SP2 != 0, MOE_FP8 != 0>(F.lds, DM * EB, S, E); }
            SEAM(pb + 5);
        }
        if (PHON(6) && IN(pb + 6)) { REFRESH(); DUP(6) {
            moe_tables(F, l, false, DM / 256);
            constexpr int EB = MOE_FP8 ? 1 : 2;
            pg8::MoeSched<false> S{(const char*)WSP(bf16, WS_ACT), (const char*)WSP(unsigned char, WS_W2) + (size_t)l * NE * DM * DEXP * EB, DEXP * EB, DM, DM / 256, F.G, F.bid,
                                   (const LAS int*)(F.lds + TSTART_OFF), (const LAS int*)(F.lds + IDX_OFF)};
            EpiBias E{WSP(bf16, WS_YRAW), ARGP(16) + (size_t)l * NE * DM};
            pg8::gemm_phase<EpiBias, pg8::MoeSched<false>, false, true, F8_SP2 != 0, MOE_FP8 != 0>(F.lds, DEXP * EB, S, E); }
            SEAM(pb + 6);
        }
        if (PHON(7) && IN(pb + 7)) { REFRESH(); moe_tables(F, l, false, 1); DUP(7) combine_phase(F, l, (l == NL - 1) ? args.out : (float*)nullptr, ARGP(9), ARGP(10), ARGP(17), ARGP(18)); SEAM(pb + 7); }
    }
#undef IN
#undef SEAM
#undef ARGP
#undef REFRESH
}

extern "C" void kernel_launch(void* const* d_in, const int* in_sizes, int n_in, void* d_out, int out_size, void* d_ws, size_t ws_size, hipStream_t stream) {
    static int grid = 0;
    if (grid == 0) {
        if (n_in != 19 || in_sizes[0] != T * DM || out_size != T * DM || ws_size < WS_END) { fprintf(stderr, "kernel_launch: unexpected shapes (n_in %d, in0 %d, out %d, ws %zu)\n", n_in, n_in > 0 ? in_sizes[0] : -1, out_size, ws_size); grid = -1; return; }
        int dev = 0, cus = 0, per_cu = 0;
        if (hipGetDevice(&dev) != hipSuccess || hipDeviceGetAttribute(&cus, hipDeviceAttributeMultiprocessorCount, dev) != hipSuccess) { fprintf(stderr, "kernel_launch: device query failed\n"); grid = -1; return; }
        if (hipFuncSetAttribute((const void*)mk_fwd, hipFuncAttributeMaxDynamicSharedMemorySize, LDS_BYTES) != hipSuccess) { fprintf(stderr, "kernel_launch: hipFuncSetAttribute failed\n"); grid = -1; return; }
        if (hipOccupancyMaxActiveBlocksPerMultiprocessor(&per_cu, (const void*)mk_fwd, NTHREADS, LDS_BYTES) != hipSuccess || per_cu < 1) fprintf(stderr, "kernel_launch: occupancy query reports %d blocks per CU\n", per_cu);
        (void)hipGetLastError();
        grid = cus < 256 ? cus : 256;
        if (grid != 256) fprintf(stderr, "kernel_launch: %d CUs; the MoE row tables assume 256 workgroups\n", grid);
    }
    if (grid < 0) return;
    (void)hipMemsetAsync((char*)d_ws + WS_CTL, 0, CTL_ZERO_BYTES, stream);
    Args a{};
    for (int i = 0; i < 19; ++i) a.in[i] = (const float*)d_in[i];
    a.out = (float*)d_out; a.ws = (unsigned char*)d_ws;
    if (MK_N_LAUNCHES == 1) {
        a.ph_lo = 0; a.ph_hi = N_PHASES;
        hipLaunchKernelGGL(mk_fwd, dim3(grid), dim3(NTHREADS), LDS_BYTES, stream, a);
    } else {
        for (int p = 0; p < N_PHASES; ++p) { a.ph_lo = p; a.ph_hi = p + 1; hipLaunchKernelGGL(mk_fwd, dim3(grid), dim3(NTHREADS), LDS_BYTES, stream, a); }
    }
    const hipError_t le = hipPeekAtLastError();
    if (le != hipSuccess) fprintf(stderr, "kernel_launch: launch failed: %s\n", hipGetErrorName(le));
}
```

```cpp
#include <hip/hip_runtime.h>
#include <cstdio>
#include <cstdint>

#ifndef MK_N_LAUNCHES
#define MK_N_LAUNCHES 1
#endif

#ifndef INPROJ_FP8
#define INPROJ_FP8 1
#endif
#ifndef GATE_U8
#define GATE_U8 1
#endif
#ifndef MOE_BIAS_LDS
#define MOE_BIAS_LDS 1
#endif
#ifndef F8_SP2
#define F8_SP2 0
#endif
#ifndef MOE_FP8
#define MOE_FP8 1
#endif
#define LAS __attribute__((address_space(3)))
#define GAS __attribute__((address_space(1)))
typedef unsigned short bf16;
typedef short bf16x8 __attribute__((ext_vector_type(8)));
typedef short s16x4 __attribute__((ext_vector_type(4)));
typedef float f32x4 __attribute__((ext_vector_type(4)));
typedef float f32x2 __attribute__((ext_vector_type(2)));
typedef unsigned u32x4 __attribute__((ext_vector_type(4)));
typedef unsigned u32x2 __attribute__((ext_vector_type(2)));
typedef int i32x4 __attribute__((ext_vector_type(4)));
typedef GAS unsigned gu32;

constexpr int DM = 1024, NBATCH = 16, SEQ = 2048, T = NBATCH * SEQ, NL = 4;
constexpr int INW = 7168, NE = 32, TOPK = 4, DEXP = 1024;
constexpr int C_Q = 0, C_K = 512, C_V = 1024, C_G = 2048, C_U = 3072, C_VS = 4096, C_GA = 5120, C_GB = 6144;
constexpr float LN_EPS = 1e-5f, DN_ALPHA = 1.681792830507429f;
constexpr int AROWS = T * TOPK + NE * 256;
constexpr int NWAVES = 8, NTHREADS = 512;

constexpr size_t MiB = 1u << 20;
constexpr size_t WS_CTL = 0, CTL_ZERO_BYTES = 65536;
constexpr size_t WS_ST1 = 256 * 1024;
constexpr size_t WS_ROPE = 1 * MiB;
constexpr size_t WS_ROPEB = (1944 + 100) * MiB;
constexpr size_t WS_SEL = 2 * MiB;
constexpr size_t WS_TOK = 3 * MiB;
constexpr size_t WS_SGW = 7 * MiB;
constexpr size_t WS_WIN = 8 * MiB;
constexpr size_t WS_PRET = 64 * MiB, WS_PSG = 72 * MiB, WS_WO = 80 * MiB;
constexpr size_t WS_W1 = 88 * MiB;
constexpr size_t WS_W2 = 600 * MiB;
constexpr size_t WS_XF = 856 * MiB;
constexpr size_t WS_XB = 984 * MiB;
constexpr size_t WS_XQ = 856 * MiB;
constexpr size_t WS_P = 1048 * MiB;
constexpr size_t WS_YRET = 1496 * MiB, WS_YSG = 1560 * MiB;
constexpr size_t WS_HF = 1624 * MiB;
constexpr size_t WS_HB = 1752 * MiB;
constexpr size_t WS_Z = 1816 * MiB;
constexpr size_t WS_X1F = 1944 * MiB;
constexpr size_t WS_PG8 = (1944 + 32) * MiB;
constexpr size_t WS_X1B = 2072 * MiB;
constexpr size_t WS_ACT = 2136 * MiB;
constexpr size_t WS_YRAW = 2408 * MiB;
constexpr size_t WS_END = 2680 * MiB;
static_assert((size_t)AROWS * 1024 * 2 <= 272 * MiB, "expert row buffers");
constexpr int CW_TMO = 0, CW_CODE = 1, CW_BAR = 4096, CW_CNT = 8192;

constexpr int RING_BYTES = 131072;
constexpr int IDX_OFF = RING_BYTES, IDX_SLOTS = 18;
constexpr int TSTART_OFF = IDX_OFF + IDX_SLOTS * 1024;
constexpr int LCNT_OFF = TSTART_OFF + 256, LBASE_OFF = LCNT_OFF + 128, LSEL_OFF = LBASE_OFF + 128;
constexpr int MISC_OFF = LSEL_OFF + 2048;
constexpr int LDS_BYTES = 163840;
constexpr int BIAS_OFF = 153600;
static_assert(MISC_OFF + 64 <= BIAS_OFF && BIAS_OFF + 2048 <= LDS_BYTES, "LDS map");

#define RLX_AGENT __ATOMIC_RELAXED, __HIP_MEMORY_SCOPE_AGENT
#define LDS_WAIT() asm volatile("s_waitcnt lgkmcnt(0)" ::: "memory")
#define VM_WAIT() asm volatile("s_waitcnt vmcnt(0)" ::: "memory")
__device__ __forceinline__ unsigned cvt_pk_bf16(float lo, float hi) { unsigned r; asm volatile("v_cvt_pk_bf16_f32 %0, %1, %2" : "=v"(r) : "v"(lo), "v"(hi)); return r; }
__device__ __forceinline__ unsigned cvt4_fp8(float a, float b, float c, float d) { int w = __builtin_amdgcn_cvt_pk_fp8_f32(a, b, 0, false); w = __builtin_amdgcn_cvt_pk_fp8_f32(c, d, w, true); return (unsigned)w; }
__device__ __forceinline__ void unpack8_u8(const u32x2 w, f32x4& a, f32x4& b) {
    a = (f32x4){(float)(w.x & 0xffu), (float)((w.x >> 8) & 0xffu), (float)((w.x >> 16) & 0xffu), (float)(w.x >> 24)} * (1.0f / 255.0f);
    b = (f32x4){(float)(w.y & 0xffu), (float)((w.y >> 8) & 0xffu), (float)((w.y >> 16) & 0xffu), (float)(w.y >> 24)} * (1.0f / 255.0f); }
__device__ __forceinline__ unsigned pack4_u8(const f32x4 s) { return (unsigned)(s[0] * 255.0f + 0.5f) | ((unsigned)(s[1] * 255.0f + 0.5f) << 8) | ((unsigned)(s[2] * 255.0f + 0.5f) << 16) | ((unsigned)(s[3] * 255.0f + 0.5f) << 24); }
__device__ __forceinline__ float bf_lo(unsigned w) { return __uint_as_float(w << 16); }
__device__ __forceinline__ float bf_hi(unsigned w) { return __uint_as_float(w & 0xffff0000u); }
__device__ __forceinline__ float sigmoidf_(float x) { return __builtin_amdgcn_rcpf(1.0f + __builtin_amdgcn_exp2f(x * -1.4426950408889634f)); }
__device__ __forceinline__ float siluf_(float x) { return x * sigmoidf_(x); }
__device__ __forceinline__ float geluf_(float x) { return x * sigmoidf_(1.5957691216057308f * (x + 0.044715f * x * x * x)); }
__device__ __forceinline__ float lg2_gamma(int h) { return h == 0 ? -0.04580368961312479f : h == 1 ? -0.018003552928331026f : h == 2 ? -0.007117849617096985f : -0.0028205190623786626f; }
__device__ __forceinline__ int opaque_tid() { int t = threadIdx.x; asm volatile("" : "+v"(t)); return t; }
__device__ __forceinline__ float wave_sum(float v) {
#pragma unroll
    for (int o = 1; o < 64; o <<= 1) v += __shfl_xor(v, o);
    return v;
}

#define XB_TMO      128
#define XB_XCNT(j)  (256  + 64 * (j))
#define XB_XSUB(j)  (1280 + 64 * (j))
#define XB_XGEN(j)  (2304 + 64 * (j))
#define XB_TOP      3328
#define XB_TOPGEN   3392
#define XCD_BAR_WORDS 3456
#define XB_SPIN_CAP (1u << 18)
__device__ __forceinline__ unsigned xb_ld(unsigned* p)              { return __hip_atomic_load(p, __ATOMIC_RELAXED, __HIP_MEMORY_SCOPE_AGENT); }
__device__ __forceinline__ unsigned xb_add(unsigned* p, unsigned v) { return __hip_atomic_fetch_add(p, v, __ATOMIC_RELAXED, __HIP_MEMORY_SCOPE_AGENT); }
__device__ __forceinline__ unsigned xb_xcc_id() { return (unsigned)__builtin_amdgcn_s_getreg((3 << 11) | 20) & 0xFu; }
#define XB_SPIN(cond, bar) do { unsigned _sp = 0; while (cond) { __builtin_amdgcn_s_sleep(1); \
    if ((++_sp & 255u) == 0u) { if (xb_ld(&(bar)[XB_TMO])) break; if (_sp > XB_SPIN_CAP) { atomicAdd(&(bar)[XB_TMO], 1u); break; } } } } while (0)
struct XcdBarrier { unsigned* bar; unsigned x; volatile LAS unsigned* st; };
__device__ __forceinline__ XcdBarrier xcd_barrier_post(unsigned* bar, volatile LAS unsigned* st) {
    XcdBarrier b; b.bar = bar; b.x = xb_xcc_id(); b.st = st;
    if (threadIdx.x == 0) (void)xb_add(&bar[XB_XCNT(b.x)], 1u);
    return b;
}
__device__ __forceinline__ void xcd_barrier_complete(unsigned* bar, unsigned x, unsigned& nloc, unsigned& nx) {
    const unsigned G = gridDim.x * gridDim.y * gridDim.z;
    unsigned sum, cnt, mine, sp = 0u;
    for (;;) {
        sum = 0u; cnt = 0u; mine = 0u;
#pragma unroll
        for (unsigned j = 0; j < 16; ++j) { const unsigned c = xb_ld(&bar[XB_XCNT(j)]); sum += c; cnt += (c > 0u) ? 1u : 0u; mine = (j == x) ? c : mine; }
        if (sum == G) break;
        __builtin_amdgcn_s_sleep(1);
        if ((++sp & 255u) == 0u) { if (xb_ld(&bar[XB_TMO])) break; if (sp > XB_SPIN_CAP) { atomicAdd(&bar[XB_TMO], 1u); break; } }
    }
    nloc = mine > 0u ? mine : 1u; nx = cnt > 0u ? cnt : 1u;
}
__device__ __forceinline__ void xcd_barrier(const XcdBarrier& b) {
    asm volatile("s_waitcnt vmcnt(0)" ::: "memory");
    __syncthreads();
    if (threadIdx.x == 0) {
        unsigned* bar = b.bar;
        __builtin_amdgcn_s_waitcnt(0);
        unsigned nloc = b.st[0], nx = b.st[1];
        if (nloc == 0u) { xcd_barrier_complete(bar, b.x, nloc, nx); b.st[0] = nloc; b.st[1] = nx; }
        const unsigned old = xb_add(&bar[XB_XSUB(b.x)], 1u);
        const unsigned gen = old / nloc;
        if (old + 1u == (gen + 1u) * nloc) {
            __builtin_amdgcn_fence(__ATOMIC_RELEASE, "agent");
            asm volatile("s_waitcnt vmcnt(0)" ::: "memory");
            const unsigned og = xb_add(&bar[XB_TOP], 1u);
            const unsigned tg = og / nx;
            if (og + 1u == (tg + 1u) * nx) xb_add(&bar[XB_TOPGEN], 1u);
            else XB_SPIN(xb_ld(&bar[XB_TOPGEN]) == tg, bar);
            __builtin_amdgcn_fence(__ATOMIC_ACQUIRE, "agent");
            xb_add(&bar[XB_XGEN(b.x)], 1u);
            asm volatile("s_waitcnt vmcnt(0)" ::: "memory");
        } else {
            XB_SPIN(xb_ld(&bar[XB_XGEN(b.x)]) == gen, bar);
            __builtin_amdgcn_fence(__ATOMIC_ACQUIRE, "agent");
            asm volatile("s_waitcnt vmcnt(0)" ::: "memory");
        }
    }
    __syncthreads();
}

namespace pg8 {
constexpr int BM = 256, BK = 64, HALF = 128, HTB = HALF * BK * 2, STAGE_BYTES = 8 * HTB, NXCD = 8, WGM = 8;
__host__ __device__ __forceinline__ int lds_byte(int r, int c) { const int st = (r >> 4) * 2 + (c >> 5), rr = r & 15, cc = c & 31, ob = rr * 64 + cc * 2; return st * 1024 + (ob ^ (((ob >> 9) & 1) << 5)); }
__host__ __device__ __forceinline__ void stage_rc(int b, int& R, int& C) { const int st = b / 1024, sb = b % 1024, swz = sb ^ (((sb >> 9) & 1) << 5); R = (st >> 1) * 16 + swz / 64; C = (st & 1) * 32 + (swz % 64) / 2; }
__host__ __device__ __forceinline__ int perm32(int rho) { const int n = rho >> 4, i = rho & 15; return 8 * (i >> 2) + 4 * n + (i & 3); }

struct Unit { const char* a; const char* b; int r0, c0, e, slot; };

struct StaticOrder {
    int nM, nN, nwg, G, c;
    __device__ void init(int M, int N, int G_, int c_) { nM = M / BM; nN = N / BM; nwg = nM * nN; G = G_; c = c_; }
    __device__ bool next(int i, int& pm, int& pn) const {
        const long L = (long)i * G + c; if (L >= nwg) return false;
        int wgid = (int)L; { const int q = nwg / NXCD, r = nwg % NXCD, xcd = wgid % NXCD, off = wgid / NXCD; wgid = (xcd < r ? xcd * (q + 1) : r * (q + 1) + (xcd - r) * q) + off; }
        const int nig = WGM * nN, gid = wgid / nig, fm = gid * WGM, gsz = (nM - fm) < WGM ? (nM - fm) : WGM;
        pm = fm + ((wgid % nig) % gsz); pn = (wgid % nig) / gsz; return true;
    }
};
struct DenseSched {
    const char* A; const char* Bt; int KB; StaticOrder so;
    __device__ void init(const bf16* A_, const bf16* Bt_, int M, int N, int K_, int G, int c) { A = (const char*)A_; Bt = (const char*)Bt_; KB = 2 * K_; so.init(M, N, G, c); }
    __device__ __forceinline__ bool next(int i, Unit& u) const { int pm, pn; if (!so.next(i, pm, pn)) return false;
        u.a = A + (size_t)pm * BM * KB; u.b = Bt + (size_t)pn * BM * KB; u.r0 = pm * BM; u.c0 = pn * BM; u.e = 0; u.slot = i; return true; }
    __device__ __forceinline__ void aoff(const Unit&, const int (&R)[2], const int (&C)[2], unsigned (&v)[2][2]) const {
#pragma unroll
        for (int h = 0; h < 2; ++h)
#pragma unroll
            for (int i = 0; i < 2; ++i) v[h][i] = (unsigned)((h * HALF + R[i]) * KB + C[i] * 2); }
};
struct InProjSched {
    const char* A; const char* Bt; int KB, G, c;
    __device__ __forceinline__ bool next(int i, Unit& u) const {
        const int L = i * G + c; if (L >= 128 * 28) return false;
        const int x = L & 7, off = L >> 3, blk = off >> 6, r = off & 63;
        const int pm = 16 * x + (r & 7) + 8 * (r >> 5), ob = blk == 0 ? 6 : blk == 1 ? 5 : blk == 2 ? 2 : blk == 3 ? 3 : blk == 4 ? 4 : blk == 5 ? 0 : 1, pn = 4 * ob + ((r >> 3) & 3);
        u.a = A + (size_t)pm * BM * KB; u.b = Bt + (size_t)pn * BM * KB; u.r0 = pm * BM; u.c0 = pn * BM; u.e = 0; u.slot = i; return true; }
    __device__ __forceinline__ void aoff(const Unit&, const int (&R)[2], const int (&C)[2], unsigned (&v)[2][2]) const {
#pragma unroll
        for (int h = 0; h < 2; ++h)
#pragma unroll
            for (int i = 0; i < 2; ++i) v[h][i] = (unsigned)((h * HALF + R[i]) * KB + C[i] * 2); }
};
__device__ __forceinline__ void moe_unit_map(int i, int c, int nN, int G, int& mtg, int& pn) {
    if (G == 256) { const int x = c & 7, r = c >> 3, mpx = 32 / nN; mtg = i * (256 / nN) + x * mpx + r / nN; pn = r % nN; }
    else { const int U = i * G + c; mtg = U / nN; pn = U - mtg * nN; } }
template <bool GATHER> struct MoeSched {
    const char* A; const char* Wt; int KB, N, nN, G, c; const LAS int* tstart; const LAS int* idx;
    __device__ __forceinline__ bool next(int i, Unit& u) const {
        int mtg, pn; moe_unit_map(i, c, nN, G, mtg, pn); if (mtg >= __builtin_amdgcn_readfirstlane(tstart[32])) return false;
        int e = 0;
#pragma unroll
        for (int k = 1; k < 32; ++k) e += (tstart[k] <= mtg) ? 1 : 0;
        e = __builtin_amdgcn_readfirstlane(e);
        u.e = e; u.r0 = mtg * BM; u.c0 = pn * BM; u.slot = i;
        u.a = GATHER ? A : A + (size_t)mtg * BM * KB; u.b = Wt + ((size_t)e * N + (size_t)pn * BM) * KB; return true; }
    __device__ __forceinline__ void aoff(const Unit& u, const int (&R)[2], const int (&C)[2], unsigned (&v)[2][2]) const {
#pragma unroll
        for (int h = 0; h < 2; ++h)
#pragma unroll
            for (int i = 0; i < 2; ++i) { const int row = GATHER ? idx[u.slot * 256 + h * HALF + R[i]] : (h * HALF + R[i]); v[h][i] = (unsigned)(row * KB + C[i] * 2); } }
};

typedef int v8i32 __attribute__((ext_vector_type(8)));
template <class E, class = void> struct has_bias_lds { static constexpr bool value = false; };
template <class E> struct has_bias_lds<E, decltype((void)E::BIAS_LDS)> { static constexpr bool value = E::BIAS_LDS; };
template <class E, class = void> struct has_probe2 { static constexpr bool value = false; };
template <class E> struct has_probe2<E, decltype((void)E::PROBE2)> { static constexpr bool value = true; };
template <class Epi, class Sched, bool GATHER, bool ALIGN_EPI, bool SP2, bool F8 = false>
__device__ __forceinline__ void gemm_phase(LAS unsigned char* lds, const int KB, const Sched& S, const Epi& E) {
    const int tid = opaque_tid(), wid = __builtin_amdgcn_readfirstlane(tid >> 6), lane = tid & 63, wr = wid >> 2, wc = wid & 3, fr = lane & 15, fq = lane >> 4;
    const int nt = KB / (2 * BK);
    int Rr[2], Cc[2]; unsigned voffB[2], voffB1[2];
#pragma unroll
    for (int i = 0; i < 2; ++i) { int R, C; stage_rc(tid * 16 + i * 8192, R, C); Rr[i] = R; Cc[i] = C; const int Rb = (R >> 5) * 64 + ((R & 15) >> 2) * 16 + ((R >> 4) & 1) * 4 + (R & 3);
        voffB[i] = (unsigned)(Rb * KB + C * 2); voffB1[i] = (unsigned)((Rb + 8) * KB + C * 2); }
    const size_t kstep = (size_t)(BK * 2);
    const size_t hstep = (size_t)HALF * KB;
    const unsigned ldsw = (unsigned)wid * 1024u;
    const int aoff = lds_byte(wr * 64 + fr, fq * 8), boff = lds_byte(wc * 32 + fr, fq * 8);
#define PG8_SA(b, h) (((b) * 2 + (h)) * HTB)
#define PG8_SB(b, h) ((4 + (b) * 2 + (h)) * HTB)
#define PG8_STAGE(bufoff, gbase, voff) do { _Pragma("unroll") for (int _i = 0; _i < 2; ++_i) \
        __builtin_amdgcn_global_load_lds((const unsigned*)((const char*)(gbase) + (voff)[_i]), (LAS unsigned*)(lds + (bufoff) + ldsw + _i * 8192), 16, 0, 0); } while (0)
#define PG8_CAT8(lo, hi) __builtin_bit_cast(v8i32, __builtin_shufflevector((lo), (hi), 0, 1, 2, 3, 4, 5, 6, 7, 8, 9, 10, 11, 12, 13, 14, 15))
#define PG8_LDA(dst, b, h) do { if constexpr (F8) { _Pragma("unroll") for (int m = 0; m < 4; ++m) dst##8[m] = PG8_CAT8(*(const LAS bf16x8*)(lds + PG8_SA(b, h) + aoff + m * 2048), *(const LAS bf16x8*)(lds + PG8_SA(b, h) + aoff + m * 2048 + 1024)); } \
        else { _Pragma("unroll") for (int m = 0; m < 4; ++m) _Pragma("unroll") for (int k = 0; k < 2; ++k) dst[m][k] = *(const LAS bf16x8*)(lds + PG8_SA(b, h) + aoff + m * 2048 + k * 1024); } } while (0)
#define PG8_LDB(dst, b, h) do { if constexpr (F8) { _Pragma("unroll") for (int n = 0; n < 2; ++n) dst##8[n] = PG8_CAT8(*(const LAS bf16x8*)(lds + PG8_SB(b, h) + boff + n * 2048), *(const LAS bf16x8*)(lds + PG8_SB(b, h) + boff + n * 2048 + 1024)); } \
        else { _Pragma("unroll") for (int n = 0; n < 2; ++n) _Pragma("unroll") for (int k = 0; k < 2; ++k) dst[n][k] = *(const LAS bf16x8*)(lds + PG8_SB(b, h) + boff + n * 2048 + k * 1024); } } while (0)
#define PG8_MMA(ai, bj, At, Bt) do { __builtin_amdgcn_s_setprio(1); \
        if constexpr (F8) { _Pragma("unroll") for (int m = 0; m < 4; ++m) _Pragma("unroll") for (int n = 0; n < 2; ++n) \
            asm volatile("v_mfma_f32_16x16x128_f8f6f4 %0, %1, %2, %0" : "+v"(acc[ai][bj][m][n]) : "v"(Bt##8[n]), "v"(At##8[m])); } \
        else { _Pragma("unroll") for (int m = 0; m < 4; ++m) _Pragma("unroll") for (int n = 0; n < 2; ++n) _Pragma("unroll") for (int k = 0; k < 2; ++k) \
            acc[ai][bj][m][n] = __builtin_amdgcn_mfma_f32_16x16x32_bf16(Bt[n][k], At[m][k], acc[ai][bj][m][n], 0, 0, 0); } \
        __builtin_amdgcn_s_setprio(0); } while (0)
#define PG8_WAIT_V(n) asm volatile("s_waitcnt vmcnt(" #n ")" ::: "memory")
#define PG8_WAIT_L(n) asm volatile("s_waitcnt lgkmcnt(" #n ")" ::: "memory")
#define PG8_BAR __builtin_amdgcn_s_barrier()
#define PG8_SCHED __builtin_amdgcn_sched_barrier(0)
    Unit cur, nxt; int ui = 0;
    if (!S.next(0, cur)) return;
    unsigned vA[2][2], vN[2][2];
    S.aoff(cur, Rr, Cc, vA);
    f32x4 acc[2][2][4][2];
#pragma unroll
    for (int a = 0; a < 2; ++a)
#pragma unroll
        for (int b = 0; b < 2; ++b)
#pragma unroll
            for (int m = 0; m < 4; ++m)
#pragma unroll
                for (int n = 0; n < 2; ++n) acc[a][b][m][n] = (f32x4){0.f, 0.f, 0.f, 0.f};
    bf16x8 At[4][2], B0[2][2], B1[2][2];
    v8i32 At8[4], B08[2], B18[2];
    const char* cA = cur.a; const char* cB = cur.b;
    if constexpr (has_bias_lds<Epi>::value) { if (wid == 0) E.bias_dma(cur, lane); }
    if constexpr (SP2) {
        PG8_STAGE(PG8_SB(0, 0), cB, voffB); PG8_STAGE(PG8_SB(0, 1), cB, voffB1); PG8_STAGE(PG8_SA(0, 0), cA, vA[0]); PG8_STAGE(PG8_SA(0, 1), cA, vA[1]);
        if (wr == 1) PG8_BAR;
        PG8_WAIT_V(2); PG8_BAR;
        PG8_STAGE(PG8_SB(1, 0), cB + kstep, voffB); PG8_STAGE(PG8_SA(1, 0), cA + kstep, vA[0]); PG8_STAGE(PG8_SB(1, 1), cB + kstep, voffB1);
        PG8_WAIT_V(6); PG8_BAR;
    } else {
        PG8_STAGE(PG8_SB(0, 0), cB, voffB); PG8_STAGE(PG8_SA(0, 0), cA, vA[0]); PG8_STAGE(PG8_SB(0, 1), cB, voffB1); PG8_STAGE(PG8_SA(0, 1), cA, vA[1]);
        if (wr == 1) PG8_BAR;
        PG8_WAIT_V(4); PG8_BAR;
        PG8_STAGE(PG8_SB(1, 0), cB + kstep, voffB); PG8_STAGE(PG8_SA(1, 0), cA + kstep, vA[0]); PG8_STAGE(PG8_SB(1, 1), cB + kstep, voffB1);
        PG8_WAIT_V(6); PG8_BAR;
    }
    for (;;) {
        const bool has_next = S.next(ui + 1, nxt);
        const char* nA = has_next ? nxt.a : cA; const char* nB = has_next ? nxt.b : cB;
        if (GATHER && has_next) S.aoff(nxt, Rr, Cc, vN);
        else {
#pragma unroll
            for (int h = 0; h < 2; ++h)
#pragma unroll
                for (int i = 0; i < 2; ++i) vN[h][i] = vA[h][i]; }
#pragma unroll 1
        for (int t = 0; t < nt; t += 2) {
            const bool last = (t == nt - 2);
            const char* a1 = cA + (size_t)(t + 1) * kstep;
            const char* a2 = last ? nA : cA + (size_t)(t + 2) * kstep; const char* b2 = last ? nB : cB + (size_t)(t + 2) * kstep;
            const char* a3 = a2 + kstep; const char* b3 = b2 + kstep;
            unsigned v2[2][2];
#pragma unroll
            for (int h = 0; h < 2; ++h)
#pragma unroll
                for (int i = 0; i < 2; ++i) v2[h][i] = last ? vN[h][i] : vA[h][i];
            if constexpr (SP2) {
            PG8_LDB(B0, 0, 0); PG8_LDB(B1, 0, 1); PG8_SCHED; PG8_LDA(At, 0, 0); PG8_STAGE(PG8_SA(1, 1), a1, vA[1]);
            PG8_WAIT_V(8); PG8_WAIT_L(0); PG8_BAR; PG8_MMA(0, 0, At, B0); PG8_MMA(0, 1, At, B1); PG8_BAR; PG8_SCHED;
            PG8_LDA(At, 0, 1); PG8_STAGE(PG8_SB(0, 0), b2, voffB); PG8_STAGE(PG8_SB(0, 1), b2, voffB1); PG8_STAGE(PG8_SA(0, 0), a2, v2[0]);
            PG8_WAIT_V(8); PG8_WAIT_L(0); PG8_BAR; PG8_MMA(1, 0, At, B0); PG8_MMA(1, 1, At, B1); PG8_BAR; PG8_SCHED;
            PG8_LDB(B0, 1, 0); PG8_LDB(B1, 1, 1); PG8_SCHED; PG8_LDA(At, 1, 0); PG8_STAGE(PG8_SA(0, 1), a2, v2[1]);
            PG8_WAIT_V(8); PG8_WAIT_L(0); PG8_BAR; PG8_MMA(0, 0, At, B0); PG8_MMA(0, 1, At, B1); PG8_BAR; PG8_SCHED;
            PG8_LDA(At, 1, 1); PG8_STAGE(PG8_SB(1, 0), b3, voffB); PG8_STAGE(PG8_SB(1, 1), b3, voffB1); PG8_STAGE(PG8_SA(1, 0), a3, v2[0]);
            PG8_WAIT_V(8); PG8_WAIT_L(0); PG8_BAR; PG8_MMA(1, 0, At, B0); PG8_MMA(1, 1, At, B1); PG8_BAR; PG8_SCHED;
            } else {
            PG8_LDB(B0, 0, 0); PG8_SCHED; PG8_LDA(At, 0, 0); PG8_STAGE(PG8_SA(1, 1), a1, vA[1]);
            PG8_WAIT_L(8); PG8_BAR; PG8_WAIT_L(0); PG8_MMA(0, 0, At, B0); PG8_BAR; PG8_SCHED;
            PG8_LDB(B1, 0, 1); PG8_STAGE(PG8_SB(0, 0), b2, voffB);
            PG8_BAR; PG8_WAIT_L(0); PG8_MMA(0, 1, At, B1); PG8_BAR;
            PG8_LDA(At, 0, 1); PG8_STAGE(PG8_SA(0, 0), a2, v2[0]);
            PG8_BAR; PG8_WAIT_L(0); PG8_MMA(1, 0, At, B0); PG8_BAR; PG8_SCHED;
            PG8_STAGE(PG8_SB(0, 1), b2, voffB1);
            PG8_WAIT_V(6); PG8_BAR; PG8_MMA(1, 1, At, B1); PG8_BAR;
            PG8_LDB(B0, 1, 0); PG8_SCHED; PG8_LDA(At, 1, 0); PG8_STAGE(PG8_SA(0, 1), a2, v2[1]);
            PG8_WAIT_L(8); PG8_BAR; PG8_WAIT_L(0); PG8_MMA(0, 0, At, B0); PG8_BAR; PG8_SCHED;
            PG8_LDB(B1, 1, 1); PG8_STAGE(PG8_SB(1, 0), b3, voffB);
            PG8_BAR; PG8_WAIT_L(0); PG8_MMA(0, 1, At, B1); PG8_BAR;
            PG8_LDA(At, 1, 1); PG8_STAGE(PG8_SA(1, 0), a3, v2[0]);
            PG8_BAR; PG8_WAIT_L(0); PG8_MMA(1, 0, At, B0); PG8_BAR; PG8_SCHED;
            PG8_STAGE(PG8_SB(1, 1), b3, voffB1);
            PG8_WAIT_V(6); PG8_BAR; PG8_MMA(1, 1, At, B1); PG8_BAR;
            }
        }
        if constexpr (ALIGN_EPI) { if (wr == 0) PG8_BAR; }
        if constexpr (F8) asm volatile("s_nop 15\n\ts_nop 15" ::: "memory");
        { int fr_e = fr, fq_e = fq; asm volatile("" : "+v"(fr_e), "+v"(fq_e));
          E(acc, cur, wr, wc, fr_e, fq_e);
#if defined(PROBE_EPI2)
          if constexpr (has_probe2<Epi>::value) { asm volatile("" : "+v"(fr_e), "+v"(fq_e)); E(acc, cur, wr, wc, fr_e, fq_e); }
#endif
        }
        if (!has_next) break;
        if constexpr (has_bias_lds<Epi>::value) { if (wid == 0) E.bias_dma(nxt, lane); }
#pragma unroll
        for (int a = 0; a < 2; ++a)
#pragma unroll
            for (int b = 0; b < 2; ++b)
#pragma unroll
                for (int m = 0; m < 4; ++m)
#pragma unroll
                    for (int n = 0; n < 2; ++n) acc[a][b][m][n] = (f32x4){0.f, 0.f, 0.f, 0.f};
        cur = nxt; cA = nA; cB = nB; ++ui;
#pragma unroll
        for (int h = 0; h < 2; ++h)
#pragma unroll
            for (int i = 0; i < 2; ++i) vA[h][i] = vN[h][i];
        if constexpr (ALIGN_EPI) { if (wr == 1) PG8_BAR; }
    }
    PG8_WAIT_V(0);
    if constexpr (!ALIGN_EPI) { if (wr == 0) PG8_BAR; }
    PG8_BAR;
#undef PG8_SA
#undef PG8_SB
#undef PG8_STAGE
#undef PG8_LDA
#undef PG8_LDB
#undef PG8_MMA
#undef PG8_CAT8
#undef PG8_WAIT_V
#undef PG8_WAIT_L
#undef PG8_BAR
#undef PG8_SCHED
}
}
typedef f32x4 AccT[2][2][4][2];

#define EPI_LOOP(...) \
    _Pragma("unroll") for (int ai = 0; ai < 2; ++ai) _Pragma("unroll") for (int m = 0; m < 4; ++m) { const int row = u.r0 + ai * 128 + wr * 64 + m * 16 + fr; u32x4 ow[2]; \
    _Pragma("unroll") for (int bj = 0; bj < 2; ++bj) { const int col = u.c0 + wc * 64 + 16 * fq + 8 * bj; const f32x4 v0 = acc[ai][bj][m][0], v1 = acc[ai][bj][m][1]; __VA_ARGS__ } \
    EPI_STORE(u.r0 + ai * 128 + wr * 64 + m * 16, u.c0 + wc * 64 + 16 * fq, ow); }
#ifndef EPI_PIPE_A
#define EPI_PIPE_A 1
#endif
#ifndef EPI_PIPE_C1
#define EPI_PIPE_C1 1
#endif
#ifndef EPI_PIPE_C2
#define EPI_PIPE_C2 1
#endif
#ifndef EPI_PIPE_D
#define EPI_PIPE_D 1
#endif
#define EPI_LD_BATCH_(LD) _Pragma("unroll") for (int mm = 0; mm < 2; ++mm) { const int row = u.r0 + ai * 128 + wr * 64 + (2 * mp + mm) * 16 + fr; \
    _Pragma("unroll") for (int bj = 0; bj < 2; ++bj) { const int col = u.c0 + wc * 64 + 16 * fq + 8 * bj; LD } }
#define EPI_LOOP_LD(NLD, LD, ...) { u32x4 ldq[2][2][2][NLD]; \
    { constexpr int ai = 0, mp = 0; auto& ld = ldq[0]; EPI_LD_BATCH_(LD) } \
    _Pragma("unroll") for (int q = 0; q < 4; ++q) { \
    if (EPI_PIPE && q < 3) { const int ai = (q + 1) >> 1, mp = (q + 1) & 1; auto& ld = ldq[(q + 1) & 1]; EPI_LD_BATCH_(LD) } \
    { const int ai = q >> 1, mp = q & 1; auto& ld = ldq[EPI_PIPE ? (q & 1) : 0]; if (!EPI_PIPE && q > 0) { EPI_LD_BATCH_(LD) } \
    _Pragma("unroll") for (int mm = 0; mm < 2; ++mm) { const int m = 2 * mp + mm; const int row = u.r0 + ai * 128 + wr * 64 + m * 16 + fr; u32x4 ow[2]; \
    _Pragma("unroll") for (int bj = 0; bj < 2; ++bj) { const int col = u.c0 + wc * 64 + 16 * fq + 8 * bj; const f32x4 v0 = acc[ai][bj][m][0] * EPI_SCALE, v1 = acc[ai][bj][m][1] * EPI_SCALE; __VA_ARGS__ } \
    EPI_STORE(u.r0 + ai * 128 + wr * 64 + m * 16, u.c0 + wc * 64 + 16 * fq, ow); } } } }
__device__ __forceinline__ void store_pair16(bf16* base, int ld, int R0, int fr, int col16, const u32x4 (&ow)[2]) {
    const bool lo = fr < 8; u32x4 recv;
#pragma unroll
    for (int j = 0; j < 4; ++j) { const unsigned snd = lo ? ow[1][j] : ow[0][j]; recv[j] = (unsigned)__builtin_amdgcn_update_dpp(0, (int)snd, 0x128, 0xF, 0xF, true); }
    u32x4 d1, d2;
#pragma unroll
    for (int j = 0; j < 4; ++j) { d1[j] = lo ? ow[0][j] : recv[j]; d2[j] = lo ? recv[j] : ow[1][j]; }
    bf16* p = base + (size_t)(R0 + (fr & 7)) * ld + col16 + (lo ? 0 : 8);
    *(u32x4*)p = d1; *(u32x4*)(p + (size_t)8 * ld) = d2;
}
__device__ __forceinline__ u32x4 pack8(const f32x4 a, const f32x4 b) { u32x4 w; w.x = cvt_pk_bf16(a[0], a[1]); w.y = cvt_pk_bf16(a[2], a[3]); w.z = cvt_pk_bf16(b[0], b[1]); w.w = cvt_pk_bf16(b[2], b[3]); return w; }
__device__ __forceinline__ void unpack8(const u32x4 w, f32x4& a, f32x4& b) { a = (f32x4){bf_lo(w.x), bf_hi(w.x), bf_lo(w.y), bf_hi(w.y)}; b = (f32x4){bf_lo(w.z), bf_hi(w.z), bf_lo(w.w), bf_hi(w.w)}; }

#define EPI_STORE(R0_, C16_, OW_) do { if (ST_G8) *(u32x4*)(ST_G8 + (size_t)((R0_) + fr) * (2 * DM) + ((C16_) - C_GA)) = (u32x4){OW_[0].x, OW_[0].y, OW_[1].x, OW_[1].y}; else store_pair16(ST_BASE, ST_LD, R0_, fr, C16_, OW_); } while (0)
struct EpiInProj {
#if defined(PROBE_EPI2) && PROBE_EPI2 == 1
    static constexpr bool PROBE2 = true;
#endif
    bf16* P; const bf16* rcs; unsigned char* PG8;
    __device__ __forceinline__ void operator()(const AccT& acc, const pg8::Unit& u, int wr, int wc, int fr, int fq) const {
        const int c0 = __builtin_amdgcn_readfirstlane(u.c0);
        const int mode = c0 < C_K ? 0 : c0 < C_V ? 1 : c0 < C_G ? 2 : c0 < C_U ? 3 : c0 < C_GA ? 4 : 5;
        switch (mode) { case 0: run<0>(acc, u, wr, wc, fr, fq); break; case 1: run<1>(acc, u, wr, wc, fr, fq); break; case 2: run<2>(acc, u, wr, wc, fr, fq); break;
                        case 3: run<3>(acc, u, wr, wc, fr, fq); break; case 4: run<4>(acc, u, wr, wc, fr, fq); break; default: run<5>(acc, u, wr, wc, fr, fq); break; }
    }
    template <int mode> __device__ __forceinline__ void run(const AccT& acc, const pg8::Unit& u, int wr, int wc, int fr, int fq) const {
        bf16* const ST_BASE = P; constexpr int ST_LD = INW; constexpr float EPI_SCALE = INPROJ_FP8 ? 1.0f / 256.0f : 1.0f; constexpr bool EPI_PIPE = EPI_PIPE_A != 0;
        unsigned char* const ST_G8 = (GATE_U8 && mode == 5) ? PG8 : nullptr;
        EPI_LOOP_LD(1, if (mode <= 1) { const int pos = row & (SEQ - 1); const int jg = (col & 127) >> 3; ld[mm][bj][0] = *(const u32x4*)(rcs + (pos * 16 + jg) * 8); } ,
            f32x4 o0, o1;
            if (mode <= 1) {
                const int pos = row & (SEQ - 1), h = (col & 511) >> 7;
                f32x4 cs, sn; unpack8(ld[mm][bj][0], cs, sn);
                const float lg = lg2_gamma(h) * (float)(pos & 63);
                const float sc = mode == 0 ? __builtin_amdgcn_exp2f(lg) : __builtin_amdgcn_exp2f(-lg) * 0.08838834764831845f;
                o0 = (v0 * cs - v1 * sn) * sc; o1 = (v0 * sn + v1 * cs) * sc;
            } else if (mode == 2) { o0 = v0; o1 = v1; }
            else if (mode == 3) { _Pragma("unroll") for (int j = 0; j < 4; ++j) { o0[j] = siluf_(v0[j]); o1[j] = siluf_(v1[j]); } }
            else if (mode == 4) { _Pragma("unroll") for (int j = 0; j < 4; ++j) { o0[j] = geluf_(v0[j]); o1[j] = geluf_(v1[j]); } }
            else { _Pragma("unroll") for (int j = 0; j < 4; ++j) { o0[j] = sigmoidf_(v0[j]); o1[j] = sigmoidf_(v1[j]); } }
            if (GATE_U8 && mode == 5) { ow[bj].x = pack4_u8(o0); ow[bj].y = pack4_u8(o1); } else
            ow[bj] = pack8(o0, o1);
        )
    }
};
struct EpiGate1 {
    const bf16* P; bf16* H1; const unsigned char* PG8;
    __device__ __forceinline__ void operator()(const AccT& acc, const pg8::Unit& u, int wr, int wc, int fr, int fq) const {
        bf16* const ST_BASE = H1; constexpr int ST_LD = DM; constexpr float EPI_SCALE = 1.0f; unsigned char* const ST_G8 = nullptr; constexpr bool EPI_PIPE = EPI_PIPE_C1 != 0;
        EPI_LOOP_LD(1, if (GATE_U8) { const u32x2 q8 = *(const u32x2*)(PG8 + (size_t)row * (2 * DM) + col); ld[mm][bj][0].x = q8.x; ld[mm][bj][0].y = q8.y; } else ld[mm][bj][0] = *(const u32x4*)(P + (size_t)row * INW + C_GA + col); ,
            f32x4 g0, g1; if (GATE_U8) unpack8_u8((u32x2){ld[mm][bj][0].x, ld[mm][bj][0].y}, g0, g1); else unpack8(ld[mm][bj][0], g0, g1);
            ow[bj] = pack8(v0 * g0, v1 * g1);
        )
    }
};
struct EpiGate2 {
    const bf16* P; const bf16* H1; bf16* Hb; const unsigned char* PG8;
    __device__ __forceinline__ void operator()(const AccT& acc, const pg8::Unit& u, int wr, int wc, int fr, int fq) const {
        bf16* const ST_BASE = Hb; constexpr int ST_LD = DM; constexpr float EPI_SCALE = 1.0f; unsigned char* const ST_G8 = nullptr; constexpr bool EPI_PIPE = EPI_PIPE_C2 != 0;
        EPI_LOOP_LD(2, if (GATE_U8) { const u32x2 q8 = *(const u32x2*)(PG8 + (size_t)row * (2 * DM) + DM + col); ld[mm][bj][0].x = q8.x; ld[mm][bj][0].y = q8.y; } else ld[mm][bj][0] = *(const u32x4*)(P + (size_t)row * INW + C_GB + col); ld[mm][bj][1] = *(const u32x4*)(H1 + (size_t)row * DM + col); ,
            f32x4 g0, g1, h0, h1; if (GATE_U8) unpack8_u8((u32x2){ld[mm][bj][0].x, ld[mm][bj][0].y}, g0, g1); else unpack8(ld[mm][bj][0], g0, g1); unpack8(ld[mm][bj][1], h0, h1);
            ow[bj] = pack8(h0 + v0 * g0, h1 + v1 * g1);
        )
    }
};
struct EpiResid {
    const float* Xf; const bf16* Xb; bf16* Z;
    __device__ __forceinline__ void operator()(const AccT& acc, const pg8::Unit& u, int wr, int wc, int fr, int fq) const {
        bf16* const ST_BASE = Z; constexpr int ST_LD = DM; constexpr float EPI_SCALE = 1.0f; unsigned char* const ST_G8 = nullptr; constexpr bool EPI_PIPE = EPI_PIPE_D != 0;
        EPI_LOOP_LD(2, if (Xf) { ld[mm][bj][0] = *(const u32x4*)(Xf + (size_t)row * DM + col); ld[mm][bj][1] = *(const u32x4*)(Xf + (size_t)row * DM + col + 4); } else ld[mm][bj][0] = *(const u32x4*)(Xb + (size_t)row * DM + col); ,
            f32x4 x0, x1;
            if (Xf) { x0 = __builtin_bit_cast(f32x4, ld[mm][bj][0]); x1 = __builtin_bit_cast(f32x4, ld[mm][bj][1]); }
            else unpack8(ld[mm][bj][0], x0, x1);
            ow[bj] = pack8(x0 * DN_ALPHA + v0, x1 * DN_ALPHA + v1);
        )
    }
};
struct EpiSwiglu {
#if defined(PROBE_EPI2) && PROBE_EPI2 == 3
    static constexpr bool PROBE2 = true;
#endif
    bf16* Act; const float* b1; LAS unsigned char* L;
    static constexpr bool BIAS_LDS = MOE_BIAS_LDS != 0;
    __device__ __forceinline__ void bias_dma(const pg8::Unit& u, int lane) const {
        const float* src = b1 + (size_t)u.e * 2 * DEXP + (u.c0 >> 1) + (lane < 32 ? lane * 4 : DEXP + (lane - 32) * 4);
        __builtin_amdgcn_global_load_lds((const unsigned*)src, (LAS unsigned*)(L + BIAS_OFF + (u.slot & 1) * 1024), 16, 0, 0); }
    __device__ __forceinline__ void operator()(const AccT& acc, const pg8::Unit& u, int wr, int wc, int fr, int fq) const {
        const int j0 = (u.c0 >> 1) + wc * 32 + 8 * fq;
        const float* be = b1 + (size_t)u.e * 2 * DEXP + j0;
        f32x4 bg0, bg1, bu0, bu1;
        if (BIAS_LDS) { const LAS float* bl = (const LAS float*)(L + BIAS_OFF + (u.slot & 1) * 1024) + wc * 32 + 8 * fq;
            bg0 = *(const LAS f32x4*)bl; bg1 = *(const LAS f32x4*)(bl + 4); bu0 = *(const LAS f32x4*)(bl + 128); bu1 = *(const LAS f32x4*)(bl + 132); }
        else { bg0 = *(const f32x4*)be; bg1 = *(const f32x4*)(be + 4); bu0 = *(const f32x4*)(be + DEXP); bu1 = *(const f32x4*)(be + DEXP + 4); }
        constexpr float sc = MOE_FP8 ? 1.0f / 256.0f : 1.0f;
#pragma unroll
        for (int ai = 0; ai < 2; ++ai)
#pragma unroll
            for (int m = 0; m < 4; ++m) { const int row = u.r0 + ai * 128 + wr * 64 + m * 16 + fr;
                const f32x4 hg0 = acc[ai][0][m][0] * sc + bg0, hg1 = acc[ai][0][m][1] * sc + bg1, hu0 = acc[ai][1][m][0] * sc + bu0, hu1 = acc[ai][1][m][1] * sc + bu1; float a[8];
#pragma unroll
                for (int j = 0; j < 4; ++j) { const float g0 = fminf(hg0[j], 7.0f), u0 = fminf(fmaxf(hu0[j], -7.0f), 7.0f), g1 = fminf(hg1[j], 7.0f), u1 = fminf(fmaxf(hu1[j], -7.0f), 7.0f);
                    a[j] = g0 * sigmoidf_(1.702f * g0) * (u0 + 1.0f); a[4 + j] = g1 * sigmoidf_(1.702f * g1) * (u1 + 1.0f); }
                if (MOE_FP8) { u32x2 w; w.x = cvt4_fp8(a[0] * 4.0f, a[1] * 4.0f, a[2] * 4.0f, a[3] * 4.0f); w.y = cvt4_fp8(a[4] * 4.0f, a[5] * 4.0f, a[6] * 4.0f, a[7] * 4.0f); *(u32x2*)((unsigned char*)Act + (size_t)row * DEXP + j0) = w; }
                else { u32x4 w; w.x = cvt_pk_bf16(a[0], a[1]); w.y = cvt_pk_bf16(a[2], a[3]); w.z = cvt_pk_bf16(a[4], a[5]); w.w = cvt_pk_bf16(a[6], a[7]); *(u32x4*)(Act + (size_t)row * DEXP + j0) = w; } }
    }
};
struct EpiBias {
    bf16* Y; const float* b2; LAS unsigned char* L;
    static constexpr bool BIAS_LDS = MOE_BIAS_LDS != 0;
    __device__ __forceinline__ void bias_dma(const pg8::Unit& u, int lane) const {
        __builtin_amdgcn_global_load_lds((const unsigned*)(b2 + (size_t)u.e * DM + u.c0 + lane * 4), (LAS unsigned*)(L + BIAS_OFF + (u.slot & 1) * 1024), 16, 0, 0); }
    __device__ __forceinline__ void operator()(const AccT& acc, const pg8::Unit& u, int wr, int wc, int fr, int fq) const {
        const float* be = b2 + (size_t)u.e * DM; f32x4 b0a[2], b1a[2];
#pragma unroll
        for (int bj = 0; bj < 2; ++bj) { const int cc = u.c0 + wc * 64 + 16 * fq + 8 * bj;
            if (BIAS_LDS) { const LAS float* bl = (const LAS float*)(L + BIAS_OFF + (u.slot & 1) * 1024) + wc * 64 + 16 * fq + 8 * bj; b0a[bj] = *(const LAS f32x4*)bl; b1a[bj] = *(const LAS f32x4*)(bl + 4); }
            else { b0a[bj] = *(const f32x4*)(be + cc); b1a[bj] = *(const f32x4*)(be + cc + 4); } }
        bf16* const ST_BASE = Y; constexpr int ST_LD = DM; unsigned char* const ST_G8 = nullptr;
        if (MOE_FP8) {
#pragma unroll
            for (int ai = 0; ai < 2; ++ai)
#pragma unroll
                for (int m = 0; m < 4; ++m) { const int row = u.r0 + ai * 128 + wr * 64 + m * 16 + fr; u32x4 w;
#pragma unroll
                    for (int bj = 0; bj < 2; ++bj) { const f32x4 y0 = (acc[ai][bj][m][0] * (1.0f / 512.0f) + b0a[bj]) * 16.0f, y1 = (acc[ai][bj][m][1] * (1.0f / 512.0f) + b1a[bj]) * 16.0f;
                        w[2 * bj] = cvt4_fp8(y0[0], y0[1], y0[2], y0[3]); w[2 * bj + 1] = cvt4_fp8(y1[0], y1[1], y1[2], y1[3]); }
                    *(u32x4*)((unsigned char*)Y + (size_t)row * DM + u.c0 + wc * 64 + 16 * fq) = w; }
        } else {
        EPI_LOOP(
            const f32x4 b0v = b0a[bj], b1v = b1a[bj];
            ow[bj] = pack8(v0 + b0v, v1 + b1v);
        )
        }
    }
};

struct Frame {
    LAS unsigned char* lds; volatile LAS unsigned* MISC; unsigned* ctl;
    int tid, lane, wave, G, bid;
    unsigned char* ws;
};
#define WSP(T_, off) ((T_*)(F.ws + (off)))
__device__ __forceinline__ void frame_refresh(Frame& F) { F.tid = opaque_tid(); F.lane = F.tid & 63; F.wave = __builtin_amdgcn_readfirstlane(F.tid >> 6);
    int b_ = blockIdx.x, g_ = gridDim.x; asm volatile("" : "+s"(b_), "+s"(g_)); F.bid = b_; F.G = g_; }

template <class FN>
__device__ __forceinline__ void transpose_item(const float* __restrict__ W, int N, bf16* __restrict__ WT, int K, int k0, int n0, FN srccol, LAS float* scr, int lane) {
    const int dq = lane & 15, ks = lane >> 4; const int sc = srccol(n0 + 4 * dq);
    f32x4 v[16];
#pragma unroll
    for (int it = 0; it < 16; ++it) v[it] = *(const f32x4*)(W + (size_t)(k0 + 4 * it + ks) * N + sc);
#pragma unroll
    for (int it = 0; it < 16; ++it) { LAS float* d = scr + (4 * it + ks) * 65 + 4 * dq; d[0] = v[it][0]; d[1] = v[it][1]; d[2] = v[it][2]; d[3] = v[it][3]; }
    LDS_WAIT();
    const int c = lane >> 3, ns = lane & 7;
#pragma unroll
    for (int j = 0; j < 8; ++j) { const int n = 8 * j + ns; const LAS float* s = scr + (8 * c) * 65 + n;
        u32x4 o; o.x = cvt_pk_bf16(s[0], s[65]); o.y = cvt_pk_bf16(s[2 * 65], s[3 * 65]); o.z = cvt_pk_bf16(s[4 * 65], s[5 * 65]); o.w = cvt_pk_bf16(s[6 * 65], s[7 * 65]);
        *(u32x4*)(WT + (size_t)(n0 + n) * K + k0 + 8 * c) = o; }
    LDS_WAIT();
}
template <class FN>
__device__ __forceinline__ void transpose_item_f8(const float* __restrict__ W, int N, unsigned char* __restrict__ WT, int K, int k0, int n0, FN srccol, float scale, LAS float* scr, int lane) {
    const int dq = lane & 7, ks = lane >> 3; const int sc = srccol(n0 + 4 * dq);
    f32x4 v[16];
#pragma unroll
    for (int it = 0; it < 16; ++it) v[it] = *(const f32x4*)(W + (size_t)(k0 + 8 * it + ks) * N + sc);
#pragma unroll
    for (int it = 0; it < 16; ++it) { LAS float* d = scr + (8 * it + ks) * 33 + 4 * dq; d[0] = v[it][0] * scale; d[1] = v[it][1] * scale; d[2] = v[it][2] * scale; d[3] = v[it][3] * scale; }
    LDS_WAIT();
    const int c = lane & 7, ns = lane >> 3;
#pragma unroll
    for (int j = 0; j < 4; ++j) { const int n = 8 * j + ns; const LAS float* s = scr + (16 * c) * 33 + n;
        u32x4 o; o.x = cvt4_fp8(s[0], s[33], s[2 * 33], s[3 * 33]); o.y = cvt4_fp8(s[4 * 33], s[5 * 33], s[6 * 33], s[7 * 33]);
        o.z = cvt4_fp8(s[8 * 33], s[9 * 33], s[10 * 33], s[11 * 33]); o.w = cvt4_fp8(s[12 * 33], s[13 * 33], s[14 * 33], s[15 * 33]);
        *(u32x4*)(WT + (size_t)(n0 + n) * K + k0 + 16 * c) = o; }
    LDS_WAIT();
}
struct ColId { __device__ int operator()(int n) const { return n; } };
struct ColQK { __device__ int operator()(int n) const { if (n >= C_V) return n; const int cl = n & 127, g8 = cl >> 3, i = cl & 7; return (n & ~127) + (i < 4 ? 4 * g8 + i : 64 + 4 * g8 + (i - 4)); } };
struct ColGU { __device__ int operator()(int n) const { const int pn = n >> 8, wi = n & 255, hid = pn * 128 + (wi >> 4) * 8 + (wi & 7); return (wi & 8) ? DEXP + hid : hid; } };

struct F8Item { const float* src; unsigned char* dst; int N, K; float scale; };
__device__ __forceinline__ void f8item_load(const F8Item& d, f32x4 (&v)[16]) {
#pragma unroll
    for (int it = 0; it < 16; ++it) v[it] = *(const f32x4*)(d.src + (size_t)(8 * it) * d.N);
}
__device__ __forceinline__ void f8item_finish(const F8Item& d, const f32x4 (&v)[16], LAS float* scr, int lane) {
    const int dq = lane & 7, ks = lane >> 3;
#pragma unroll
    for (int it = 0; it < 16; ++it) { LAS float* p = scr + (8 * it + ks) * 33 + 4 * dq; p[0] = v[it][0] * d.scale; p[1] = v[it][1] * d.scale; p[2] = v[it][2] * d.scale; p[3] = v[it][3] * d.scale; }
    LDS_WAIT();
    const int c = lane & 7, ns = lane >> 3;
#pragma unroll
    for (int j = 0; j < 4; ++j) { const int n = 8 * j + ns; const LAS float* s = scr + (16 * c) * 33 + n;
        u32x4 o; o.x = cvt4_fp8(s[0], s[33], s[2 * 33], s[3 * 33]); o.y = cvt4_fp8(s[4 * 33], s[5 * 33], s[6 * 33], s[7 * 33]);
        o.z = cvt4_fp8(s[8 * 33], s[9 * 33], s[10 * 33], s[11 * 33]); o.w = cvt4_fp8(s[12 * 33], s[13 * 33], s[14 * 33], s[15 * 33]);
        *(u32x4*)(d.dst + (size_t)(8 * j) * d.K) = o; }
    LDS_WAIT();
}
__device__ __forceinline__ void p0_prologue(Frame& F, const float* x, const float* w_in, const float* p_ret, const float* p_sg, const float* w_o, const float* sg_w, const float* e_w1, const float* e_w2) {
    LAS float* scr = (LAS float*)(F.lds + F.wave * 16896);
    const int gw = F.bid * NWAVES + F.wave, NGW = F.G * NWAVES;
    constexpr int I_IN = (DM / 64) * (INW / 64), I_SQ = (DM / 64) * (DM / 64), I_W1 = NE * (DM / 64) * (2 * DEXP / 64), I_W2 = NE * (DEXP / 64) * (DM / 64);
    constexpr int I_LAYER = I_IN + 3 * I_SQ + I_W1 + I_W2;
    if (MOE_FP8) {
        constexpr int I_SMALL = I_IN + 3 * I_SQ;
        for (int it = gw; it < NL * I_SMALL; it += NGW) {
            const int l = it / I_SMALL; int r = it - l * I_SMALL;
            if (r < I_IN) { const int nb = INW / 64, kb = r / nb, nn = r - kb * nb;
                if (INPROJ_FP8) { const int nb8 = INW / 32, kb8 = r / nb8, nn8 = r - kb8 * nb8; transpose_item_f8(w_in + (size_t)l * DM * INW, INW, WSP(unsigned char, WS_WIN) + (size_t)l * INW * DM, DM, 128 * kb8, 32 * nn8, ColQK(), 64.0f, scr, F.lane); }
                else transpose_item(w_in + (size_t)l * DM * INW, INW, WSP(bf16, WS_WIN) + (size_t)l * INW * DM, DM, 64 * kb, 64 * nn, ColQK(), scr, F.lane);
                continue; } r -= I_IN;
            { const int which = r / I_SQ; r -= which * I_SQ; const int kb = r / 16, nn = r & 15;
              const float* src = (which == 0 ? p_ret : which == 1 ? p_sg : w_o) + (size_t)l * DM * DM;
              bf16* dst = WSP(bf16, which == 0 ? WS_PRET : which == 1 ? WS_PSG : WS_WO) + (size_t)l * DM * DM;
              transpose_item(src, DM, dst, DM, 64 * kb, 64 * nn, ColId(), scr, F.lane); } }
        constexpr int I_MOE = I_W1 + I_W2, N_MOE = NL * I_MOE;
        const int dq = F.lane & 7, ks = F.lane >> 3, c8 = F.lane & 7, ns = F.lane >> 3;
        auto decode = [&](int it, F8Item& d) {
            const int l = it / I_MOE; int r = it - l * I_MOE;
            if (r < I_W1) { const int e = r / 512; r -= e * 512; const int k0 = 128 * (r >> 6), n0 = 32 * (r & 63);
                d.N = 2 * DEXP; d.K = DM; d.scale = 64.0f;
                d.src = e_w1 + ((size_t)l * NE + e) * DM * 2 * DEXP + (size_t)(k0 + ks) * d.N + ColGU()(n0 + 4 * dq);
                d.dst = WSP(unsigned char, WS_W1) + ((size_t)l * NE + e) * 2 * DEXP * DM + (size_t)(n0 + ns) * d.K + k0 + 16 * c8; }
            else { r -= I_W1; const int e = r / 256; r -= e * 256; const int k0 = 128 * (r >> 5), n0 = 32 * (r & 31);
                d.N = DM; d.K = DEXP; d.scale = 128.0f;
                d.src = e_w2 + ((size_t)l * NE + e) * DEXP * DM + (size_t)(k0 + ks) * d.N + ColId()(n0 + 4 * dq);
                d.dst = WSP(unsigned char, WS_W2) + ((size_t)l * NE + e) * DM * DEXP + (size_t)(n0 + ns) * d.K + k0 + 16 * c8; } };
        f32x4 va[16], vb[16]; F8Item da, db;
        int it = gw;
        if (it < N_MOE) { decode(it, da); f8item_load(da, va); }
        while (it < N_MOE) {
            const int i1 = it + NGW, i2 = it + 2 * NGW;
            if (i1 < N_MOE) { decode(i1, db); f8item_load(db, vb); }
            f8item_finish(da, va, scr, F.lane);
            if (i1 >= N_MOE) break;
            if (i2 < N_MOE) { decode(i2, da); f8item_load(da, va); }
            f8item_finish(db, vb, scr, F.lane);
            it = i2;
        }
    } else {
    for (int it = gw; it < NL * I_LAYER; it += NGW) {
        const int l = it / I_LAYER; int r = it - l * I_LAYER;
        if (r < I_IN) { const int nb = INW / 64, kb = r / nb, nn = r - kb * nb;
            if (INPROJ_FP8) { const int nb8 = INW / 32, kb8 = r / nb8, nn8 = r - kb8 * nb8; transpose_item_f8(w_in + (size_t)l * DM * INW, INW, WSP(unsigned char, WS_WIN) + (size_t)l * INW * DM, DM, 128 * kb8, 32 * nn8, ColQK(), 64.0f, scr, F.lane); }
            else transpose_item(w_in + (size_t)l * DM * INW, INW, WSP(bf16, WS_WIN) + (size_t)l * INW * DM, DM, 64 * kb, 64 * nn, ColQK(), scr, F.lane);
            continue; } r -= I_IN;
        if (r < 3 * I_SQ) { const int which = r / I_SQ; r -= which * I_SQ; const int kb = r / 16, nn = r & 15;
            const float* src = (which == 0 ? p_ret : which == 1 ? p_sg : w_o) + (size_t)l * DM * DM;
            bf16* dst = WSP(bf16, which == 0 ? WS_PRET : which == 1 ? WS_PSG : WS_WO) + (size_t)l * DM * DM;
            transpose_item(src, DM, dst, DM, 64 * kb, 64 * nn, ColId(), scr, F.lane); continue; } r -= 3 * I_SQ;
        if (r < I_W1) { const int e = r / 512; r -= e * 512; const int kb = r / 32, nn = r & 31;
            if (MOE_FP8) transpose_item_f8(e_w1 + ((size_t)l * NE + e) * DM * 2 * DEXP, 2 * DEXP, WSP(unsigned char, WS_W1) + ((size_t)l * NE + e) * 2 * DEXP * DM, DM, 128 * (r >> 6), 32 * (r & 63), ColGU(), 64.0f, scr, F.lane);
            else transpose_item(e_w1 + ((size_t)l * NE + e) * DM * 2 * DEXP, 2 * DEXP, WSP(bf16, WS_W1) + ((size_t)l * NE + e) * 2 * DEXP * DM, DM, 64 * kb, 64 * nn, ColGU(), scr, F.lane);
            continue; } r -= I_W1;
        { const int e = r / 256; r -= e * 256; const int kb = r / 16, nn = r & 15;
            if (MOE_FP8) transpose_item_f8(e_w2 + ((size_t)l * NE + e) * DEXP * DM, DM, WSP(unsigned char, WS_W2) + ((size_t)l * NE + e) * DM * DEXP, DEXP, 128 * (r >> 5), 32 * (r & 31), ColId(), 128.0f, scr, F.lane);
            else transpose_item(e_w2 + ((size_t)l * NE + e) * DEXP * DM, DM, WSP(bf16, WS_W2) + ((size_t)l * NE + e) * DM * DEXP, DEXP, 64 * kb, 64 * nn, ColId(), scr, F.lane); }
    }
    }
    const size_t gt = (size_t)F.bid * NTHREADS + F.tid, NT = (size_t)F.G * NTHREADS;
    { const f32x4* s = (const f32x4*)sg_w; u32x2* d = WSP(u32x2, WS_SGW);
      for (size_t i = gt; i < (size_t)NL * 8 * 128 * 128 / 4; i += NT) { const f32x4 v = s[i]; u32x2 w; w.x = cvt_pk_bf16(v[0], v[1]); w.y = cvt_pk_bf16(v[2], v[3]); d[i] = w; } }
    { const f32x4* s = (const f32x4*)x; u32x2* d = WSP(u32x2, WS_XB);
      unsigned* dq = WSP(unsigned, WS_XQ);
      for (size_t i = gt; i < (size_t)T * DM / 4; i += NT) { const f32x4 v = s[i]; if (INPROJ_FP8) dq[i] = cvt4_fp8(v[0] * 4.0f, v[1] * 4.0f, v[2] * 4.0f, v[3] * 4.0f); else { u32x2 w; w.x = cvt_pk_bf16(v[0], v[1]); w.y = cvt_pk_bf16(v[2], v[3]); d[i] = w; } } }
    { float* rc = WSP(float, WS_ROPE); float* rs = rc + SEQ * 64;
      for (size_t i = gt; i < (size_t)SEQ * 64; i += NT) { const int pos = (int)(i >> 6), j = (int)(i & 63);
          const double inv = exp2(-(double)j * (13.287712379549449 / 64.0)), ang = (double)pos * inv;
          const double qd = rint(ang * 0.6366197723675814); const int qi = (int)qd;
          const double r = (ang - qd * 1.5707963267341256) - qd * 6.077100506506192e-11, r2 = r * r;
          const double sn = r * (1.0 + r2 * (-1.0 / 6 + r2 * (1.0 / 120 + r2 * (-1.0 / 5040 + r2 * (1.0 / 362880 + r2 * (-1.0 / 39916800 + r2 * (1.0 / 6227020800.0)))))));
          const double cs = 1.0 + r2 * (-0.5 + r2 * (1.0 / 24 + r2 * (-1.0 / 720 + r2 * (1.0 / 40320 + r2 * (-1.0 / 3628800 + r2 * (1.0 / 479001600.0 + r2 * (-1.0 / 87178291200.0)))))));
          const int qm = qi & 3; const double c = qm == 0 ? cs : qm == 1 ? -sn : qm == 2 ? -cs : sn, sv = qm == 0 ? sn : qm == 1 ? cs : qm == 2 ? -sn : -cs;
          rc[i] = (float)c; rs[i] = (float)sv;
          unsigned short* rcs = WSP(unsigned short, WS_ROPEB); const size_t o = ((size_t)pos * 16 + (j >> 2)) * 8 + (j & 3);
          rcs[o] = (unsigned short)(cvt_pk_bf16((float)c, 0.0f) & 0xffffu); rcs[o + 4] = (unsigned short)(cvt_pk_bf16((float)sv, 0.0f) & 0xffffu); } }
}

typedef short v4i16_t __attribute__((ext_vector_type(4)));
__device__ __forceinline__ s16x4 tr_read(const LAS unsigned char* p) { return __builtin_bit_cast(s16x4, __builtin_amdgcn_ds_read_tr16_b64_v4i16((LAS v4i16_t*)p)); }
__device__ __forceinline__ bf16x8 cat8(s16x4 a, s16x4 b) { return __builtin_shufflevector(a, b, 0, 1, 2, 3, 4, 5, 6, 7); }
constexpr int RQ_STRIDE = 272, RV_STRIDE = 544;
constexpr int RO_STRIDE = 528;
constexpr int R_Q = 0, R_K = 64 * RQ_STRIDE, R_V = 2 * 64 * RQ_STRIDE, R_SF = R_V + 64 * RV_STRIDE, R_ST = R_SF + 8192, R_OT = R_ST + 4096, R_END = R_OT + 64 * RO_STRIDE;
static_assert(R_END <= RING_BYTES, "retention LDS");

constexpr int RSEG = 4, RCPS = SEQ / 64 / RSEG;
__device__ __forceinline__ float* sloc_ptr(Frame& F, int bh, int seg, int w) { return WSP(float, WS_X1F) + ((size_t)((bh * 3 + seg) * 8 + w)) * 4096; }
__device__ __forceinline__ void ret_unit(Frame& F, int b, int h, int seg) {
    LAS unsigned char* L = F.lds;
    __syncthreads();
    const int tid = F.tid, lane = F.lane, w = F.wave, l15 = lane & 15, rq = lane >> 4, tq = l15 >> 2, tp = lane & 3, es = 32 * w;
    const bf16* P = WSP(bf16, WS_P); bf16* Y = WSP(bf16, WS_YRET);
    const float gam = __builtin_amdgcn_exp2f(lg2_gamma(h)), g63 = __builtin_amdgcn_exp2f(63.0f * lg2_gamma(h));
    const unsigned qoff = (unsigned)((tid >> 4) * INW + h * 128 + (tid & 15) * 8) * 2u, voffv = (unsigned)((tid >> 5) * INW + C_V + h * 256 + (tid & 31) * 8) * 2u;
    const unsigned qlds = (unsigned)((tid >> 4) * RQ_STRIDE + (tid & 15) * 16), vlds = (unsigned)((tid >> 5) * RV_STRIDE + (tid & 31) * 16);
    const unsigned goff = (unsigned)((tid >> 5) * INW + C_G + h * 256 + (tid & 31) * 8) * 2u, yoff = (unsigned)((tid >> 5) * DM + h * 256 + (tid & 31) * 8) * 2u, olds = (unsigned)((tid >> 5) * RO_STRIDE + (tid & 31) * 16);
    u32x4 pq[2], pk[2], pv[4];
    const size_t tb = (size_t)b * SEQ;
    const char* Pc = (const char*)P; char* Yc = (char*)Y;
#define RET_LOAD(c) do { const char* ub_ = Pc + (tb + (size_t)(c) * 64) * INW * 2; \
        _Pragma("unroll") for (int i = 0; i < 2; ++i) { const char* rp = ub_ + (size_t)(32 * i) * INW * 2 + qoff; pq[i] = __builtin_nontemporal_load((const u32x4*)(rp + C_Q * 2)); pk[i] = __builtin_nontemporal_load((const u32x4*)(rp + C_K * 2)); } \
        _Pragma("unroll") for (int i = 0; i < 4; ++i) pv[i] = __builtin_nontemporal_load((const u32x4*)(ub_ + (size_t)(16 * i) * INW * 2 + voffv)); } while (0)
#define RET_STORE() do { \
        _Pragma("unroll") for (int i = 0; i < 2; ++i) { *(LAS u32x4*)(L + R_Q + qlds + i * 32 * RQ_STRIDE) = pq[i]; *(LAS u32x4*)(L + R_K + qlds + i * 32 * RQ_STRIDE) = pk[i]; } \
        _Pragma("unroll") for (int i = 0; i < 4; ++i) *(LAS u32x4*)(L + R_V + vlds + i * 16 * RV_STRIDE) = pv[i]; } while (0)
    if (tid < 64) { *(LAS u32x2*)(L + R_SF + ((0 * 2 + 0) * 64 + tid) * 16 + 8) = (u32x2){0u, 0u}; *(LAS u32x2*)(L + R_SF + ((2 * 2 + 1) * 64 + tid) * 16 + 8) = (u32x2){0u, 0u}; }
    const int c0 = seg * RCPS;
    RET_LOAD(c0); RET_STORE(); RET_LOAD(c0 + 1);
    f32x4 St[8][2];
#pragma unroll
    for (int dt = 0; dt < 8; ++dt) { St[dt][0] = (f32x4){0.f, 0.f, 0.f, 0.f}; St[dt][1] = (f32x4){0.f, 0.f, 0.f, 0.f}; }
    if (seg > 0) {
        const float fseg = __builtin_amdgcn_exp2f((float)(64 * RCPS) * lg2_gamma(h));
        for (int sg = 0; sg < seg; ++sg) { const f32x4* sp = (const f32x4*)sloc_ptr(F, b * 4 + h, sg, w) + lane; f32x4 tl[8][2];
#pragma unroll
            for (int dt = 0; dt < 8; ++dt) { tl[dt][0] = sp[(dt * 2) * 64]; tl[dt][1] = sp[(dt * 2 + 1) * 64]; }
#pragma unroll
            for (int dt = 0; dt < 8; ++dt) { St[dt][0] = St[dt][0] * fseg + tl[dt][0]; St[dt][1] = St[dt][1] * fseg + tl[dt][1]; } } }
    __syncthreads();
    for (int cc = 0; cc < RCPS; ++cc) {
        const int c = c0 + cc;
        const size_t t0 = tb + (size_t)c * 64;
        u32x4 gp[4];
#pragma unroll
        for (int k = 0; k < 4; ++k) gp[k] = __builtin_nontemporal_load((const u32x4*)(Pc + (t0 + 16 * k) * INW * 2 + goff));
#pragma unroll
        for (int rep = 0; rep < 2; ++rep) {
            const int id = w + 8 * rep;
            if (id < 10) {
                const int tj = id < 4 ? 0 : id < 7 ? 1 : id < 9 ? 2 : 3, ti = id < 4 ? id : id < 7 ? id - 3 : id < 9 ? id - 5 : 3;
                f32x4 s = (f32x4){0.f, 0.f, 0.f, 0.f};
#pragma unroll
                for (int kb = 0; kb < 4; ++kb) {
                    const bf16x8 a = *(const LAS bf16x8*)(L + R_K + (16 * tj + l15) * RQ_STRIDE + (32 * kb + 8 * rq) * 2);
                    const bf16x8 q = *(const LAS bf16x8*)(L + R_Q + (16 * ti + l15) * RQ_STRIDE + (32 * kb + 8 * rq) * 2);
                    s = __builtin_amdgcn_mfma_f32_16x16x32_bf16(a, q, s, 0, 0, 0); }
                if (tj == ti) {
#pragma unroll
                    for (int r = 0; r < 4; ++r) s[r] = (l15 >= 4 * rq + r) ? s[r] : 0.f; }
                u32x2 wv; wv.x = cvt_pk_bf16(s[0], s[1]); wv.y = cvt_pk_bf16(s[2], s[3]);
                *(LAS u32x2*)(L + R_SF + ((ti * 2 + (tj >> 1)) * 64 + lane) * 16 + (tj & 1) * 8) = wv;
            }
        }
        __syncthreads();
        f32x4 O[2][4];
#pragma unroll
        for (int et = 0; et < 2; ++et)
#pragma unroll
            for (int ti = 0; ti < 4; ++ti) O[et][ti] = (f32x4){0.f, 0.f, 0.f, 0.f};
#pragma unroll
        for (int kb = 0; kb < 4; ++kb) {
            bf16x8 A[2];
#pragma unroll
            for (int et = 0; et < 2; ++et) { const f32x4 s0 = St[2 * kb][et], s1 = St[2 * kb + 1][et];
                u32x4 p; p.x = cvt_pk_bf16(s0[0], s0[1]); p.y = cvt_pk_bf16(s0[2], s0[3]); p.z = cvt_pk_bf16(s1[0], s1[1]); p.w = cvt_pk_bf16(s1[2], s1[3]); A[et] = __builtin_bit_cast(bf16x8, p); }
#pragma unroll
            for (int ti = 0; ti < 4; ++ti) {
                const LAS unsigned char* qp = L + R_Q + (16 * ti + l15) * RQ_STRIDE + (32 * kb + 4 * rq) * 2;
                const bf16x8 Bq = cat8(*(const LAS s16x4*)qp, *(const LAS s16x4*)(qp + 32));
#pragma unroll
                for (int et = 0; et < 2; ++et) O[et][ti] = __builtin_amdgcn_mfma_f32_16x16x32_bf16(A[et], Bq, O[et][ti], 0, 0, 0); }
            __builtin_amdgcn_sched_barrier(0);
        }
#pragma unroll
        for (int et = 0; et < 2; ++et)
#pragma unroll
            for (int ti = 0; ti < 4; ++ti) O[et][ti] *= gam;
#pragma unroll
        for (int kb = 0; kb < 2; ++kb) {
            bf16x8 Av[2];
#pragma unroll
            for (int et = 0; et < 2; ++et) { const LAS unsigned char* vp = L + R_V + (32 * kb + 4 * rq + tq) * RV_STRIDE + (es + 16 * et + 4 * tp) * 2;
                Av[et] = cat8(tr_read(vp), tr_read(vp + 16 * RV_STRIDE)); }
#pragma unroll
            for (int ti = 2 * kb; ti < 4; ++ti) {
                const bf16x8 Bs = *(const LAS bf16x8*)(L + R_SF + ((ti * 2 + kb) * 64 + lane) * 16);
#pragma unroll
                for (int et = 0; et < 2; ++et) O[et][ti] = __builtin_amdgcn_mfma_f32_16x16x32_bf16(Av[et], Bs, O[et][ti], 0, 0, 0); }
            __builtin_amdgcn_sched_barrier(0);
        }
#pragma unroll
        for (int dt = 0; dt < 8; ++dt) { St[dt][0] *= gam; St[dt][1] *= gam; }
#pragma unroll
        for (int kb = 0; kb < 2; ++kb) {
            bf16x8 Bv[2];
#pragma unroll
            for (int et = 0; et < 2; ++et) { const LAS unsigned char* vp = L + R_V + (32 * kb + 8 * rq + tq) * RV_STRIDE + (es + 16 * et + 4 * tp) * 2;
                Bv[et] = cat8(tr_read(vp), tr_read(vp + 4 * RV_STRIDE)); }
#pragma unroll
            for (int dt = 0; dt < 8; ++dt) { const LAS unsigned char* kp = L + R_K + (32 * kb + 8 * rq + tq) * RQ_STRIDE + (16 * dt + 4 * tp) * 2;
                const bf16x8 Ak = cat8(tr_read(kp), tr_read(kp + 4 * RQ_STRIDE));
#pragma unroll
                for (int et = 0; et < 2; ++et) St[dt][et] = __builtin_amdgcn_mfma_f32_16x16x32_bf16(Ak, Bv[et], St[dt][et], 0, 0, 0);
                if (dt & 1) __builtin_amdgcn_sched_barrier(0); }
        }
#pragma unroll
        for (int dt = 0; dt < 8; ++dt) { St[dt][0] *= g63; St[dt][1] *= g63; }
#pragma unroll
        for (int ti = 0; ti < 4; ++ti) { float s = 0.f, ss = 0.f;
#pragma unroll
            for (int et = 0; et < 2; ++et)
#pragma unroll
                for (int r = 0; r < 4; ++r) { const float v = O[et][ti][r]; s += v; ss += v * v; }
            s += __shfl_xor(s, 16); s += __shfl_xor(s, 32); ss += __shfl_xor(ss, 16); ss += __shfl_xor(ss, 32);
            if (lane < 16) *(LAS f32x2*)(L + R_ST + ((16 * ti + lane) * 8 + w) * 8) = (f32x2){s, ss}; }
        __syncthreads();
        if (cc + 1 < RCPS) { RET_STORE(); if (cc + 2 < RCPS) RET_LOAD(c + 2); }
#pragma unroll
        for (int ti = 0; ti < 4; ++ti) { float s = 0.f, ss = 0.f;
            const LAS f32x4* sp = (const LAS f32x4*)(L + R_ST + (16 * ti + l15) * 64);
#pragma unroll
            for (int k = 0; k < 4; ++k) { const f32x4 v = sp[k]; s += v[0] + v[2]; ss += v[1] + v[3]; }
            const float mean = s * (1.0f / 256.0f), var = ss * (1.0f / 256.0f) - mean * mean, rstd = 1.0f / sqrtf(fmaxf(var, 0.f) + LN_EPS);
#pragma unroll
            for (int et = 0; et < 2; ++et) { const f32x4 o = (O[et][ti] - mean) * rstd;
                u32x2 wv; wv.x = cvt_pk_bf16(o[0], o[1]); wv.y = cvt_pk_bf16(o[2], o[3]);
                *(LAS u32x2*)(L + R_OT + (16 * ti + l15) * RO_STRIDE + (es + 16 * et + 4 * rq) * 2) = wv; } }
        __syncthreads();
#pragma unroll
        for (int k = 0; k < 4; ++k) { f32x4 o0, o1, g0, g1; unpack8(*(const LAS u32x4*)(L + R_OT + olds + k * 16 * RO_STRIDE), o0, o1); unpack8(gp[k], g0, g1);
            *(u32x4*)(Yc + (t0 + 16 * k) * DM * 2 + yoff) = pack8(o0 * g0, o1 * g1); }
    }
#undef RET_LOAD
#undef RET_STORE
}


__device__ __forceinline__ void ret_prepass(Frame& F, int b, int h, int seg) {
    LAS unsigned char* L = F.lds;
    __syncthreads();
    const int tid = F.tid, lane = F.lane, w = F.wave, l15 = lane & 15, rq = lane >> 4, tq = l15 >> 2, tp = lane & 3, es = 32 * w;
    const float gam = __builtin_amdgcn_exp2f(lg2_gamma(h)), g63 = __builtin_amdgcn_exp2f(63.0f * lg2_gamma(h));
    const unsigned qoff = (unsigned)((tid >> 4) * INW + h * 128 + (tid & 15) * 8) * 2u, voffv = (unsigned)((tid >> 5) * INW + C_V + h * 256 + (tid & 31) * 8) * 2u;
    const unsigned qlds = (unsigned)((tid >> 4) * RQ_STRIDE + (tid & 15) * 16), vlds = (unsigned)((tid >> 5) * RV_STRIDE + (tid & 31) * 16);
    u32x4 pk[2], pv[4];
    const size_t tb = (size_t)b * SEQ; const char* Pc = (const char*)WSP(bf16, WS_P);
#define RPP_LOAD(c) do { const char* ub_ = Pc + (tb + (size_t)(c) * 64) * INW * 2; \
        _Pragma("unroll") for (int i = 0; i < 2; ++i) pk[i] = __builtin_nontemporal_load((const u32x4*)(ub_ + (size_t)(32 * i) * INW * 2 + qoff + C_K * 2)); \
        _Pragma("unroll") for (int i = 0; i < 4; ++i) pv[i] = __builtin_nontemporal_load((const u32x4*)(ub_ + (size_t)(16 * i) * INW * 2 + voffv)); } while (0)
#define RPP_STORE() do { \
        _Pragma("unroll") for (int i = 0; i < 2; ++i) *(LAS u32x4*)(L + R_K + qlds + i * 32 * RQ_STRIDE) = pk[i]; \
        _Pragma("unroll") for (int i = 0; i < 4; ++i) *(LAS u32x4*)(L + R_V + vlds + i * 16 * RV_STRIDE) = pv[i]; } while (0)
    const int c0 = seg * RCPS;
    RPP_LOAD(c0); RPP_STORE(); RPP_LOAD(c0 + 1);
    f32x4 St[8][2];
#pragma unroll
    for (int dt = 0; dt < 8; ++dt) { St[dt][0] = (f32x4){0.f, 0.f, 0.f, 0.f}; St[dt][1] = (f32x4){0.f, 0.f, 0.f, 0.f}; }
    __syncthreads();
    for (int cc = 0; cc < RCPS; ++cc) {
#pragma unroll
        for (int dt = 0; dt < 8; ++dt) { St[dt][0] *= gam; St[dt][1] *= gam; }
#pragma unroll
        for (int kb = 0; kb < 2; ++kb) {
            bf16x8 Bv[2];
#pragma unroll
            for (int et = 0; et < 2; ++et) { const LAS unsigned char* vp = L + R_V + (32 * kb + 8 * rq + tq) * RV_STRIDE + (es + 16 * et + 4 * tp) * 2;
                Bv[et] = cat8(tr_read(vp), tr_read(vp + 4 * RV_STRIDE)); }
#pragma unroll
            for (int dt = 0; dt < 8; ++dt) { const LAS unsigned char* kp = L + R_K + (32 * kb + 8 * rq + tq) * RQ_STRIDE + (16 * dt + 4 * tp) * 2;
                const bf16x8 Ak = cat8(tr_read(kp), tr_read(kp + 4 * RQ_STRIDE));
#pragma unroll
                for (int et = 0; et < 2; ++et) St[dt][et] = __builtin_amdgcn_mfma_f32_16x16x32_bf16(Ak, Bv[et], St[dt][et], 0, 0, 0);
                if (dt & 1) __builtin_amdgcn_sched_barrier(0); }
        }
#pragma unroll
        for (int dt = 0; dt < 8; ++dt) { St[dt][0] *= g63; St[dt][1] *= g63; }
        __syncthreads();
        if (cc + 1 < RCPS) { RPP_STORE(); if (cc + 2 < RCPS) RPP_LOAD(c0 + cc + 2); }
        __syncthreads();
    }
    f32x4* sp = (f32x4*)sloc_ptr(F, b * 4 + h, seg, w) + lane;
#pragma unroll
    for (int dt = 0; dt < 8; ++dt)
#pragma unroll
        for (int et = 0; et < 2; ++et) sp[(dt * 2 + et) * 64] = St[dt][et];
#undef RPP_LOAD
#undef RPP_STORE
}

__device__ __forceinline__ float wave_sum_dpp(float v);
constexpr int SGT_STRIDE = 272;
constexpr int SG4_ST = 0, SG4_T = 1024, SG4_U = SG4_T + 128 * SGT_STRIDE, SG4_W = SG4_U + 128 * SGT_STRIDE, SG4_END = SG4_W + 24 * 1024;
static_assert(SG4_END <= RING_BYTES, "SGU LDS");
__device__ __forceinline__ void sgu_unit(Frame& F, int blk, int l, const float* sg_b, const float* sg_ln_g, const float* sg_ln_b) {
    LAS unsigned char* L = F.lds;
    const int tid = F.tid, lane = F.lane, w = F.wave, l15 = lane & 15, rq = lane >> 4, tq = l15 >> 2, tp = lane & 3;
    const size_t t0 = (size_t)blk * 128;
    const char* Pc = (const char*)WSP(bf16, WS_P); char* Yc = (char*)WSP(bf16, WS_YSG);
    const bf16* Wl = WSP(bf16, WS_SGW) + (size_t)l * 8 * 128 * 128;
    __syncthreads();
    const int srow = tid >> 4, sch = tid & 15;
    const unsigned soff = (unsigned)(srow * INW + sch * 8) * 2u, slds = (unsigned)(srow * SGT_STRIDE + sch * 16), yoff = (unsigned)(srow * DM + sch * 8) * 2u;
    unsigned wsrc[3];
#pragma unroll
    for (int i = 0; i < 3; ++i) { const int p = tid + 512 * i, f = p >> 6, ln = p & 63, qt = f < 8 ? (f >> 1) : 4 + ((f - 8) >> 2), kb = f < 8 ? (f & 1) : ((f - 8) & 3);
        wsrc[i] = (unsigned)((16 * qt + (ln & 15)) * 128 + 32 * kb + 8 * (ln >> 4)) * 2u; }
    u32x4 xv[4], xu[4], wreg[3]; f32x4 lnp[4]; float bq[8], bqn[8];
#define SG_LOAD(g_) do { _Pragma("unroll") for (int i = 0; i < 4; ++i) { const char* rp = Pc + ((t0 + 32 * i) * INW + (g_) * 128) * 2 + soff; xv[i] = __builtin_nontemporal_load((const u32x4*)(rp + C_VS * 2)); xu[i] = __builtin_nontemporal_load((const u32x4*)(rp + C_U * 2)); } \
        { const float* lng = sg_ln_g + (size_t)l * DM + (g_) * 128 + sch * 8; const float* lnb = sg_ln_b + (size_t)l * DM + (g_) * 128 + sch * 8; lnp[0] = *(const f32x4*)lng; lnp[1] = *(const f32x4*)(lng + 4); lnp[2] = *(const f32x4*)lnb; lnp[3] = *(const f32x4*)(lnb + 4); } \
        _Pragma("unroll") for (int qt = 0; qt < 8; ++qt) bqn[qt] = sg_b[((size_t)l * 8 + (g_)) * 128 + 16 * qt + l15]; \
        _Pragma("unroll") for (int i = 0; i < 3; ++i) wreg[i] = *(const u32x4*)((const char*)(Wl + (size_t)(g_) * 128 * 128) + wsrc[i]); } while (0)
#define SG_WPUT() do { _Pragma("unroll") for (int i = 0; i < 3; ++i) *(LAS u32x4*)(L + SG4_W + (tid + 512 * i) * 16) = wreg[i]; } while (0)
    SG_LOAD(0);
#pragma unroll 1
    for (int r8 = 0; r8 < 2; ++r8) { u32x4 a[8], b2[8];
#pragma unroll
        for (int r = 0; r < 8; ++r) { const char* rp = Pc + ((t0 + 16 * w + 8 * r8 + r) * INW + C_VS) * 2 + lane * 32; a[r] = *(const u32x4*)rp; b2[r] = *(const u32x4*)(rp + 16); }
#pragma unroll
        for (int r = 0; r < 8; ++r) { f32x4 x0, x1, x2, x3; unpack8(a[r], x0, x1); unpack8(b2[r], x2, x3);
            float s = 0.f, ss = 0.f;
#pragma unroll
            for (int j = 0; j < 4; ++j) { s += x0[j] + x1[j] + x2[j] + x3[j]; ss += x0[j] * x0[j] + x1[j] * x1[j] + x2[j] * x2[j] + x3[j] * x3[j]; }
            s = wave_sum_dpp(s); ss = wave_sum_dpp(ss);
            const float mean = s * (1.0f / 1024.0f), var = ss * (1.0f / 1024.0f) - mean * mean;
            if (lane == 0) *(LAS f32x2*)(L + SG4_ST + (16 * w + 8 * r8 + r) * 8) = (f32x2){mean, 1.0f / sqrtf(fmaxf(var, 0.f) + LN_EPS)}; } }
    SG_WPUT();
    __syncthreads();
#pragma unroll 1
    for (int g = 0; g < 8; ++g) {
#pragma unroll
        for (int qt = 0; qt < 8; ++qt) bq[qt] = bqn[qt];
#pragma unroll
        for (int i = 0; i < 4; ++i) { f32x4 x0, x1; unpack8(xv[i], x0, x1);
            const f32x2 st = *(const LAS f32x2*)(L + SG4_ST + (srow + 32 * i) * 8);
            x0 = (x0 - st.x) * st.y * lnp[0] + lnp[2]; x1 = (x1 - st.x) * st.y * lnp[1] + lnp[3];
            *(LAS u32x4*)(L + SG4_T + slds + i * 32 * SGT_STRIDE) = pack8(x0, x1);
            *(LAS u32x4*)(L + SG4_U + slds + i * 32 * SGT_STRIDE) = xu[i]; }
        if (g < 7) SG_LOAD(g + 1);
        __syncthreads();
        bf16x8 Av[4];
#pragma unroll
        for (int kb = 0; kb < 4; ++kb) { const LAS unsigned char* vp = L + SG4_T + (32 * kb + 8 * rq + tq) * SGT_STRIDE + (16 * w + 4 * tp) * 2; Av[kb] = cat8(tr_read(vp), tr_read(vp + 4 * SGT_STRIDE)); }
#pragma unroll
        for (int qt = 0; qt < 8; ++qt) {
            f32x4 a0 = (f32x4){0.f, 0.f, 0.f, 0.f};
#pragma unroll
            for (int kb = 0; kb < 4; ++kb) { if (qt < 4 && kb >= 2) continue;
                const int f = qt < 4 ? 2 * qt + kb : 8 + 4 * (qt - 4) + kb;
                const bf16x8 Bw = *(const LAS bf16x8*)(L + SG4_W + f * 1024 + lane * 16);
                a0 = __builtin_amdgcn_mfma_f32_16x16x32_bf16(Av[kb], Bw, a0, 0, 0, 0); }
            const f32x4 a = a0 + bq[qt];
            LAS u32x2* up = (LAS u32x2*)(L + SG4_U + (16 * qt + l15) * SGT_STRIDE + (16 * w + 4 * rq) * 2);
            const u32x2 u2 = *up;
            u32x2 wv; wv.x = cvt_pk_bf16(a[0] * bf_lo(u2.x), a[1] * bf_hi(u2.x)); wv.y = cvt_pk_bf16(a[2] * bf_lo(u2.y), a[3] * bf_hi(u2.y));
            *up = wv;
        }
        __syncthreads();
        if (g < 7) SG_WPUT();
#pragma unroll
        for (int i = 0; i < 4; ++i) *(u32x4*)(Yc + ((t0 + 32 * i) * DM + g * 128) * 2 + yoff) = *(const LAS u32x4*)(L + SG4_U + slds + i * 32 * SGT_STRIDE);
    }
#undef SG_LOAD
#undef SG_WPUT
}

__device__ __forceinline__ float wave_sum_dpp(float v) {
    v += __builtin_bit_cast(float, __builtin_amdgcn_update_dpp(0, __builtin_bit_cast(int, v), 0xB1, 0xF, 0xF, true));
    v += __builtin_bit_cast(float, __builtin_amdgcn_update_dpp(0, __builtin_bit_cast(int, v), 0x4E, 0xF, 0xF, true));
    v += __builtin_bit_cast(float, __builtin_amdgcn_update_dpp(0, __builtin_bit_cast(int, v), 0x141, 0xF, 0xF, true));
    v += __builtin_bit_cast(float, __builtin_amdgcn_update_dpp(0, __builtin_bit_cast(int, v), 0x140, 0xF, 0xF, true));
    const int iv = __builtin_bit_cast(int, v);
    return (__builtin_bit_cast(float, __builtin_amdgcn_readlane(iv, 0)) + __builtin_bit_cast(float, __builtin_amdgcn_readlane(iv, 16))) +
           (__builtin_bit_cast(float, __builtin_amdgcn_readlane(iv, 32)) + __builtin_bit_cast(float, __builtin_amdgcn_readlane(iv, 48)));
}
constexpr int RX_STRIDE = 2064, RX_H = 0, RX_L = 16 * RX_STRIDE, RX_PART = 2 * 16 * RX_STRIDE, RX_LOG = RX_PART + 8 * 2 * 1024, RX_END = RX_LOG + 2048;
static_assert(RX_END <= RING_BYTES, "router LDS");
__device__ __forceinline__ void ln_router_phase(Frame& F, int l, int cnt_off, const float* router_w, const float* router_b, const float* ln1_g, const float* ln1_b) {
    LAS unsigned char* L = F.lds;
    LAS int* LCNT = (LAS int*)(F.lds + LCNT_OFF); LAS int* LBASE = (LAS int*)(F.lds + LBASE_OFF); LAS int* LSEL = (LAS int*)(F.lds + LSEL_OFF);
    const int tid = F.tid, lane = F.lane, w = F.wave, l15 = lane & 15, rq = lane >> 4;
    const bf16* Z = WSP(bf16, WS_Z); bf16* X1b = WSP(bf16, WS_X1B); float* st1 = WSP(float, WS_ST1);
    int* selinfo = WSP(int, WS_SEL); float* gates = (float*)(selinfo + (size_t)T * 4); int* tok_list = WSP(int, WS_TOK);
    unsigned* cnt = F.ctl + CW_CNT + cnt_off + l * NE;
    const float* lg = ln1_g + (size_t)l * DM; const float* lb = ln1_b + (size_t)l * DM;
    f32x4 gv[4], bv[4];
#pragma unroll
    for (int j = 0; j < 4; ++j) { gv[j] = *(const f32x4*)(lg + 4 * lane + 256 * j); bv[j] = *(const f32x4*)(lb + 4 * lane + 256 * j); }
    bf16x8 Bh[4][2], Bl[4][2];
    { const float* rw = router_w + (size_t)l * DM * NE;
#pragma unroll
      for (int ks = 0; ks < 4; ++ks)
#pragma unroll
          for (int et = 0; et < 2; ++et) { float x[8];
#pragma unroll
              for (int j = 0; j < 8; ++j) x[j] = rw[(size_t)(128 * w + 32 * ks + 8 * rq + j) * NE + 16 * et + l15];
              u32x4 h, lo;
#pragma unroll
              for (int p = 0; p < 4; ++p) { const unsigned hp = cvt_pk_bf16(x[2 * p], x[2 * p + 1]); h[p] = hp; lo[p] = cvt_pk_bf16(x[2 * p] - bf_lo(hp), x[2 * p + 1] - bf_hi(hp)); }
              Bh[ks][et] = __builtin_bit_cast(bf16x8, h); Bl[ks][et] = __builtin_bit_cast(bf16x8, lo); } }
    const float rbias = router_b[(size_t)l * NE + (lane & 31)];
    for (int chunk = F.bid; chunk < T / 128; chunk += F.G) {
        if (tid < 32) LCNT[tid] = 0;
        __syncthreads();
        const size_t cbase = (size_t)chunk * 128;
        u32x2 nx[2][4];
#pragma unroll
        for (int q = 0; q < 2; ++q)
#pragma unroll
            for (int j = 0; j < 4; ++j) nx[q][j] = *(const u32x2*)(Z + (cbase + 2 * w + q) * DM + 4 * lane + 256 * j);
#pragma unroll 1
        for (int r = 0; r < 8; ++r) {
            u32x2 cu[2][4];
#pragma unroll
            for (int q = 0; q < 2; ++q)
#pragma unroll
                for (int j = 0; j < 4; ++j) cu[q][j] = nx[q][j];
            if (r < 7) {
#pragma unroll
                for (int q = 0; q < 2; ++q)
#pragma unroll
                    for (int j = 0; j < 4; ++j) nx[q][j] = *(const u32x2*)(Z + (cbase + 16 * (r + 1) + 2 * w + q) * DM + 4 * lane + 256 * j); }
#pragma unroll
            for (int q = 0; q < 2; ++q) { const int tl = 16 * r + 2 * w + q; const size_t t = cbase + tl;
                f32x4 v[4]; float s = 0.f;
#pragma unroll
                for (int j = 0; j < 4; ++j) { v[j] = (f32x4){bf_lo(cu[q][j].x), bf_hi(cu[q][j].x), bf_lo(cu[q][j].y), bf_hi(cu[q][j].y)}; s += (v[j][0] + v[j][1]) + (v[j][2] + v[j][3]); }
                const float mean = wave_sum_dpp(s) * (1.0f / DM); float s2 = 0.f;
#pragma unroll
                for (int j = 0; j < 4; ++j) { v[j] = v[j] - mean; s2 += (v[j][0] * v[j][0] + v[j][1] * v[j][1]) + (v[j][2] * v[j][2] + v[j][3] * v[j][3]); }
                const float rstd = 1.0f / sqrtf(wave_sum_dpp(s2) * (1.0f / DM) + LN_EPS);
                if (lane == 0) *(f32x2*)(st1 + t * 2) = (f32x2){mean, rstd};
#pragma unroll
                for (int j = 0; j < 4; ++j) { v[j] = v[j] * rstd * gv[j] + bv[j];
                    if (MOE_FP8) *(unsigned*)((unsigned char*)X1b + t * DM + 4 * lane + 256 * j) = cvt4_fp8(v[j][0] * 4.0f, v[j][1] * 4.0f, v[j][2] * 4.0f, v[j][3] * 4.0f);
                    else { u32x2 wv; wv.x = cvt_pk_bf16(v[j][0], v[j][1]); wv.y = cvt_pk_bf16(v[j][2], v[j][3]); *(u32x2*)(X1b + t * DM + 4 * lane + 256 * j) = wv; }
                    u32x2 h, lo; h.x = cvt_pk_bf16(v[j][0], v[j][1]); h.y = cvt_pk_bf16(v[j][2], v[j][3]);
                    lo.x = cvt_pk_bf16(v[j][0] - bf_lo(h.x), v[j][1] - bf_hi(h.x)); lo.y = cvt_pk_bf16(v[j][2] - bf_lo(h.y), v[j][3] - bf_hi(h.y));
                    *(LAS u32x2*)(L + RX_H + (2 * w + q) * RX_STRIDE + (4 * lane + 256 * j) * 2) = h; *(LAS u32x2*)(L + RX_L + (2 * w + q) * RX_STRIDE + (4 * lane + 256 * j) * 2) = lo; } }
            __syncthreads();
            f32x4 acc[2] = {(f32x4){0.f, 0.f, 0.f, 0.f}, (f32x4){0.f, 0.f, 0.f, 0.f}};
#pragma unroll
            for (int ks = 0; ks < 4; ++ks) {
                const bf16x8 ah = *(const LAS bf16x8*)(L + RX_H + l15 * RX_STRIDE + (128 * w + 32 * ks + 8 * rq) * 2), al = *(const LAS bf16x8*)(L + RX_L + l15 * RX_STRIDE + (128 * w + 32 * ks + 8 * rq) * 2);
#pragma unroll
                for (int et = 0; et < 2; ++et) { acc[et] = __builtin_amdgcn_mfma_f32_16x16x32_bf16(ah, Bh[ks][et], acc[et], 0, 0, 0); acc[et] = __builtin_amdgcn_mfma_f32_16x16x32_bf16(ah, Bl[ks][et], acc[et], 0, 0, 0);
                    acc[et] = __builtin_amdgcn_mfma_f32_16x16x32_bf16(al, Bh[ks][et], acc[et], 0, 0, 0); } }
            *(LAS f32x4*)(L + RX_PART + ((w * 2 + 0) * 64 + lane) * 16) = acc[0]; *(LAS f32x4*)(L + RX_PART + ((w * 2 + 1) * 64 + lane) * 16) = acc[1];
            __syncthreads();
            float xl;
            { const int tk = 2 * w + (lane >> 5), e = lane & 31, src = ((e >> 4) * 64 + (tk >> 2) * 16 + (e & 15)) * 16 + (tk & 3) * 4; float sum = rbias;
#pragma unroll
              for (int v8 = 0; v8 < 8; ++v8) sum += *(const LAS float*)(L + RX_PART + v8 * 2048 + src);
              xl = sum; }
            float tv[4]; int te[4];
#pragma unroll
            for (int k = 0; k < 4; ++k) { float m = xl;
                m = fmaxf(m, __builtin_bit_cast(float, __builtin_amdgcn_update_dpp(0, __builtin_bit_cast(int, m), 0xB1, 0xF, 0xF, true)));
                m = fmaxf(m, __builtin_bit_cast(float, __builtin_amdgcn_update_dpp(0, __builtin_bit_cast(int, m), 0x4E, 0xF, 0xF, true)));
                m = fmaxf(m, __builtin_bit_cast(float, __builtin_amdgcn_update_dpp(0, __builtin_bit_cast(int, m), 0x141, 0xF, 0xF, true)));
                m = fmaxf(m, __builtin_bit_cast(float, __builtin_amdgcn_update_dpp(0, __builtin_bit_cast(int, m), 0x140, 0xF, 0xF, true)));
                const int mi = __builtin_bit_cast(int, m);
                const float mlo = fmaxf(__builtin_bit_cast(float, __builtin_amdgcn_readlane(mi, 0)), __builtin_bit_cast(float, __builtin_amdgcn_readlane(mi, 16)));
                const float mhi = fmaxf(__builtin_bit_cast(float, __builtin_amdgcn_readlane(mi, 32)), __builtin_bit_cast(float, __builtin_amdgcn_readlane(mi, 48)));
                const float mm = lane < 32 ? mlo : mhi;
                const unsigned long long bal = __ballot(xl == mm);
                const int wlo = __builtin_ctz((unsigned)bal | 0x80000000u), whi = __builtin_ctz((unsigned)(bal >> 32) | 0x80000000u);
                const int win = lane < 32 ? wlo : whi;
                tv[k] = mm; te[k] = win;
                if ((lane & 31) == win) xl = -INFINITY; }
            if ((lane & 31) == 0) {
                const int tk = 2 * w + (lane >> 5), tl = 16 * r + tk; const size_t t = cbase + tl;
                const float v0 = tv[0], v1 = tv[1], v2 = tv[2], v3 = tv[3];
                const float p1 = __expf(v1 - v0), p2 = __expf(v2 - v0), p3 = __expf(v3 - v0), inv = 1.0f / (1.0f + p1 + p2 + p3);
#pragma unroll
                for (int k = 0; k < 4; ++k) { const int lp = __hip_atomic_fetch_add(&LCNT[te[k]], 1, __ATOMIC_RELAXED, __HIP_MEMORY_SCOPE_WORKGROUP); LSEL[tl * 4 + k] = (te[k] << 16) | lp; }
                *(f32x4*)(gates + t * 4) = (f32x4){inv, p1 * inv, p2 * inv, p3 * inv};
            }
        }
        __syncthreads();
        if (tid < 32) LBASE[tid] = (int)__hip_atomic_fetch_add(cnt + tid, (unsigned)LCNT[tid], __ATOMIC_RELAXED, __HIP_MEMORY_SCOPE_AGENT);
        __syncthreads();
        { const int sidx = tid, v = LSEL[sidx], e = v >> 16, pos = LBASE[e] + (v & 0xffff); const int t = chunk * 128 + (sidx >> 2);
          tok_list[(size_t)e * T + pos] = t; selinfo[(size_t)t * 4 + (sidx & 3)] = (e << 16) | pos; }
        __syncthreads();
    }
}

__device__ __forceinline__ void moe_tables(Frame& F, int l, bool fill_idx, int nN) {
    LAS int* TS = (LAS int*)(F.lds + TSTART_OFF); LAS int* LC = (LAS int*)(F.lds + LCNT_OFF); LAS int* IDX = (LAS int*)(F.lds + IDX_OFF);
    const unsigned* cnt = F.ctl + CW_CNT + l * NE;
    __syncthreads();
    if (F.tid < 64) {
        const int e = F.tid & 31; const int c = (int)__hip_atomic_load(cnt + e, __ATOMIC_RELAXED, __HIP_MEMORY_SCOPE_AGENT); const int tl = (c + 255) >> 8;
        int inc = tl;
#pragma unroll
        for (int o = 1; o < 32; o <<= 1) { const int y = __shfl_up(inc, o, 32); if (e >= o) inc += y; }
        if (F.tid < 32) { LC[e] = c; TS[e] = inc - tl; if (e == 31) TS[32] = inc; } }
    __syncthreads();
    if (fill_idx) {
        const int* tok_list = WSP(int, WS_TOK); const int ntile = TS[32];
        int tv[IDX_SLOTS];
#pragma unroll
        for (int s = 0; s < IDX_SLOTS; ++s) { int mtg, pn_; pg8::moe_unit_map(s, F.bid, nN, F.G, mtg, pn_); tv[s] = 0;
            if (mtg < ntile && F.tid < 256) { int e = 0; for (int k = 1; k < 32; ++k) e += (TS[k] <= mtg) ? 1 : 0;
                const int r = (mtg - TS[e]) * 256 + F.tid; if (r < LC[e]) tv[s] = tok_list[(size_t)e * T + r]; } }
        if (F.tid < 256) {
#pragma unroll
            for (int s = 0; s < IDX_SLOTS; ++s) IDX[s * 256 + F.tid] = tv[s]; }
        __syncthreads();
    }
}

#if MOE_FP8
typedef unsigned YR_T;
#define YR_LOAD(row_, j_) __builtin_nontemporal_load((const unsigned*)((const unsigned char*)Yr + (row_) * DM + 4 * lane + 256 * (j_)))
#else
typedef u32x2 YR_T;
#define YR_LOAD(row_, j_) (*(const u32x2*)(Yr + (row_) * DM + 4 * lane + 256 * (j_)))
#endif
__device__ __forceinline__ void combine_phase(Frame& F, int l, float* Xo, const float* ln1_g, const float* ln1_b, const float* ln2_g, const float* ln2_b) {
    LAS int* TS = (LAS int*)(F.lds + TSTART_OFF);
    const int lane = F.lane;
    const bf16* Z = WSP(bf16, WS_Z); const float* st1 = WSP(float, WS_ST1); const bf16* Yr = WSP(bf16, WS_YRAW);
    const int* selinfo = WSP(int, WS_SEL); const float* gates = (const float*)(selinfo + (size_t)T * 4);
    bf16* Xb = WSP(bf16, WS_XB);
    const float* lg1 = ln1_g + (size_t)l * DM; const float* lb1 = ln1_b + (size_t)l * DM; const float* lg = ln2_g + (size_t)l * DM; const float* lb = ln2_b + (size_t)l * DM;
    f32x4 gv[4], bv[4], g1v[4], b1v[4];
#pragma unroll
    for (int j = 0; j < 4; ++j) { gv[j] = *(const f32x4*)(lg + 4 * lane + 256 * j); bv[j] = *(const f32x4*)(lb + 4 * lane + 256 * j); g1v[j] = *(const f32x4*)(lg1 + 4 * lane + 256 * j); b1v[j] = *(const f32x4*)(lb1 + 4 * lane + 256 * j); }
    const int tfirst = F.bid * NWAVES + F.wave, tstep = F.G * NWAVES;
    const int ntok = (T - tfirst + tstep - 1) / tstep;
    i32x4 si_n; f32x4 gt_n;
    u32x2 zr[4]; YR_T yr[4][4]; f32x2 ms; f32x4 gt_c;
    { const i32x4 s0 = *(const i32x4*)(selinfo + (size_t)tfirst * 4); gt_c = *(const f32x4*)(gates + (size_t)tfirst * 4); ms = *(const f32x2*)(st1 + (size_t)tfirst * 2);
#pragma unroll
      for (int j = 0; j < 4; ++j) zr[j] = __builtin_nontemporal_load((const u32x2*)(Z + (size_t)tfirst * DM + 4 * lane + 256 * j));
#pragma unroll
      for (int k = 0; k < 4; ++k) { const size_t row = (size_t)TS[s0[k] >> 16] * 256 + (s0[k] & 0xffff);
#pragma unroll
          for (int j = 0; j < 4; ++j) yr[k][j] = YR_LOAD(row, j); }
      const int t1 = tfirst + tstep < T ? tfirst + tstep : tfirst; si_n = *(const i32x4*)(selinfo + (size_t)t1 * 4); gt_n = *(const f32x4*)(gates + (size_t)t1 * 4); }
    for (int i = 0; i < ntok; ++i) {
        const int t = tfirst + i * tstep;
        f32x4 v[4];
#pragma unroll
        for (int j = 0; j < 4; ++j) { const f32x4 zf = (f32x4){bf_lo(zr[j].x), bf_hi(zr[j].x), bf_lo(zr[j].y), bf_hi(zr[j].y)};
            v[j] = ((zf - ms.x) * ms.y * g1v[j] + b1v[j]) * DN_ALPHA; }
#pragma unroll
        for (int k = 0; k < 4; ++k)
#pragma unroll
            for (int j = 0; j < 4; ++j) {
#if MOE_FP8
                const int y = (int)yr[k][j]; const float gt = gt_c[k] * (1.0f / 16.0f);
                v[j][0] += gt * __builtin_amdgcn_cvt_f32_fp8(y, 0); v[j][1] += gt * __builtin_amdgcn_cvt_f32_fp8(y, 1); v[j][2] += gt * __builtin_amdgcn_cvt_f32_fp8(y, 2); v[j][3] += gt * __builtin_amdgcn_cvt_f32_fp8(y, 3);
#else
                const u32x2 y = yr[k][j]; const float gt = gt_c[k];
                v[j][0] += gt * bf_lo(y.x); v[j][1] += gt * bf_hi(y.x); v[j][2] += gt * bf_lo(y.y); v[j][3] += gt * bf_hi(y.y);
#endif
            }
        if (i + 1 < ntok) { const int tn = t + tstep; const i32x4 s1 = si_n; gt_c = gt_n; ms = *(const f32x2*)(st1 + (size_t)tn * 2);
#pragma unroll
            for (int j = 0; j < 4; ++j) zr[j] = __builtin_nontemporal_load((const u32x2*)(Z + (size_t)tn * DM + 4 * lane + 256 * j));
#pragma unroll
            for (int k = 0; k < 4; ++k) { const size_t row = (size_t)TS[s1[k] >> 16] * 256 + (s1[k] & 0xffff);
#pragma unroll
                for (int j = 0; j < 4; ++j) yr[k][j] = YR_LOAD(row, j); }
            const int t2 = tn + tstep < T ? tn + tstep : tn; si_n = *(const i32x4*)(selinfo + (size_t)t2 * 4); gt_n = *(const f32x4*)(gates + (size_t)t2 * 4); }
        float s = 0.f;
#pragma unroll
        for (int j = 0; j < 4; ++j) s += (v[j][0] + v[j][1]) + (v[j][2] + v[j][3]);
        const float mean = wave_sum_dpp(s) * (1.0f / DM); float s2 = 0.f;
#pragma unroll
        for (int j = 0; j < 4; ++j) { v[j] = v[j] - mean; s2 += (v[j][0] * v[j][0] + v[j][1] * v[j][1]) + (v[j][2] * v[j][2] + v[j][3] * v[j][3]); }
        const float rstd = 1.0f / sqrtf(wave_sum_dpp(s2) * (1.0f / DM) + LN_EPS);
#pragma unroll
        for (int j = 0; j < 4; ++j) { v[j] = v[j] * rstd * gv[j] + bv[j];
            if (Xo) *(f32x4*)(Xo + (size_t)t * DM + 4 * lane + 256 * j) = v[j];
            if (!Xo) { u32x2 wv; wv.x = cvt_pk_bf16(v[j][0], v[j][1]); wv.y = cvt_pk_bf16(v[j][2], v[j][3]); *(u32x2*)(Xb + (size_t)t * DM + 4 * lane + 256 * j) = wv; }
            if (INPROJ_FP8 && !Xo) *(unsigned*)(WSP(unsigned char, WS_XQ) + (size_t)t * DM + 4 * lane + 256 * j) = cvt4_fp8(v[j][0] * 4.0f, v[j][1] * 4.0f, v[j][2] * 4.0f, v[j][3] * 4.0f); }
    }
}

constexpr int NPH = 8, N_PHASES = 1 + NL * NPH;
struct Args { const float* in[19]; float* out; unsigned char* ws; int ph_lo, ph_hi; };
static_assert(sizeof(Args) == 19 * 8 + 8 + 8 + 8, "Args has no padding");

__global__ void __launch_bounds__(NTHREADS, 2) mk_fwd(Args args) {
    extern __shared__ __attribute__((aligned(16))) unsigned char lds_raw[];
    Frame F;
    F.lds = (LAS unsigned char*)lds_raw; F.MISC = (volatile LAS unsigned*)(F.lds + MISC_OFF);
    F.tid = threadIdx.x; F.lane = F.tid & 63; F.wave = __builtin_amdgcn_readfirstlane(F.tid >> 6); F.G = gridDim.x; F.bid = blockIdx.x;
    F.ws = args.ws; F.ctl = (unsigned*)(args.ws + WS_CTL);
    if (F.tid < 16) F.MISC[F.tid] = 0u;
    __syncthreads();
    XcdBarrier bar; bar.bar = F.ctl + CW_BAR; bar.x = 0; bar.st = nullptr;
    if (MK_N_LAUNCHES == 1) bar = xcd_barrier_post(F.ctl + CW_BAR, F.MISC + 8);
    const int lo = args.ph_lo, hi = args.ph_hi;
#ifndef PH_MASK
#define PH_MASK 0x1ff
#endif
#define PHON(p) ((PH_MASK >> (p)) & 1)
#ifndef PROBE_DUP
#define PROBE_DUP 0
#endif
#define DUP(p) for (int rep_ = 0; rep_ < 1 + ((PROBE_DUP >> (p)) & 1); ++rep_, frame_refresh(F))
#define IN(k) (lo <= (k) && (k) < hi)
#define REFRESH() frame_refresh(F)
#ifndef PROBE_BAR2
#define PROBE_BAR2 0
#endif
#define SEAM(k) do { if (IN((k) + 1)) { if (MK_N_LAUNCHES == 1) { xcd_barrier(bar); if (PROBE_BAR2) xcd_barrier(bar); } } } while (0)

    if (PHON(8) && IN(0)) { REFRESH(); DUP(8) p0_prologue(F, args.in[0], args.in[1], args.in[2], args.in[7], args.in[8], args.in[5], args.in[13], args.in[15]); SEAM(0); }

    for (int l = 0; l < NL; ++l) {
        const int pb = 1 + l * NPH;
        int z = 0; asm volatile("" : "+s"(z));
#define ARGP(i) (args.in[(i) + z])
        if (PHON(0) && IN(pb + 0)) { REFRESH(); DUP(0) {
            pg8::InProjSched S{INPROJ_FP8 ? (const char*)WSP(unsigned char, WS_XQ) : (const char*)WSP(bf16, WS_XB), (const char*)WSP(unsigned char, WS_WIN) + (size_t)l * INW * DM * (INPROJ_FP8 ? 1 : 2), INPROJ_FP8 ? DM : 2 * DM, F.G, F.bid};
            EpiInProj E{WSP(bf16, WS_P), WSP(bf16, WS_ROPEB), WSP(unsigned char, WS_PG8)};
            pg8::gemm_phase<EpiInProj, pg8::InProjSched, false, true, F8_SP2 != 0, INPROJ_FP8 != 0>(F.lds, INPROJ_FP8 ? DM : 2 * DM, S, E); }
            SEAM(pb + 0);
        }
        if (PHON(1) && IN(pb + 1)) { REFRESH();
            DUP(1) {
#ifndef NO_RET
                if (F.bid < 192) for (int r2 = 0; r2 < 1 + ((PROBE_DUP >> 10) & 1); ++r2, frame_refresh(F)) ret_prepass(F, (F.bid / 3) >> 2, (F.bid / 3) & 3, F.bid % 3);
#endif
#ifndef NO_SGU
                for (int r2 = 0; r2 < 1 + ((PROBE_DUP >> 9) & 1); ++r2, frame_refresh(F)) sgu_unit(F, F.bid, l, ARGP(6), ARGP(3), ARGP(4));
#endif
                if (MK_N_LAUNCHES == 1) xcd_barrier(bar);
                REFRESH();
#ifndef NO_RET
                for (int r2 = 0; r2 < 1 + ((PROBE_DUP >> 11) & 1); ++r2, frame_refresh(F)) ret_unit(F, F.bid >> 4, (F.bid >> 2) & 3, F.bid & 3);
#endif
            }
            SEAM(pb + 1);
        }
        if (PHON(2) && IN(pb + 2)) { REFRESH(); DUP(2) {
            { pg8::DenseSched S; S.init(WSP(bf16, WS_YRET), WSP(bf16, WS_PRET) + (size_t)l * DM * DM, T, DM, DM, F.G, F.bid);
              EpiGate1 E{WSP(bf16, WS_P), WSP(bf16, WS_HF), WSP(unsigned char, WS_PG8)};
              pg8::gemm_phase<EpiGate1, pg8::DenseSched, false, true, true>(F.lds, 2 * DM, S, E); }
            { pg8::DenseSched S; S.init(WSP(bf16, WS_YSG), WSP(bf16, WS_PSG) + (size_t)l * DM * DM, T, DM, DM, F.G, F.bid);
              EpiGate2 E{WSP(bf16, WS_P), WSP(bf16, WS_HF), WSP(bf16, WS_HB), WSP(unsigned char, WS_PG8)};
              pg8::gemm_phase<EpiGate2, pg8::DenseSched, false, true, true>(F.lds, 2 * DM, S, E); } }
            SEAM(pb + 2);
        }
        if (PHON(3) && IN(pb + 3)) { REFRESH(); DUP(3) {
            pg8::DenseSched S; S.init(WSP(bf16, WS_HB), WSP(bf16, WS_WO) + (size_t)l * DM * DM, T, DM, DM, F.G, F.bid);
            EpiResid E{(l == 0) ? ARGP(0) : (const float*)nullptr, WSP(bf16, WS_XB), WSP(bf16, WS_Z)};
            pg8::gemm_phase<EpiResid, pg8::DenseSched, false, true, true>(F.lds, 2 * DM, S, E); }
            SEAM(pb + 3);
        }
        if (PHON(4) && IN(pb + 4)) { REFRESH();
#if (PROBE_DUP >> 4) & 1
            ln_router_phase(F, l, 128, ARGP(11), ARGP(12), ARGP(9), ARGP(10)); xcd_barrier(bar); REFRESH();
#endif
            ln_router_phase(F, l, 0, ARGP(11), ARGP(12), ARGP(9), ARGP(10)); SEAM(pb + 4); }
        if (PHON(5) && IN(pb + 5)) { REFRESH(); DUP(5) {
            moe_tables(F, l, true, 2 * DEXP / 256);
            constexpr int EB = MOE_FP8 ? 1 : 2;
            pg8::MoeSched<true> S{(const char*)WSP(bf16, WS_X1B), (const char*)WSP(unsigned char, WS_W1) + (size_t)l * NE * 2 * DEXP * DM * EB, DM * EB, 2 * DEXP, 2 * DEXP / 256, F.G, F.bid,
                                  (const LAS int*)(F.lds + TSTART_OFF), (const LAS int*)(F.lds + IDX_OFF)};
            EpiSwiglu E{WSP(bf16, WS_ACT), ARGP(14) + (size_t)l * NE * 2 * DEXP, F.lds};
            pg8::gemm_phase<EpiSwiglu, pg8::MoeSched<true>, true, true, F8_SP2 != 0, MOE_FP8 != 0>(F.lds, DM * EB, S, E); }
            SEAM(pb + 5);
        }
        if (PHON(6) && IN(pb + 6)) { REFRESH(); DUP(6) {
            moe_tables(F, l, false, DM / 256);
            constexpr int EB = MOE_FP8 ? 1 : 2;
            pg8::MoeSched<false> S{(const char*)WSP(bf16, WS_ACT), (const char*)WSP(unsigned char, WS_W2) + (size_t)l * NE * DM * DEXP * EB, DEXP * EB, DM, DM / 256, F.G, F.bid,
                                   (const LAS int*)(F.lds + TSTART_OFF), (const LAS int*)(F.lds + IDX_OFF)};
            EpiBias E{WSP(bf16, WS_YRAW), ARGP(16) + (size_t)l * NE * DM, F.lds};
            pg8::gemm_phase<EpiBias, pg8::MoeSched<false>, false, true, F8_SP2 != 0, MOE_FP8 != 0>(F.lds, DEXP * EB, S, E); }
            SEAM(pb + 6);
        }
        if (PHON(7) && IN(pb + 7)) { REFRESH(); moe_tables(F, l, false, 1); DUP(7) combine_phase(F, l, (l == NL - 1) ? args.out : (float*)nullptr, ARGP(9), ARGP(10), ARGP(17), ARGP(18)); SEAM(pb + 7); }
    }
#undef IN
#undef SEAM
#undef ARGP
#undef REFRESH
}

extern "C" void kernel_launch(void* const* d_in, const int* in_sizes, int n_in, void* d_out, int out_size, void* d_ws, size_t ws_size, hipStream_t stream) {
    static int grid = 0;
    if (grid == 0) {
        if (n_in != 19 || in_sizes[0] != T * DM || out_size != T * DM || ws_size < WS_END) { fprintf(stderr, "kernel_launch: unexpected shapes (n_in %d, in0 %d, out %d, ws %zu)\n", n_in, n_in > 0 ? in_sizes[0] : -1, out_size, ws_size); grid = -1; return; }
        int dev = 0, cus = 0, per_cu = 0;
        if (hipGetDevice(&dev) != hipSuccess || hipDeviceGetAttribute(&cus, hipDeviceAttributeMultiprocessorCount, dev) != hipSuccess) { fprintf(stderr, "kernel_launch: device query failed\n"); grid = -1; return; }
        if (hipFuncSetAttribute((const void*)mk_fwd, hipFuncAttributeMaxDynamicSharedMemorySize, LDS_BYTES) != hipSuccess) { fprintf(stderr, "kernel_launch: hipFuncSetAttribute failed\n"); grid = -1; return; }
        if (hipOccupancyMaxActiveBlocksPerMultiprocessor(&per_cu, (const void*)mk_fwd, NTHREADS, LDS_BYTES) != hipSuccess || per_cu < 1) fprintf(stderr, "kernel_launch: occupancy query reports %d blocks per CU\n", per_cu);
        (void)hipGetLastError();
        grid = cus < 256 ? cus : 256;
        if (grid != 256) fprintf(stderr, "kernel_launch: %d CUs; the MoE row tables assume 256 workgroups\n", grid);
    }
    if (grid < 0) return;
    (void)hipMemsetAsync((char*)d_ws + WS_CTL, 0, CTL_ZERO_BYTES, stream);
    Args a{};
    for (int i = 0; i < 19; ++i) a.in[i] = (const float*)d_in[i];
    a.out = (float*)d_out; a.ws = (unsigned char*)d_ws;
    if (MK_N_LAUNCHES == 1) {
        a.ph_lo = 0; a.ph_hi = N_PHASES;
        hipLaunchKernelGGL(mk_fwd, dim3(grid), dim3(NTHREADS), LDS_BYTES, stream, a);
    } else {
        for (int p = 0; p < N_PHASES; ++p) { a.ph_lo = p; a.ph_hi = p + 1; hipLaunchKernelGGL(mk_fwd, dim3(grid), dim3(NTHREADS), LDS_BYTES, stream, a); }
    }
    const hipError_t le = hipPeekAtLastError();
    if (le != hipSuccess) fprintf(stderr, "kernel_launch: launch failed: %s\n", hipGetErrorName(le));
}
```

```cpp
#include <hip/hip_runtime.h>
#include <cstdio>
#include <cstdint>

#ifndef MK_N_LAUNCHES
#define MK_N_LAUNCHES 1
#endif

#ifndef INPROJ_FP8
#define INPROJ_FP8 1
#endif
#ifndef GATE_U8
#define GATE_U8 1
#endif
#ifndef MOE_BIAS_LDS
#define MOE_BIAS_LDS 0
#endif
#ifndef F8_SP2
#define F8_SP2 0
#endif
#ifndef MOE_FP8
#define MOE_FP8 1
#endif
#define LAS __attribute__((address_space(3)))
#define GAS __attribute__((address_space(1)))
typedef unsigned short bf16;
typedef short bf16x8 __attribute__((ext_vector_type(8)));
typedef short s16x4 __attribute__((ext_vector_type(4)));
typedef float f32x4 __attribute__((ext_vector_type(4)));
typedef float f32x2 __attribute__((ext_vector_type(2)));
typedef unsigned u32x4 __attribute__((ext_vector_type(4)));
typedef unsigned u32x2 __attribute__((ext_vector_type(2)));
typedef int i32x4 __attribute__((ext_vector_type(4)));
typedef GAS unsigned gu32;

constexpr int DM = 1024, NBATCH = 16, SEQ = 2048, T = NBATCH * SEQ, NL = 4;
constexpr int INW = 7168, NE = 32, TOPK = 4, DEXP = 1024;
constexpr int C_Q = 0, C_K = 512, C_V = 1024, C_G = 2048, C_U = 3072, C_VS = 4096, C_GA = 5120, C_GB = 6144;
constexpr float LN_EPS = 1e-5f, DN_ALPHA = 1.681792830507429f;
constexpr int AROWS = T * TOPK + NE * 256;
constexpr int NWAVES = 8, NTHREADS = 512;

constexpr size_t MiB = 1u << 20;
constexpr size_t WS_CTL = 0, CTL_ZERO_BYTES = 65536;
constexpr size_t WS_ST1 = 256 * 1024;
constexpr size_t WS_ROPE = 1 * MiB;
constexpr size_t WS_ROPEB = (1944 + 100) * MiB;
constexpr size_t WS_SEL = 2 * MiB;
constexpr size_t WS_TOK = 3 * MiB;
constexpr size_t WS_SGW = 7 * MiB;
constexpr size_t WS_WIN = 8 * MiB;
constexpr size_t WS_PRET = 64 * MiB, WS_PSG = 72 * MiB, WS_WO = 80 * MiB;
constexpr size_t WS_W1 = 88 * MiB;
constexpr size_t WS_W2 = 600 * MiB;
constexpr size_t WS_XF = 856 * MiB;
constexpr size_t WS_XB = 984 * MiB;
constexpr size_t WS_XQ = 856 * MiB;
constexpr size_t WS_P = 1048 * MiB;
constexpr size_t WS_YRET = 1496 * MiB, WS_YSG = 1560 * MiB;
constexpr size_t WS_HF = 1624 * MiB;
constexpr size_t WS_HB = 1752 * MiB;
constexpr size_t WS_Z = 1816 * MiB;
constexpr size_t WS_X1F = 1944 * MiB;
constexpr size_t WS_PG8 = (1944 + 32) * MiB;
constexpr size_t WS_X1B = 2072 * MiB;
constexpr size_t WS_ACT = 2136 * MiB;
constexpr size_t WS_YRAW = 2408 * MiB;
constexpr size_t WS_END = 2680 * MiB;
static_assert((size_t)AROWS * 1024 * 2 <= 272 * MiB, "expert row buffers");
constexpr int CW_TMO = 0, CW_CODE = 1, CW_BAR = 4096, CW_CNT = 8192;

constexpr int RING_BYTES = 131072;
constexpr int IDX_OFF = RING_BYTES, IDX_SLOTS = 18;
constexpr int TSTART_OFF = IDX_OFF + IDX_SLOTS * 1024;
constexpr int LCNT_OFF = TSTART_OFF + 256, LBASE_OFF = LCNT_OFF + 128, LSEL_OFF = LBASE_OFF + 128;
constexpr int MISC_OFF = LSEL_OFF + 2048;
constexpr int LDS_BYTES = 163840;
constexpr int BIAS_OFF = 153600;
static_assert(MISC_OFF + 64 <= BIAS_OFF && BIAS_OFF + 2048 <= LDS_BYTES, "LDS map");

#define RLX_AGENT __ATOMIC_RELAXED, __HIP_MEMORY_SCOPE_AGENT
#define LDS_WAIT() asm volatile("s_waitcnt lgkmcnt(0)" ::: "memory")
#define VM_WAIT() asm volatile("s_waitcnt vmcnt(0)" ::: "memory")
__device__ __forceinline__ unsigned cvt_pk_bf16(float lo, float hi) { unsigned r; asm volatile("v_cvt_pk_bf16_f32 %0, %1, %2" : "=v"(r) : "v"(lo), "v"(hi)); return r; }
__device__ __forceinline__ unsigned cvt4_fp8(float a, float b, float c, float d) { int w = __builtin_amdgcn_cvt_pk_fp8_f32(a, b, 0, false); w = __builtin_amdgcn_cvt_pk_fp8_f32(c, d, w, true); return (unsigned)w; }
__device__ __forceinline__ void unpack8_u8(const u32x2 w, f32x4& a, f32x4& b) {
    a = (f32x4){(float)(w.x & 0xffu), (float)((w.x >> 8) & 0xffu), (float)((w.x >> 16) & 0xffu), (float)(w.x >> 24)} * (1.0f / 255.0f);
    b = (f32x4){(float)(w.y & 0xffu), (float)((w.y >> 8) & 0xffu), (float)((w.y >> 16) & 0xffu), (float)(w.y >> 24)} * (1.0f / 255.0f); }
__device__ __forceinline__ unsigned pack4_u8(const f32x4 s) { return (unsigned)(s[0] * 255.0f + 0.5f) | ((unsigned)(s[1] * 255.0f + 0.5f) << 8) | ((unsigned)(s[2] * 255.0f + 0.5f) << 16) | ((unsigned)(s[3] * 255.0f + 0.5f) << 24); }
__device__ __forceinline__ float bf_lo(unsigned w) { return __uint_as_float(w << 16); }
__device__ __forceinline__ float bf_hi(unsigned w) { return __uint_as_float(w & 0xffff0000u); }
__device__ __forceinline__ float sigmoidf_(float x) { return __builtin_amdgcn_rcpf(1.0f + __builtin_amdgcn_exp2f(x * -1.4426950408889634f)); }
__device__ __forceinline__ float siluf_(float x) { return x * sigmoidf_(x); }
__device__ __forceinline__ float geluf_(float x) { return x * sigmoidf_(1.5957691216057308f * (x + 0.044715f * x * x * x)); }
__device__ __forceinline__ float lg2_gamma(int h) { return h == 0 ? -0.04580368961312479f : h == 1 ? -0.018003552928331026f : h == 2 ? -0.007117849617096985f : -0.0028205190623786626f; }
__device__ __forceinline__ int opaque_tid() { int t = threadIdx.x; asm volatile("" : "+v"(t)); return t; }
__device__ __forceinline__ float wave_sum(float v) {
#pragma unroll
    for (int o = 1; o < 64; o <<= 1) v += __shfl_xor(v, o);
    return v;
}

#define XB_TMO      128
#define XB_XCNT(j)  (256  + 64 * (j))
#define XB_XSUB(j)  (1280 + 64 * (j))
#define XB_XGEN(j)  (2304 + 64 * (j))
#define XB_TOP      3328
#define XB_TOPGEN   3392
#define XCD_BAR_WORDS 3456
#define XB_SPIN_CAP (1u << 18)
__device__ __forceinline__ unsigned xb_ld(unsigned* p)              { return __hip_atomic_load(p, __ATOMIC_RELAXED, __HIP_MEMORY_SCOPE_AGENT); }
__device__ __forceinline__ unsigned xb_add(unsigned* p, unsigned v) { return __hip_atomic_fetch_add(p, v, __ATOMIC_RELAXED, __HIP_MEMORY_SCOPE_AGENT); }
__device__ __forceinline__ unsigned xb_xcc_id() { return (unsigned)__builtin_amdgcn_s_getreg((3 << 11) | 20) & 0xFu; }
#define XB_SPIN(cond, bar) do { unsigned _sp = 0; while (cond) { __builtin_amdgcn_s_sleep(1); \
    if ((++_sp & 255u) == 0u) { if (xb_ld(&(bar)[XB_TMO])) break; if (_sp > XB_SPIN_CAP) { atomicAdd(&(bar)[XB_TMO], 1u); break; } } } } while (0)
struct XcdBarrier { unsigned* bar; unsigned x; volatile LAS unsigned* st; };
__device__ __forceinline__ XcdBarrier xcd_barrier_post(unsigned* bar, volatile LAS unsigned* st) {
    XcdBarrier b; b.bar = bar; b.x = xb_xcc_id(); b.st = st;
    if (threadIdx.x == 0) (void)xb_add(&bar[XB_XCNT(b.x)], 1u);
    return b;
}
__device__ __forceinline__ void xcd_barrier_complete(unsigned* bar, unsigned x, unsigned& nloc, unsigned& nx) {
    const unsigned G = gridDim.x * gridDim.y * gridDim.z;
    unsigned sum, cnt, mine, sp = 0u;
    for (;;) {
        sum = 0u; cnt = 0u; mine = 0u;
#pragma unroll
        for (unsigned j = 0; j < 16; ++j) { const unsigned c = xb_ld(&bar[XB_XCNT(j)]); sum += c; cnt += (c > 0u) ? 1u : 0u; mine = (j == x) ? c : mine; }
        if (sum == G) break;
        __builtin_amdgcn_s_sleep(1);
        if ((++sp & 255u) == 0u) { if (xb_ld(&bar[XB_TMO])) break; if (sp > XB_SPIN_CAP) { atomicAdd(&bar[XB_TMO], 1u); break; } }
    }
    nloc = mine > 0u ? mine : 1u; nx = cnt > 0u ? cnt : 1u;
}
__device__ __forceinline__ void xcd_barrier(const XcdBarrier& b) {
    asm volatile("s_waitcnt vmcnt(0)" ::: "memory");
    __syncthreads();
    if (threadIdx.x == 0) {
        unsigned* bar = b.bar;
        __builtin_amdgcn_s_waitcnt(0);
        unsigned nloc = b.st[0], nx = b.st[1];
        if (nloc == 0u) { xcd_barrier_complete(bar, b.x, nloc, nx); b.st[0] = nloc; b.st[1] = nx; }
        const unsigned old = xb_add(&bar[XB_XSUB(b.x)], 1u);
        const unsigned gen = old / nloc;
        if (old + 1u == (gen + 1u) * nloc) {
            __builtin_amdgcn_fence(__ATOMIC_RELEASE, "agent");
            asm volatile("s_waitcnt vmcnt(0)" ::: "memory");
            const unsigned og = xb_add(&bar[XB_TOP], 1u);
            const unsigned tg = og / nx;
            if (og + 1u == (tg + 1u) * nx) xb_add(&bar[XB_TOPGEN], 1u);
            else XB_SPIN(xb_ld(&bar[XB_TOPGEN]) == tg, bar);
            __builtin_amdgcn_fence(__ATOMIC_ACQUIRE, "agent");
            xb_add(&bar[XB_XGEN(b.x)], 1u);
            asm volatile("s_waitcnt vmcnt(0)" ::: "memory");
        } else {
            XB_SPIN(xb_ld(&bar[XB_XGEN(b.x)]) == gen, bar);
            __builtin_amdgcn_fence(__ATOMIC_ACQUIRE, "agent");
            asm volatile("s_waitcnt vmcnt(0)" ::: "memory");
        }
    }
    __syncthreads();
}

namespace pg8 {
constexpr int BM = 256, BK = 64, HALF = 128, HTB = HALF * BK * 2, STAGE_BYTES = 8 * HTB, NXCD = 8, WGM = 8;
__host__ __device__ __forceinline__ int lds_byte(int r, int c) { const int st = (r >> 4) * 2 + (c >> 5), rr = r & 15, cc = c & 31, ob = rr * 64 + cc * 2; return st * 1024 + (ob ^ (((ob >> 9) & 1) << 5)); }
__host__ __device__ __forceinline__ void stage_rc(int b, int& R, int& C) { const int st = b / 1024, sb = b % 1024, swz = sb ^ (((sb >> 9) & 1) << 5); R = (st >> 1) * 16 + swz / 64; C = (st & 1) * 32 + (swz % 64) / 2; }
__host__ __device__ __forceinline__ int perm32(int rho) { const int n = rho >> 4, i = rho & 15; return 8 * (i >> 2) + 4 * n + (i & 3); }

struct Unit { const char* a; const char* b; int r0, c0, e, slot; };

struct StaticOrder {
    int nM, nN, nwg, G, c;
    __device__ void init(int M, int N, int G_, int c_) { nM = M / BM; nN = N / BM; nwg = nM * nN; G = G_; c = c_; }
    __device__ bool next(int i, int& pm, int& pn) const {
        const long L = (long)i * G + c; if (L >= nwg) return false;
        int wgid = (int)L; { const int q = nwg / NXCD, r = nwg % NXCD, xcd = wgid % NXCD, off = wgid / NXCD; wgid = (xcd < r ? xcd * (q + 1) : r * (q + 1) + (xcd - r) * q) + off; }
        const int nig = WGM * nN, gid = wgid / nig, fm = gid * WGM, gsz = (nM - fm) < WGM ? (nM - fm) : WGM;
        pm = fm + ((wgid % nig) % gsz); pn = (wgid % nig) / gsz; return true;
    }
};
struct DenseSched {
    const char* A; const char* Bt; int KB; StaticOrder so;
    __device__ void init(const bf16* A_, const bf16* Bt_, int M, int N, int K_, int G, int c) { A = (const char*)A_; Bt = (const char*)Bt_; KB = 2 * K_; so.init(M, N, G, c); }
    __device__ __forceinline__ bool next(int i, Unit& u) const { int pm, pn; if (!so.next(i, pm, pn)) return false;
        u.a = A + (size_t)pm * BM * KB; u.b = Bt + (size_t)pn * BM * KB; u.r0 = pm * BM; u.c0 = pn * BM; u.e = 0; u.slot = i; return true; }
    __device__ __forceinline__ void aoff(const Unit&, const int (&R)[2], const int (&C)[2], unsigned (&v)[2][2]) const {
#pragma unroll
        for (int h = 0; h < 2; ++h)
#pragma unroll
            for (int i = 0; i < 2; ++i) v[h][i] = (unsigned)((h * HALF + R[i]) * KB + C[i] * 2); }
};
struct InProjSched {
    const char* A; const char* Bt; int KB, G, c;
    __device__ __forceinline__ bool next(int i, Unit& u) const {
        const int L = i * G + c; if (L >= 128 * 28) return false;
        const int x = L & 7, off = L >> 3, blk = off >> 6, r = off & 63;
        const int pm = 16 * x + (r & 7) + 8 * (r >> 5), ob = blk == 0 ? 6 : blk == 1 ? 5 : blk == 2 ? 2 : blk == 3 ? 3 : blk == 4 ? 4 : blk == 5 ? 0 : 1, pn = 4 * ob + ((r >> 3) & 3);
        u.a = A + (size_t)pm * BM * KB; u.b = Bt + (size_t)pn * BM * KB; u.r0 = pm * BM; u.c0 = pn * BM; u.e = 0; u.slot = i; return true; }
    __device__ __forceinline__ void aoff(const Unit&, const int (&R)[2], const int (&C)[2], unsigned (&v)[2][2]) const {
#pragma unroll
        for (int h = 0; h < 2; ++h)
#pragma unroll
            for (int i = 0; i < 2; ++i) v[h][i] = (unsigned)((h * HALF + R[i]) * KB + C[i] * 2); }
};
__device__ __forceinline__ void moe_unit_map(int i, int c, int nN, int G, int& mtg, int& pn) {
    const int ls = nN == 8 ? 3 : nN == 4 ? 2 : nN == 2 ? 1 : 0;
    if (G == 256) { const int x = c & 7, r = c >> 3; mtg = i * (256 >> ls) + x * (32 >> ls) + (r >> ls); pn = r & (nN - 1); }
    else { const int U = i * G + c; mtg = U >> ls; pn = U & (nN - 1); } }
template <bool GATHER> struct MoeSched {
    const char* A; const char* Wt; int KB, N, nN, G, c; const LAS int* tstart; const LAS int* idx; int Mt, tsl;
    __device__ __forceinline__ bool next(int i, Unit& u) const {
        int mtg, pn; moe_unit_map(i, c, nN, G, mtg, pn); if (mtg >= Mt) return false;
        const int e = __builtin_popcount(((unsigned)__ballot(tsl <= mtg)) >> 1);
        u.e = e; u.r0 = mtg * BM; u.c0 = pn * BM; u.slot = i;
        u.a = GATHER ? A : A + (size_t)mtg * BM * KB; u.b = Wt + ((size_t)e * N + (size_t)pn * BM) * KB; return true; }
    __device__ __forceinline__ void aoff(const Unit& u, const int (&R)[2], const int (&C)[2], unsigned (&v)[2][2]) const {
#pragma unroll
        for (int h = 0; h < 2; ++h)
#pragma unroll
            for (int i = 0; i < 2; ++i) { const int row = GATHER ? idx[u.slot * 256 + h * HALF + R[i]] : (h * HALF + R[i]); v[h][i] = (unsigned)(row * KB + C[i] * 2); } }
};

typedef int v8i32 __attribute__((ext_vector_type(8)));
template <class E, class = void> struct has_bias_lds { static constexpr bool value = false; };
template <class E> struct has_bias_lds<E, decltype((void)E::BIAS_LDS)> { static constexpr bool value = E::BIAS_LDS; };
template <class E, class = void> struct has_probe2 { static constexpr bool value = false; };
template <class E> struct has_probe2<E, decltype((void)E::PROBE2)> { static constexpr bool value = true; };
template <class Epi, class Sched, bool GATHER, bool ALIGN_EPI, bool SP2, bool F8 = false>
__device__ __forceinline__ void gemm_phase(LAS unsigned char* lds, const int KB, const Sched& S, const Epi& E) {
    const int tid = opaque_tid(), wid = __builtin_amdgcn_readfirstlane(tid >> 6), lane = tid & 63, wr = wid >> 2, wc = wid & 3, fr = lane & 15, fq = lane >> 4;
    const int nt = KB / (2 * BK);
    int Rr[2], Cc[2]; unsigned voffB[2], voffB1[2];
#pragma unroll
    for (int i = 0; i < 2; ++i) { int R, C; stage_rc(tid * 16 + i * 8192, R, C); Rr[i] = R; Cc[i] = C; const int Rb = (R >> 5) * 64 + ((R & 15) >> 2) * 16 + ((R >> 4) & 1) * 4 + (R & 3);
        voffB[i] = (unsigned)(Rb * KB + C * 2); voffB1[i] = (unsigned)((Rb + 8) * KB + C * 2); }
    const size_t kstep = (size_t)(BK * 2);
    const size_t hstep = (size_t)HALF * KB;
    const unsigned ldsw = (unsigned)wid * 1024u;
    const int aoff = lds_byte(wr * 64 + fr, fq * 8), boff = lds_byte(wc * 32 + fr, fq * 8);
#define PG8_SA(b, h) (((b) * 2 + (h)) * HTB)
#define PG8_SB(b, h) ((4 + (b) * 2 + (h)) * HTB)
#define PG8_STAGE(bufoff, gbase, voff) do { _Pragma("unroll") for (int _i = 0; _i < 2; ++_i) \
        __builtin_amdgcn_global_load_lds((const unsigned*)((const char*)(gbase) + (voff)[_i]), (LAS unsigned*)(lds + (bufoff) + ldsw + _i * 8192), 16, 0, 0); } while (0)
#define PG8_CAT8(lo, hi) __builtin_bit_cast(v8i32, __builtin_shufflevector((lo), (hi), 0, 1, 2, 3, 4, 5, 6, 7, 8, 9, 10, 11, 12, 13, 14, 15))
#define PG8_LDA(dst, b, h) do { if constexpr (F8) { _Pragma("unroll") for (int m = 0; m < 4; ++m) dst##8[m] = PG8_CAT8(*(const LAS bf16x8*)(lds + PG8_SA(b, h) + aoff + m * 2048), *(const LAS bf16x8*)(lds + PG8_SA(b, h) + aoff + m * 2048 + 1024)); } \
        else { _Pragma("unroll") for (int m = 0; m < 4; ++m) _Pragma("unroll") for (int k = 0; k < 2; ++k) dst[m][k] = *(const LAS bf16x8*)(lds + PG8_SA(b, h) + aoff + m * 2048 + k * 1024); } } while (0)
#define PG8_LDB(dst, b, h) do { if constexpr (F8) { _Pragma("unroll") for (int n = 0; n < 2; ++n) dst##8[n] = PG8_CAT8(*(const LAS bf16x8*)(lds + PG8_SB(b, h) + boff + n * 2048), *(const LAS bf16x8*)(lds + PG8_SB(b, h) + boff + n * 2048 + 1024)); } \
        else { _Pragma("unroll") for (int n = 0; n < 2; ++n) _Pragma("unroll") for (int k = 0; k < 2; ++k) dst[n][k] = *(const LAS bf16x8*)(lds + PG8_SB(b, h) + boff + n * 2048 + k * 1024); } } while (0)
#define PG8_MMA(ai, bj, At, Bt) do { __builtin_amdgcn_s_setprio(1); \
        if constexpr (F8) { _Pragma("unroll") for (int m = 0; m < 4; ++m) _Pragma("unroll") for (int n = 0; n < 2; ++n) \
            asm volatile("v_mfma_f32_16x16x128_f8f6f4 %0, %1, %2, %0" : "+v"(acc[ai][bj][m][n]) : "v"(Bt##8[n]), "v"(At##8[m])); } \
        else { _Pragma("unroll") for (int m = 0; m < 4; ++m) _Pragma("unroll") for (int n = 0; n < 2; ++n) _Pragma("unroll") for (int k = 0; k < 2; ++k) \
            acc[ai][bj][m][n] = __builtin_amdgcn_mfma_f32_16x16x32_bf16(Bt[n][k], At[m][k], acc[ai][bj][m][n], 0, 0, 0); } \
        __builtin_amdgcn_s_setprio(0); } while (0)
#define PG8_WAIT_V(n) asm volatile("s_waitcnt vmcnt(" #n ")" ::: "memory")
#define PG8_WAIT_L(n) asm volatile("s_waitcnt lgkmcnt(" #n ")" ::: "memory")
#define PG8_BAR __builtin_amdgcn_s_barrier()
#define PG8_SCHED __builtin_amdgcn_sched_barrier(0)
    Unit cur, nxt; int ui = 0;
    if (!S.next(0, cur)) return;
    unsigned vA[2][2], vN[2][2];
    S.aoff(cur, Rr, Cc, vA);
    f32x4 acc[2][2][4][2];
#pragma unroll
    for (int a = 0; a < 2; ++a)
#pragma unroll
        for (int b = 0; b < 2; ++b)
#pragma unroll
            for (int m = 0; m < 4; ++m)
#pragma unroll
                for (int n = 0; n < 2; ++n) acc[a][b][m][n] = (f32x4){0.f, 0.f, 0.f, 0.f};
    bf16x8 At[4][2], B0[2][2], B1[2][2];
    v8i32 At8[4], B08[2], B18[2];
    const char* cA = cur.a; const char* cB = cur.b;
    if constexpr (has_bias_lds<Epi>::value) { if (wid == 0) E.bias_dma(cur, lane); }
    if constexpr (SP2) {
        PG8_STAGE(PG8_SB(0, 0), cB, voffB); PG8_STAGE(PG8_SB(0, 1), cB, voffB1); PG8_STAGE(PG8_SA(0, 0), cA, vA[0]); PG8_STAGE(PG8_SA(0, 1), cA, vA[1]);
        if (wr == 1) PG8_BAR;
        PG8_WAIT_V(2); PG8_BAR;
        PG8_STAGE(PG8_SB(1, 0), cB + kstep, voffB); PG8_STAGE(PG8_SA(1, 0), cA + kstep, vA[0]); PG8_STAGE(PG8_SB(1, 1), cB + kstep, voffB1);
        PG8_WAIT_V(6); PG8_BAR;
    } else {
        PG8_STAGE(PG8_SB(0, 0), cB, voffB); PG8_STAGE(PG8_SA(0, 0), cA, vA[0]); PG8_STAGE(PG8_SB(0, 1), cB, voffB1); PG8_STAGE(PG8_SA(0, 1), cA, vA[1]);
        if (wr == 1) PG8_BAR;
        PG8_WAIT_V(4); PG8_BAR;
        PG8_STAGE(PG8_SB(1, 0), cB + kstep, voffB); PG8_STAGE(PG8_SA(1, 0), cA + kstep, vA[0]); PG8_STAGE(PG8_SB(1, 1), cB + kstep, voffB1);
        PG8_WAIT_V(6); PG8_BAR;
    }
    for (;;) {
        const bool has_next = S.next(ui + 1, nxt);
        const char* nA = has_next ? nxt.a : cA; const char* nB = has_next ? nxt.b : cB;
        if (GATHER && has_next) S.aoff(nxt, Rr, Cc, vN);
        else {
#pragma unroll
            for (int h = 0; h < 2; ++h)
#pragma unroll
                for (int i = 0; i < 2; ++i) vN[h][i] = vA[h][i]; }
#pragma unroll 1
        for (int t = 0; t < nt; t += 2) {
            const bool last = (t == nt - 2);
            const char* a1 = cA + (size_t)(t + 1) * kstep;
            const char* a2 = last ? nA : cA + (size_t)(t + 2) * kstep; const char* b2 = last ? nB : cB + (size_t)(t + 2) * kstep;
            const char* a3 = a2 + kstep; const char* b3 = b2 + kstep;
            unsigned v2[2][2];
#pragma unroll
            for (int h = 0; h < 2; ++h)
#pragma unroll
                for (int i = 0; i < 2; ++i) v2[h][i] = last ? vN[h][i] : vA[h][i];
            if constexpr (SP2) {
            PG8_LDB(B0, 0, 0); PG8_LDB(B1, 0, 1); PG8_SCHED; PG8_LDA(At, 0, 0); PG8_STAGE(PG8_SA(1, 1), a1, vA[1]);
            PG8_WAIT_V(8); PG8_WAIT_L(0); PG8_BAR; PG8_MMA(0, 0, At, B0); PG8_MMA(0, 1, At, B1); PG8_BAR; PG8_SCHED;
            PG8_LDA(At, 0, 1); PG8_STAGE(PG8_SB(0, 0), b2, voffB); PG8_STAGE(PG8_SB(0, 1), b2, voffB1); PG8_STAGE(PG8_SA(0, 0), a2, v2[0]);
            PG8_WAIT_V(8); PG8_WAIT_L(0); PG8_BAR; PG8_MMA(1, 0, At, B0); PG8_MMA(1, 1, At, B1); PG8_BAR; PG8_SCHED;
            PG8_LDB(B0, 1, 0); PG8_LDB(B1, 1, 1); PG8_SCHED; PG8_LDA(At, 1, 0); PG8_STAGE(PG8_SA(0, 1), a2, v2[1]);
            PG8_WAIT_V(8); PG8_WAIT_L(0); PG8_BAR; PG8_MMA(0, 0, At, B0); PG8_MMA(0, 1, At, B1); PG8_BAR; PG8_SCHED;
            PG8_LDA(At, 1, 1); PG8_STAGE(PG8_SB(1, 0), b3, voffB); PG8_STAGE(PG8_SB(1, 1), b3, voffB1); PG8_STAGE(PG8_SA(1, 0), a3, v2[0]);
            PG8_WAIT_V(8); PG8_WAIT_L(0); PG8_BAR; PG8_MMA(1, 0, At, B0); PG8_MMA(1, 1, At, B1); PG8_BAR; PG8_SCHED;
            } else {
            PG8_LDB(B0, 0, 0); PG8_SCHED; PG8_LDA(At, 0, 0); PG8_STAGE(PG8_SA(1, 1), a1, vA[1]);
            PG8_WAIT_L(8); PG8_BAR; PG8_WAIT_L(0); PG8_MMA(0, 0, At, B0); PG8_BAR; PG8_SCHED;
            PG8_LDB(B1, 0, 1); PG8_STAGE(PG8_SB(0, 0), b2, voffB);
            PG8_BAR; PG8_WAIT_L(0); PG8_MMA(0, 1, At, B1); PG8_BAR;
            PG8_LDA(At, 0, 1); PG8_STAGE(PG8_SA(0, 0), a2, v2[0]);
            PG8_BAR; PG8_WAIT_L(0); PG8_MMA(1, 0, At, B0); PG8_BAR; PG8_SCHED;
            PG8_STAGE(PG8_SB(0, 1), b2, voffB1);
            PG8_WAIT_V(6); PG8_BAR; PG8_MMA(1, 1, At, B1); PG8_BAR;
            PG8_LDB(B0, 1, 0); PG8_SCHED; PG8_LDA(At, 1, 0); PG8_STAGE(PG8_SA(0, 1), a2, v2[1]);
            PG8_WAIT_L(8); PG8_BAR; PG8_WAIT_L(0); PG8_MMA(0, 0, At, B0); PG8_BAR; PG8_SCHED;
            PG8_LDB(B1, 1, 1); PG8_STAGE(PG8_SB(1, 0), b3, voffB);
            PG8_BAR; PG8_WAIT_L(0); PG8_MMA(0, 1, At, B1); PG8_BAR;
            PG8_LDA(At, 1, 1); PG8_STAGE(PG8_SA(1, 0), a3, v2[0]);
            PG8_BAR; PG8_WAIT_L(0); PG8_MMA(1, 0, At, B0); PG8_BAR; PG8_SCHED;
            PG8_STAGE(PG8_SB(1, 1), b3, voffB1);
            PG8_WAIT_V(6); PG8_BAR; PG8_MMA(1, 1, At, B1); PG8_BAR;
            }
        }
        if constexpr (ALIGN_EPI) { if (wr == 0) PG8_BAR; }
        if constexpr (F8) asm volatile("s_nop 15\n\ts_nop 15" ::: "memory");
        { int fr_e = fr, fq_e = fq; asm volatile("" : "+v"(fr_e), "+v"(fq_e));
          E(acc, cur, wr, wc, fr_e, fq_e);
#if defined(PROBE_EPI2)
          if constexpr (has_probe2<Epi>::value) { asm volatile("" : "+v"(fr_e), "+v"(fq_e)); E(acc, cur, wr, wc, fr_e, fq_e); }
#endif
        }
        if (!has_next) break;
        if constexpr (has_bias_lds<Epi>::value) { if (wid == 0) E.bias_dma(nxt, lane); }
#pragma unroll
        for (int a = 0; a < 2; ++a)
#pragma unroll
            for (int b = 0; b < 2; ++b)
#pragma unroll
                for (int m = 0; m < 4; ++m)
#pragma unroll
                    for (int n = 0; n < 2; ++n) acc[a][b][m][n] = (f32x4){0.f, 0.f, 0.f, 0.f};
        cur = nxt; cA = nA; cB = nB; ++ui;
#pragma unroll
        for (int h = 0; h < 2; ++h)
#pragma unroll
            for (int i = 0; i < 2; ++i) vA[h][i] = vN[h][i];
        if constexpr (ALIGN_EPI) { if (wr == 1) PG8_BAR; }
    }
    PG8_WAIT_V(0);
    if constexpr (!ALIGN_EPI) { if (wr == 0) PG8_BAR; }
    PG8_BAR;
#undef PG8_SA
#undef PG8_SB
#undef PG8_STAGE
#undef PG8_LDA
#undef PG8_LDB
#undef PG8_MMA
#undef PG8_CAT8
#undef PG8_WAIT_V
#undef PG8_WAIT_L
#undef PG8_BAR
#undef PG8_SCHED
}
}
typedef f32x4 AccT[2][2][4][2];

#define EPI_LOOP(...) \
    _Pragma("unroll") for (int ai = 0; ai < 2; ++ai) _Pragma("unroll") for (int m = 0; m < 4; ++m) { const int row = u.r0 + ai * 128 + wr * 64 + m * 16 + fr; u32x4 ow[2]; \
    _Pragma("unroll") for (int bj = 0; bj < 2; ++bj) { const int col = u.c0 + wc * 64 + 16 * fq + 8 * bj; const f32x4 v0 = acc[ai][bj][m][0], v1 = acc[ai][bj][m][1]; __VA_ARGS__ } \
    EPI_STORE(u.r0 + ai * 128 + wr * 64 + m * 16, u.c0 + wc * 64 + 16 * fq, ow); }
#ifndef EPI_PIPE_A
#define EPI_PIPE_A 1
#endif
#ifndef EPI_PIPE_C1
#define EPI_PIPE_C1 1
#endif
#ifndef EPI_PIPE_C2
#define EPI_PIPE_C2 1
#endif
#ifndef EPI_PIPE_D
#define EPI_PIPE_D 1
#endif
#define EPI_LD_BATCH_(LD) _Pragma("unroll") for (int mm = 0; mm < 2; ++mm) { const int row = u.r0 + ai * 128 + wr * 64 + (2 * mp + mm) * 16 + fr; \
    _Pragma("unroll") for (int bj = 0; bj < 2; ++bj) { const int col = u.c0 + wc * 64 + 16 * fq + 8 * bj; LD } }
#define EPI_LOOP_LD(NLD, LD, ...) { u32x4 ldq[2][2][2][NLD]; \
    { constexpr int ai = 0, mp = 0; auto& ld = ldq[0]; EPI_LD_BATCH_(LD) } \
    _Pragma("unroll") for (int q = 0; q < 4; ++q) { \
    if (EPI_PIPE && q < 3) { const int ai = (q + 1) >> 1, mp = (q + 1) & 1; auto& ld = ldq[(q + 1) & 1]; EPI_LD_BATCH_(LD) } \
    { const int ai = q >> 1, mp = q & 1; auto& ld = ldq[EPI_PIPE ? (q & 1) : 0]; if (!EPI_PIPE && q > 0) { EPI_LD_BATCH_(LD) } \
    _Pragma("unroll") for (int mm = 0; mm < 2; ++mm) { const int m = 2 * mp + mm; const int row = u.r0 + ai * 128 + wr * 64 + m * 16 + fr; u32x4 ow[2]; \
    _Pragma("unroll") for (int bj = 0; bj < 2; ++bj) { const int col = u.c0 + wc * 64 + 16 * fq + 8 * bj; const f32x4 v0 = acc[ai][bj][m][0] * EPI_SCALE, v1 = acc[ai][bj][m][1] * EPI_SCALE; __VA_ARGS__ } \
    EPI_STORE(u.r0 + ai * 128 + wr * 64 + m * 16, u.c0 + wc * 64 + 16 * fq, ow); } } } }
__device__ __forceinline__ void store_pair16(bf16* base, int ld, int R0, int fr, int col16, const u32x4 (&ow)[2]) {
    const bool lo = fr < 8; u32x4 recv;
#pragma unroll
    for (int j = 0; j < 4; ++j) { const unsigned snd = lo ? ow[1][j] : ow[0][j]; recv[j] = (unsigned)__builtin_amdgcn_update_dpp(0, (int)snd, 0x128, 0xF, 0xF, true); }
    u32x4 d1, d2;
#pragma unroll
    for (int j = 0; j < 4; ++j) { d1[j] = lo ? ow[0][j] : recv[j]; d2[j] = lo ? recv[j] : ow[1][j]; }
    bf16* p = base + (size_t)(R0 + (fr & 7)) * ld + col16 + (lo ? 0 : 8);
    *(u32x4*)p = d1; *(u32x4*)(p + (size_t)8 * ld) = d2;
}
__device__ __forceinline__ u32x4 pack8(const f32x4 a, const f32x4 b) { u32x4 w; w.x = cvt_pk_bf16(a[0], a[1]); w.y = cvt_pk_bf16(a[2], a[3]); w.z = cvt_pk_bf16(b[0], b[1]); w.w = cvt_pk_bf16(b[2], b[3]); return w; }
__device__ __forceinline__ void unpack8(const u32x4 w, f32x4& a, f32x4& b) { a = (f32x4){bf_lo(w.x), bf_hi(w.x), bf_lo(w.y), bf_hi(w.y)}; b = (f32x4){bf_lo(w.z), bf_hi(w.z), bf_lo(w.w), bf_hi(w.w)}; }

#define EPI_STORE(R0_, C16_, OW_) do { if (ST_G8) *(u32x4*)(ST_G8 + (size_t)((R0_) + fr) * (2 * DM) + ((C16_) - C_GA)) = (u32x4){OW_[0].x, OW_[0].y, OW_[1].x, OW_[1].y}; else store_pair16(ST_BASE, ST_LD, R0_, fr, C16_, OW_); } while (0)
struct EpiInProj {
#if defined(PROBE_EPI2) && PROBE_EPI2 == 1
    static constexpr bool PROBE2 = true;
#endif
    bf16* P; const bf16* rcs; unsigned char* PG8;
    __device__ __forceinline__ void operator()(const AccT& acc, const pg8::Unit& u, int wr, int wc, int fr, int fq) const {
        const int c0 = __builtin_amdgcn_readfirstlane(u.c0);
        const int mode = c0 < C_K ? 0 : c0 < C_V ? 1 : c0 < C_G ? 2 : c0 < C_U ? 3 : c0 < C_GA ? 4 : 5;
        switch (mode) { case 0: run<0>(acc, u, wr, wc, fr, fq); break; case 1: run<1>(acc, u, wr, wc, fr, fq); break; case 2: run<2>(acc, u, wr, wc, fr, fq); break;
                        case 3: run<3>(acc, u, wr, wc, fr, fq); break; case 4: run<4>(acc, u, wr, wc, fr, fq); break; default: run<5>(acc, u, wr, wc, fr, fq); break; }
    }
    template <int mode> __device__ __forceinline__ void run(const AccT& acc, const pg8::Unit& u, int wr, int wc, int fr, int fq) const {
        bf16* const ST_BASE = P; constexpr int ST_LD = INW; constexpr float EPI_SCALE = INPROJ_FP8 ? 1.0f / 256.0f : 1.0f; constexpr bool EPI_PIPE = EPI_PIPE_A != 0;
        unsigned char* const ST_G8 = (GATE_U8 && mode == 5) ? PG8 : nullptr;
        EPI_LOOP_LD(1, if (mode <= 1) { const int pos = row & (SEQ - 1); const int jg = (col & 127) >> 3; ld[mm][bj][0] = *(const u32x4*)(rcs + (pos * 16 + jg) * 8); } ,
            f32x4 o0, o1;
            if (mode <= 1) {
                const int pos = row & (SEQ - 1), h = (col & 511) >> 7;
                f32x4 cs, sn; unpack8(ld[mm][bj][0], cs, sn);
                const float lg = lg2_gamma(h) * (float)(pos & 63);
                const float sc = mode == 0 ? __builtin_amdgcn_exp2f(lg) : __builtin_amdgcn_exp2f(-lg) * 0.08838834764831845f;
                o0 = (v0 * cs - v1 * sn) * sc; o1 = (v0 * sn + v1 * cs) * sc;
            } else if (mode == 2) { o0 = v0; o1 = v1; }
            else if (mode == 3) { _Pragma("unroll") for (int j = 0; j < 4; ++j) { o0[j] = siluf_(v0[j]); o1[j] = siluf_(v1[j]); } }
            else if (mode == 4) { _Pragma("unroll") for (int j = 0; j < 4; ++j) { o0[j] = geluf_(v0[j]); o1[j] = geluf_(v1[j]); } }
            else { _Pragma("unroll") for (int j = 0; j < 4; ++j) { o0[j] = sigmoidf_(v0[j]); o1[j] = sigmoidf_(v1[j]); } }
            if (GATE_U8 && mode == 5) { ow[bj].x = pack4_u8(o0); ow[bj].y = pack4_u8(o1); } else
            ow[bj] = pack8(o0, o1);
        )
    }
};
struct EpiGate1 {
    const bf16* P; bf16* H1; const unsigned char* PG8;
    __device__ __forceinline__ void operator()(const AccT& acc, const pg8::Unit& u, int wr, int wc, int fr, int fq) const {
        bf16* const ST_BASE = H1; constexpr int ST_LD = DM; constexpr float EPI_SCALE = 1.0f; unsigned char* const ST_G8 = nullptr; constexpr bool EPI_PIPE = EPI_PIPE_C1 != 0;
        EPI_LOOP_LD(1, if (GATE_U8) { const u32x2 q8 = *(const u32x2*)(PG8 + (size_t)row * (2 * DM) + col); ld[mm][bj][0].x = q8.x; ld[mm][bj][0].y = q8.y; } else ld[mm][bj][0] = *(const u32x4*)(P + (size_t)row * INW + C_GA + col); ,
            f32x4 g0, g1; if (GATE_U8) unpack8_u8((u32x2){ld[mm][bj][0].x, ld[mm][bj][0].y}, g0, g1); else unpack8(ld[mm][bj][0], g0, g1);
            ow[bj] = pack8(v0 * g0, v1 * g1);
        )
    }
};
struct EpiGate2 {
    const bf16* P; const bf16* H1; bf16* Hb; const unsigned char* PG8;
    __device__ __forceinline__ void operator()(const AccT& acc, const pg8::Unit& u, int wr, int wc, int fr, int fq) const {
        bf16* const ST_BASE = Hb; constexpr int ST_LD = DM; constexpr float EPI_SCALE = 1.0f; unsigned char* const ST_G8 = nullptr; constexpr bool EPI_PIPE = EPI_PIPE_C2 != 0;
        EPI_LOOP_LD(2, if (GATE_U8) { const u32x2 q8 = *(const u32x2*)(PG8 + (size_t)row * (2 * DM) + DM + col); ld[mm][bj][0].x = q8.x; ld[mm][bj][0].y = q8.y; } else ld[mm][bj][0] = *(const u32x4*)(P + (size_t)row * INW + C_GB + col); ld[mm][bj][1] = *(const u32x4*)(H1 + (size_t)row * DM + col); ,
            f32x4 g0, g1, h0, h1; if (GATE_U8) unpack8_u8((u32x2){ld[mm][bj][0].x, ld[mm][bj][0].y}, g0, g1); else unpack8(ld[mm][bj][0], g0, g1); unpack8(ld[mm][bj][1], h0, h1);
            ow[bj] = pack8(h0 + v0 * g0, h1 + v1 * g1);
        )
    }
};
struct EpiResid {
    const float* Xf; const bf16* Xb; bf16* Z;
    __device__ __forceinline__ void operator()(const AccT& acc, const pg8::Unit& u, int wr, int wc, int fr, int fq) const {
        bf16* const ST_BASE = Z; constexpr int ST_LD = DM; constexpr float EPI_SCALE = 1.0f; unsigned char* const ST_G8 = nullptr; constexpr bool EPI_PIPE = EPI_PIPE_D != 0;
        EPI_LOOP_LD(2, if (Xf) { ld[mm][bj][0] = *(const u32x4*)(Xf + (size_t)row * DM + col); ld[mm][bj][1] = *(const u32x4*)(Xf + (size_t)row * DM + col + 4); } else ld[mm][bj][0] = *(const u32x4*)(Xb + (size_t)row * DM + col); ,
            f32x4 x0, x1;
            if (Xf) { x0 = __builtin_bit_cast(f32x4, ld[mm][bj][0]); x1 = __builtin_bit_cast(f32x4, ld[mm][bj][1]); }
            else unpack8(ld[mm][bj][0], x0, x1);
            ow[bj] = pack8(x0 * DN_ALPHA + v0, x1 * DN_ALPHA + v1);
        )
    }
};
struct EpiSwiglu {
#if defined(PROBE_EPI2) && PROBE_EPI2 == 3
    static constexpr bool PROBE2 = true;
#endif
    bf16* Act; const float* b1; LAS unsigned char* L;
    static constexpr bool BIAS_LDS = MOE_BIAS_LDS != 0;
    __device__ __forceinline__ void bias_dma(const pg8::Unit& u, int lane) const {
        const float* src = b1 + (size_t)u.e * 2 * DEXP + (u.c0 >> 1) + (lane < 32 ? lane * 4 : DEXP + (lane - 32) * 4);
        __builtin_amdgcn_global_load_lds((const unsigned*)src, (LAS unsigned*)(L + BIAS_OFF + (u.slot & 1) * 1024), 16, 0, 0); }
    __device__ __forceinline__ void operator()(const AccT& acc, const pg8::Unit& u, int wr, int wc, int fr, int fq) const {
        const int j0 = (u.c0 >> 1) + wc * 32 + 8 * fq;
        const float* be = b1 + (size_t)u.e * 2 * DEXP + j0;
        f32x4 bg0, bg1, bu0, bu1;
        if (BIAS_LDS) { const LAS float* bl = (const LAS float*)(L + BIAS_OFF + (u.slot & 1) * 1024) + wc * 32 + 8 * fq;
            bg0 = *(const LAS f32x4*)bl; bg1 = *(const LAS f32x4*)(bl + 4); bu0 = *(const LAS f32x4*)(bl + 128); bu1 = *(const LAS f32x4*)(bl + 132); }
        else { bg0 = *(const f32x4*)be; bg1 = *(const f32x4*)(be + 4); bu0 = *(const f32x4*)(be + DEXP); bu1 = *(const f32x4*)(be + DEXP + 4); }
        constexpr float sc = MOE_FP8 ? 1.0f / 256.0f : 1.0f;
#pragma unroll
        for (int ai = 0; ai < 2; ++ai)
#pragma unroll
            for (int m = 0; m < 4; ++m) { const int row = u.r0 + ai * 128 + wr * 64 + m * 16 + fr;
                const f32x4 hg0 = acc[ai][0][m][0] * sc + bg0, hg1 = acc[ai][0][m][1] * sc + bg1, hu0 = acc[ai][1][m][0] * sc + bu0, hu1 = acc[ai][1][m][1] * sc + bu1; float a[8];
#pragma unroll
                for (int j = 0; j < 4; ++j) { const float g0 = fminf(hg0[j], 7.0f), u0 = fminf(fmaxf(hu0[j], -7.0f), 7.0f), g1 = fminf(hg1[j], 7.0f), u1 = fminf(fmaxf(hu1[j], -7.0f), 7.0f);
                    a[j] = g0 * sigmoidf_(1.702f * g0) * (u0 + 1.0f); a[4 + j] = g1 * sigmoidf_(1.702f * g1) * (u1 + 1.0f); }
                if (MOE_FP8) { u32x2 w; w.x = cvt4_fp8(a[0] * 4.0f, a[1] * 4.0f, a[2] * 4.0f, a[3] * 4.0f); w.y = cvt4_fp8(a[4] * 4.0f, a[5] * 4.0f, a[6] * 4.0f, a[7] * 4.0f); *(u32x2*)((unsigned char*)Act + (size_t)row * DEXP + j0) = w; }
                else { u32x4 w; w.x = cvt_pk_bf16(a[0], a[1]); w.y = cvt_pk_bf16(a[2], a[3]); w.z = cvt_pk_bf16(a[4], a[5]); w.w = cvt_pk_bf16(a[6], a[7]); *(u32x4*)(Act + (size_t)row * DEXP + j0) = w; } }
    }
};
struct EpiBias {
    bf16* Y; const float* b2; LAS unsigned char* L;
    static constexpr bool BIAS_LDS = MOE_BIAS_LDS != 0;
    __device__ __forceinline__ void bias_dma(const pg8::Unit& u, int lane) const {
        __builtin_amdgcn_global_load_lds((const unsigned*)(b2 + (size_t)u.e * DM + u.c0 + lane * 4), (LAS unsigned*)(L + BIAS_OFF + (u.slot & 1) * 1024), 16, 0, 0); }
    __device__ __forceinline__ void operator()(const AccT& acc, const pg8::Unit& u, int wr, int wc, int fr, int fq) const {
        const float* be = b2 + (size_t)u.e * DM; f32x4 b0a[2], b1a[2];
#pragma unroll
        for (int bj = 0; bj < 2; ++bj) { const int cc = u.c0 + wc * 64 + 16 * fq + 8 * bj;
            if (BIAS_LDS) { const LAS float* bl = (const LAS float*)(L + BIAS_OFF + (u.slot & 1) * 1024) + wc * 64 + 16 * fq + 8 * bj; b0a[bj] = *(const LAS f32x4*)bl; b1a[bj] = *(const LAS f32x4*)(bl + 4); }
            else { b0a[bj] = *(const f32x4*)(be + cc); b1a[bj] = *(const f32x4*)(be + cc + 4); } }
        bf16* const ST_BASE = Y; constexpr int ST_LD = DM; unsigned char* const ST_G8 = nullptr;
        if (MOE_FP8) {
#pragma unroll
            for (int ai = 0; ai < 2; ++ai)
#pragma unroll
                for (int m = 0; m < 4; ++m) { const int row = u.r0 + ai * 128 + wr * 64 + m * 16 + fr; u32x4 w;
#pragma unroll
                    for (int bj = 0; bj < 2; ++bj) { const f32x4 y0 = (acc[ai][bj][m][0] * (1.0f / 512.0f) + b0a[bj]) * 16.0f, y1 = (acc[ai][bj][m][1] * (1.0f / 512.0f) + b1a[bj]) * 16.0f;
                        w[2 * bj] = cvt4_fp8(y0[0], y0[1], y0[2], y0[3]); w[2 * bj + 1] = cvt4_fp8(y1[0], y1[1], y1[2], y1[3]); }
                    *(u32x4*)((unsigned char*)Y + (size_t)row * DM + u.c0 + wc * 64 + 16 * fq) = w; }
        } else {
        EPI_LOOP(
            const f32x4 b0v = b0a[bj], b1v = b1a[bj];
            ow[bj] = pack8(v0 + b0v, v1 + b1v);
        )
        }
    }
};

struct Frame {
    LAS unsigned char* lds; volatile LAS unsigned* MISC; unsigned* ctl;
    int tid, lane, wave, G, bid;
    unsigned char* ws;
};
#define WSP(T_, off) ((T_*)(F.ws + (off)))
__device__ __forceinline__ void frame_refresh(Frame& F) { F.tid = opaque_tid(); F.lane = F.tid & 63; F.wave = __builtin_amdgcn_readfirstlane(F.tid >> 6);
    int b_ = blockIdx.x, g_ = gridDim.x; asm volatile("" : "+s"(b_), "+s"(g_)); F.bid = b_; F.G = g_; }

template <class FN>
__device__ __forceinline__ void transpose_item(const float* __restrict__ W, int N, bf16* __restrict__ WT, int K, int k0, int n0, FN srccol, LAS float* scr, int lane) {
    const int dq = lane & 15, ks = lane >> 4; const int sc = srccol(n0 + 4 * dq);
    f32x4 v[16];
#pragma unroll
    for (int it = 0; it < 16; ++it) v[it] = *(const f32x4*)(W + (size_t)(k0 + 4 * it + ks) * N + sc);
#pragma unroll
    for (int it = 0; it < 16; ++it) { LAS float* d = scr + (4 * it + ks) * 65 + 4 * dq; d[0] = v[it][0]; d[1] = v[it][1]; d[2] = v[it][2]; d[3] = v[it][3]; }
    LDS_WAIT();
    const int c = lane >> 3, ns = lane & 7;
#pragma unroll
    for (int j = 0; j < 8; ++j) { const int n = 8 * j + ns; const LAS float* s = scr + (8 * c) * 65 + n;
        u32x4 o; o.x = cvt_pk_bf16(s[0], s[65]); o.y = cvt_pk_bf16(s[2 * 65], s[3 * 65]); o.z = cvt_pk_bf16(s[4 * 65], s[5 * 65]); o.w = cvt_pk_bf16(s[6 * 65], s[7 * 65]);
        *(u32x4*)(WT + (size_t)(n0 + n) * K + k0 + 8 * c) = o; }
    LDS_WAIT();
}
template <class FN>
__device__ __forceinline__ void transpose_item_f8(const float* __restrict__ W, int N, unsigned char* __restrict__ WT, int K, int k0, int n0, FN srccol, float scale, LAS float* scr, int lane) {
    const int dq = lane & 7, ks = lane >> 3; const int sc = srccol(n0 + 4 * dq);
    f32x4 v[16];
#pragma unroll
    for (int it = 0; it < 16; ++it) v[it] = *(const f32x4*)(W + (size_t)(k0 + 8 * it + ks) * N + sc);
#pragma unroll
    for (int it = 0; it < 16; ++it) { LAS float* d = scr + (8 * it + ks) * 33 + 4 * dq; d[0] = v[it][0] * scale; d[1] = v[it][1] * scale; d[2] = v[it][2] * scale; d[3] = v[it][3] * scale; }
    LDS_WAIT();
    const int c = lane & 7, ns = lane >> 3;
#pragma unroll
    for (int j = 0; j < 4; ++j) { const int n = 8 * j + ns; const LAS float* s = scr + (16 * c) * 33 + n;
        u32x4 o; o.x = cvt4_fp8(s[0], s[33], s[2 * 33], s[3 * 33]); o.y = cvt4_fp8(s[4 * 33], s[5 * 33], s[6 * 33], s[7 * 33]);
        o.z = cvt4_fp8(s[8 * 33], s[9 * 33], s[10 * 33], s[11 * 33]); o.w = cvt4_fp8(s[12 * 33], s[13 * 33], s[14 * 33], s[15 * 33]);
        *(u32x4*)(WT + (size_t)(n0 + n) * K + k0 + 16 * c) = o; }
    LDS_WAIT();
}
struct ColId { __device__ int operator()(int n) const { return n; } };
struct ColQK { __device__ int operator()(int n) const { if (n >= C_V) return n; const int cl = n & 127, g8 = cl >> 3, i = cl & 7; return (n & ~127) + (i < 4 ? 4 * g8 + i : 64 + 4 * g8 + (i - 4)); } };
struct ColGU { __device__ int operator()(int n) const { const int pn = n >> 8, wi = n & 255, hid = pn * 128 + (wi >> 4) * 8 + (wi & 7); return (wi & 8) ? DEXP + hid : hid; } };

struct F8Item { const float* src; unsigned char* dst; int N, K; float scale; };
__device__ __forceinline__ void f8item_load(const F8Item& d, f32x4 (&v)[16]) {
#pragma unroll
    for (int it = 0; it < 16; ++it) v[it] = *(const f32x4*)(d.src + (size_t)(8 * it) * d.N);
}
__device__ __forceinline__ void f8item_finish(const F8Item& d, const f32x4 (&v)[16], LAS float* scr, int lane) {
    const int dq = lane & 7, ks = lane >> 3;
#pragma unroll
    for (int it = 0; it < 16; ++it) { LAS float* p = scr + (8 * it + ks) * 33 + 4 * dq; p[0] = v[it][0] * d.scale; p[1] = v[it][1] * d.scale; p[2] = v[it][2] * d.scale; p[3] = v[it][3] * d.scale; }
    LDS_WAIT();
    const int c = lane & 7, ns = lane >> 3;
#pragma unroll
    for (int j = 0; j < 4; ++j) { const int n = 8 * j + ns; const LAS float* s = scr + (16 * c) * 33 + n;
        u32x4 o; o.x = cvt4_fp8(s[0], s[33], s[2 * 33], s[3 * 33]); o.y = cvt4_fp8(s[4 * 33], s[5 * 33], s[6 * 33], s[7 * 33]);
        o.z = cvt4_fp8(s[8 * 33], s[9 * 33], s[10 * 33], s[11 * 33]); o.w = cvt4_fp8(s[12 * 33], s[13 * 33], s[14 * 33], s[15 * 33]);
        *(u32x4*)(d.dst + (size_t)(8 * j) * d.K) = o; }
    LDS_WAIT();
}
__device__ __forceinline__ void p0_prologue(Frame& F, const float* x, const float* w_in, const float* p_ret, const float* p_sg, const float* w_o, const float* sg_w, const float* e_w1, const float* e_w2) {
    LAS float* scr = (LAS float*)(F.lds + F.wave * 16896);
    const int gw = F.bid * NWAVES + F.wave, NGW = F.G * NWAVES;
    constexpr int I_IN = (DM / 64) * (INW / 64), I_SQ = (DM / 64) * (DM / 64), I_W1 = NE * (DM / 64) * (2 * DEXP / 64), I_W2 = NE * (DEXP / 64) * (DM / 64);
    constexpr int I_LAYER = I_IN + 3 * I_SQ + I_W1 + I_W2;
    if (MOE_FP8) {
        constexpr int I_SMALL = I_IN + 3 * I_SQ;
        for (int it = gw; it < NL * I_SMALL; it += NGW) {
            const int l = it / I_SMALL; int r = it - l * I_SMALL;
            if (r < I_IN) { const int nb = INW / 64, kb = r / nb, nn = r - kb * nb;
                if (INPROJ_FP8) { const int nb8 = INW / 32, kb8 = r / nb8, nn8 = r - kb8 * nb8; transpose_item_f8(w_in + (size_t)l * DM * INW, INW, WSP(unsigned char, WS_WIN) + (size_t)l * INW * DM, DM, 128 * kb8, 32 * nn8, ColQK(), 64.0f, scr, F.lane); }
                else transpose_item(w_in + (size_t)l * DM * INW, INW, WSP(bf16, WS_WIN) + (size_t)l * INW * DM, DM, 64 * kb, 64 * nn, ColQK(), scr, F.lane);
                continue; } r -= I_IN;
            { const int which = r / I_SQ; r -= which * I_SQ; const int kb = r / 16, nn = r & 15;
              const float* src = (which == 0 ? p_ret : which == 1 ? p_sg : w_o) + (size_t)l * DM * DM;
              bf16* dst = WSP(bf16, which == 0 ? WS_PRET : which == 1 ? WS_PSG : WS_WO) + (size_t)l * DM * DM;
              transpose_item(src, DM, dst, DM, 64 * kb, 64 * nn, ColId(), scr, F.lane); } }
        constexpr int I_MOE = I_W1 + I_W2, N_MOE = NL * I_MOE;
        const int dq = F.lane & 7, ks = F.lane >> 3, c8 = F.lane & 7, ns = F.lane >> 3;
        auto decode = [&](int it, F8Item& d) {
            const int l = it / I_MOE; int r = it - l * I_MOE;
            if (r < I_W1) { const int e = r / 512; r -= e * 512; const int k0 = 128 * (r >> 6), n0 = 32 * (r & 63);
                d.N = 2 * DEXP; d.K = DM; d.scale = 64.0f;
                d.src = e_w1 + ((size_t)l * NE + e) * DM * 2 * DEXP + (size_t)(k0 + ks) * d.N + ColGU()(n0 + 4 * dq);
                d.dst = WSP(unsigned char, WS_W1) + ((size_t)l * NE + e) * 2 * DEXP * DM + (size_t)(n0 + ns) * d.K + k0 + 16 * c8; }
            else { r -= I_W1; const int e = r / 256; r -= e * 256; const int k0 = 128 * (r >> 5), n0 = 32 * (r & 31);
                d.N = DM; d.K = DEXP; d.scale = 128.0f;
                d.src = e_w2 + ((size_t)l * NE + e) * DEXP * DM + (size_t)(k0 + ks) * d.N + ColId()(n0 + 4 * dq);
                d.dst = WSP(unsigned char, WS_W2) + ((size_t)l * NE + e) * DM * DEXP + (size_t)(n0 + ns) * d.K + k0 + 16 * c8; } };
        f32x4 va[16], vb[16]; F8Item da, db;
        int it = gw;
        if (it < N_MOE) { decode(it, da); f8item_load(da, va); }
        while (it < N_MOE) {
            const int i1 = it + NGW, i2 = it + 2 * NGW;
            if (i1 < N_MOE) { decode(i1, db); f8item_load(db, vb); }
            f8item_finish(da, va, scr, F.lane);
            if (i1 >= N_MOE) break;
            if (i2 < N_MOE) { decode(i2, da); f8item_load(da, va); }
            f8item_finish(db, vb, scr, F.lane);
            it = i2;
        }
    } else {
    for (int it = gw; it < NL * I_LAYER; it += NGW) {
        const int l = it / I_LAYER; int r = it - l * I_LAYER;
        if (r < I_IN) { const int nb = INW / 64, kb = r / nb, nn = r - kb * nb;
            if (INPROJ_FP8) { const int nb8 = INW / 32, kb8 = r / nb8, nn8 = r - kb8 * nb8; transpose_item_f8(w_in + (size_t)l * DM * INW, INW, WSP(unsigned char, WS_WIN) + (size_t)l * INW * DM, DM, 128 * kb8, 32 * nn8, ColQK(), 64.0f, scr, F.lane); }
            else transpose_item(w_in + (size_t)l * DM * INW, INW, WSP(bf16, WS_WIN) + (size_t)l * INW * DM, DM, 64 * kb, 64 * nn, ColQK(), scr, F.lane);
            continue; } r -= I_IN;
        if (r < 3 * I_SQ) { const int which = r / I_SQ; r -= which * I_SQ; const int kb = r / 16, nn = r & 15;
            const float* src = (which == 0 ? p_ret : which == 1 ? p_sg : w_o) + (size_t)l * DM * DM;
            bf16* dst = WSP(bf16, which == 0 ? WS_PRET : which == 1 ? WS_PSG : WS_WO) + (size_t)l * DM * DM;
            transpose_item(src, DM, dst, DM, 64 * kb, 64 * nn, ColId(), scr, F.lane); continue; } r -= 3 * I_SQ;
        if (r < I_W1) { const int e = r / 512; r -= e * 512; const int kb = r / 32, nn = r & 31;
            if (MOE_FP8) transpose_item_f8(e_w1 + ((size_t)l * NE + e) * DM * 2 * DEXP, 2 * DEXP, WSP(unsigned char, WS_W1) + ((size_t)l * NE + e) * 2 * DEXP * DM, DM, 128 * (r >> 6), 32 * (r & 63), ColGU(), 64.0f, scr, F.lane);
            else transpose_item(e_w1 + ((size_t)l * NE + e) * DM * 2 * DEXP, 2 * DEXP, WSP(bf16, WS_W1) + ((size_t)l * NE + e) * 2 * DEXP * DM, DM, 64 * kb, 64 * nn, ColGU(), scr, F.lane);
            continue; } r -= I_W1;
        { const int e = r / 256; r -= e * 256; const int kb = r / 16, nn = r & 15;
            if (MOE_FP8) transpose_item_f8(e_w2 + ((size_t)l * NE + e) * DEXP * DM, DM, WSP(unsigned char, WS_W2) + ((size_t)l * NE + e) * DM * DEXP, DEXP, 128 * (r >> 5), 32 * (r & 31), ColId(), 128.0f, scr, F.lane);
            else transpose_item(e_w2 + ((size_t)l * NE + e) * DEXP * DM, DM, WSP(bf16, WS_W2) + ((size_t)l * NE + e) * DM * DEXP, DEXP, 64 * kb, 64 * nn, ColId(), scr, F.lane); }
    }
    }
    const size_t gt = (size_t)F.bid * NTHREADS + F.tid, NT = (size_t)F.G * NTHREADS;
    { const f32x4* s = (const f32x4*)sg_w; u32x2* d = WSP(u32x2, WS_SGW);
      for (size_t i = gt; i < (size_t)NL * 8 * 128 * 128 / 4; i += NT) { const f32x4 v = s[i]; u32x2 w; w.x = cvt_pk_bf16(v[0], v[1]); w.y = cvt_pk_bf16(v[2], v[3]); d[i] = w; } }
    { const f32x4* s = (const f32x4*)x; u32x2* d = WSP(u32x2, WS_XB);
      unsigned* dq = WSP(unsigned, WS_XQ);
      for (size_t i0 = gt; i0 < (size_t)T * DM / 4; i0 += 8 * NT) { f32x4 v[8];
#pragma unroll
          for (int k = 0; k < 8; ++k) { const size_t i = i0 + (size_t)k * NT; v[k] = i < (size_t)T * DM / 4 ? s[i] : (f32x4){0.f, 0.f, 0.f, 0.f}; }
#pragma unroll
          for (int k = 0; k < 8; ++k) { const size_t i = i0 + (size_t)k * NT; if (i < (size_t)T * DM / 4) {
              if (INPROJ_FP8) dq[i] = cvt4_fp8(v[k][0] * 4.0f, v[k][1] * 4.0f, v[k][2] * 4.0f, v[k][3] * 4.0f); else { u32x2 w; w.x = cvt_pk_bf16(v[k][0], v[k][1]); w.y = cvt_pk_bf16(v[k][2], v[k][3]); d[i] = w; } } } } }
    { float* rc = WSP(float, WS_ROPE); float* rs = rc + SEQ * 64;
      for (size_t i = gt; i < (size_t)SEQ * 64; i += NT) { const int pos = (int)(i >> 6), j = (int)(i & 63);
          const double inv = exp2(-(double)j * (13.287712379549449 / 64.0)), ang = (double)pos * inv;
          const double qd = rint(ang * 0.6366197723675814); const int qi = (int)qd;
          const double r = (ang - qd * 1.5707963267341256) - qd * 6.077100506506192e-11, r2 = r * r;
          const double sn = r * (1.0 + r2 * (-1.0 / 6 + r2 * (1.0 / 120 + r2 * (-1.0 / 5040 + r2 * (1.0 / 362880 + r2 * (-1.0 / 39916800 + r2 * (1.0 / 6227020800.0)))))));
          const double cs = 1.0 + r2 * (-0.5 + r2 * (1.0 / 24 + r2 * (-1.0 / 720 + r2 * (1.0 / 40320 + r2 * (-1.0 / 3628800 + r2 * (1.0 / 479001600.0 + r2 * (-1.0 / 87178291200.0)))))));
          const int qm = qi & 3; const double c = qm == 0 ? cs : qm == 1 ? -sn : qm == 2 ? -cs : sn, sv = qm == 0 ? sn : qm == 1 ? cs : qm == 2 ? -sn : -cs;
          rc[i] = (float)c; rs[i] = (float)sv;
          unsigned short* rcs = WSP(unsigned short, WS_ROPEB); const size_t o = ((size_t)pos * 16 + (j >> 2)) * 8 + (j & 3);
          rcs[o] = (unsigned short)(cvt_pk_bf16((float)c, 0.0f) & 0xffffu); rcs[o + 4] = (unsigned short)(cvt_pk_bf16((float)sv, 0.0f) & 0xffffu); } }
}

typedef short v4i16_t __attribute__((ext_vector_type(4)));
__device__ __forceinline__ s16x4 tr_read(const LAS unsigned char* p) { return __builtin_bit_cast(s16x4, __builtin_amdgcn_ds_read_tr16_b64_v4i16((LAS v4i16_t*)p)); }
__device__ __forceinline__ bf16x8 cat8(s16x4 a, s16x4 b) { return __builtin_shufflevector(a, b, 0, 1, 2, 3, 4, 5, 6, 7); }
constexpr int RQ_STRIDE = 272, RV_STRIDE = 544;
constexpr int RO_STRIDE = 528;
constexpr int R_Q = 0, R_K = 64 * RQ_STRIDE, R_V = 2 * 64 * RQ_STRIDE, R_SF = R_V + 64 * RV_STRIDE, R_ST = R_SF + 8192, R_OT = R_ST + 4096, R_END = R_OT + 64 * RO_STRIDE;
static_assert(R_END <= RING_BYTES, "retention LDS");

constexpr int RSEG = 4, RCPS = SEQ / 64 / RSEG;
__device__ __forceinline__ float* sloc_ptr(Frame& F, int bh, int seg, int w) { return WSP(float, WS_X1F) + ((size_t)((bh * 3 + seg) * 8 + w)) * 4096; }
__device__ __forceinline__ void ret_unit(Frame& F, int b, int h, int seg) {
    LAS unsigned char* L = F.lds;
    __syncthreads();
    const int tid = F.tid, lane = F.lane, w = F.wave, l15 = lane & 15, rq = lane >> 4, tq = l15 >> 2, tp = lane & 3, es = 32 * w;
    const bf16* P = WSP(bf16, WS_P); bf16* Y = WSP(bf16, WS_YRET);
    const float gam = __builtin_amdgcn_exp2f(lg2_gamma(h)), g63 = __builtin_amdgcn_exp2f(63.0f * lg2_gamma(h));
    const unsigned qoff = (unsigned)((tid >> 4) * INW + h * 128 + (tid & 15) * 8) * 2u, voffv = (unsigned)((tid >> 5) * INW + C_V + h * 256 + (tid & 31) * 8) * 2u;
    const unsigned qlds = (unsigned)((tid >> 4) * RQ_STRIDE + (tid & 15) * 16), vlds = (unsigned)((tid >> 5) * RV_STRIDE + (tid & 31) * 16);
    const unsigned goff = (unsigned)((tid >> 5) * INW + C_G + h * 256 + (tid & 31) * 8) * 2u, yoff = (unsigned)((tid >> 5) * DM + h * 256 + (tid & 31) * 8) * 2u, olds = (unsigned)((tid >> 5) * RO_STRIDE + (tid & 31) * 16);
    u32x4 pq[2], pk[2], pv[4];
    const size_t tb = (size_t)b * SEQ;
    const char* Pc = (const char*)P; char* Yc = (char*)Y;
#define RET_LOAD(c) do { const char* ub_ = Pc + (tb + (size_t)(c) * 64) * INW * 2; \
        _Pragma("unroll") for (int i = 0; i < 2; ++i) { const char* rp = ub_ + (size_t)(32 * i) * INW * 2 + qoff; pq[i] = __builtin_nontemporal_load((const u32x4*)(rp + C_Q * 2)); pk[i] = __builtin_nontemporal_load((const u32x4*)(rp + C_K * 2)); } \
        _Pragma("unroll") for (int i = 0; i < 4; ++i) pv[i] = __builtin_nontemporal_load((const u32x4*)(ub_ + (size_t)(16 * i) * INW * 2 + voffv)); } while (0)
#define RET_STORE() do { \
        _Pragma("unroll") for (int i = 0; i < 2; ++i) { *(LAS u32x4*)(L + R_Q + qlds + i * 32 * RQ_STRIDE) = pq[i]; *(LAS u32x4*)(L + R_K + qlds + i * 32 * RQ_STRIDE) = pk[i]; } \
        _Pragma("unroll") for (int i = 0; i < 4; ++i) *(LAS u32x4*)(L + R_V + vlds + i * 16 * RV_STRIDE) = pv[i]; } while (0)
    if (tid < 64) { *(LAS u32x2*)(L + R_SF + ((0 * 2 + 0) * 64 + tid) * 16 + 8) = (u32x2){0u, 0u}; *(LAS u32x2*)(L + R_SF + ((2 * 2 + 1) * 64 + tid) * 16 + 8) = (u32x2){0u, 0u}; }
    const int c0 = seg * RCPS;
    RET_LOAD(c0); RET_STORE(); RET_LOAD(c0 + 1);
    f32x4 St[8][2];
#pragma unroll
    for (int dt = 0; dt < 8; ++dt) { St[dt][0] = (f32x4){0.f, 0.f, 0.f, 0.f}; St[dt][1] = (f32x4){0.f, 0.f, 0.f, 0.f}; }
    if (seg > 0) {
        const float fseg = __builtin_amdgcn_exp2f((float)(64 * RCPS) * lg2_gamma(h));
        for (int sg = 0; sg < seg; ++sg) { const f32x4* sp = (const f32x4*)sloc_ptr(F, b * 4 + h, sg, w) + lane; f32x4 tl[8][2];
#pragma unroll
            for (int dt = 0; dt < 8; ++dt) { tl[dt][0] = sp[(dt * 2) * 64]; tl[dt][1] = sp[(dt * 2 + 1) * 64]; }
#pragma unroll
            for (int dt = 0; dt < 8; ++dt) { St[dt][0] = St[dt][0] * fseg + tl[dt][0]; St[dt][1] = St[dt][1] * fseg + tl[dt][1]; } } }
    __syncthreads();
    for (int cc = 0; cc < RCPS; ++cc) {
        const int c = c0 + cc;
        const size_t t0 = tb + (size_t)c * 64;
        u32x4 gp[4];
#pragma unroll
        for (int k = 0; k < 4; ++k) gp[k] = __builtin_nontemporal_load((const u32x4*)(Pc + (t0 + 16 * k) * INW * 2 + goff));
#pragma unroll
        for (int rep = 0; rep < 2; ++rep) {
            const int id = w + 8 * rep;
            if (id < 10) {
                const int tj = id < 4 ? 0 : id < 7 ? 1 : id < 9 ? 2 : 3, ti = id < 4 ? id : id < 7 ? id - 3 : id < 9 ? id - 5 : 3;
                f32x4 s = (f32x4){0.f, 0.f, 0.f, 0.f};
#pragma unroll
                for (int kb = 0; kb < 4; ++kb) {
                    const bf16x8 a = *(const LAS bf16x8*)(L + R_K + (16 * tj + l15) * RQ_STRIDE + (32 * kb + 8 * rq) * 2);
                    const bf16x8 q = *(const LAS bf16x8*)(L + R_Q + (16 * ti + l15) * RQ_STRIDE + (32 * kb + 8 * rq) * 2);
                    s = __builtin_amdgcn_mfma_f32_16x16x32_bf16(a, q, s, 0, 0, 0); }
                if (tj == ti) {
#pragma unroll
                    for (int r = 0; r < 4; ++r) s[r] = (l15 >= 4 * rq + r) ? s[r] : 0.f; }
                u32x2 wv; wv.x = cvt_pk_bf16(s[0], s[1]); wv.y = cvt_pk_bf16(s[2], s[3]);
                *(LAS u32x2*)(L + R_SF + ((ti * 2 + (tj >> 1)) * 64 + lane) * 16 + (tj & 1) * 8) = wv;
            }
        }
        __syncthreads();
        f32x4 O[2][4];
#pragma unroll
        for (int et = 0; et < 2; ++et)
#pragma unroll
            for (int ti = 0; ti < 4; ++ti) O[et][ti] = (f32x4){0.f, 0.f, 0.f, 0.f};
#pragma unroll
        for (int kb = 0; kb < 4; ++kb) {
            bf16x8 A[2];
#pragma unroll
            for (int et = 0; et < 2; ++et) { const f32x4 s0 = St[2 * kb][et], s1 = St[2 * kb + 1][et];
                u32x4 p; p.x = cvt_pk_bf16(s0[0], s0[1]); p.y = cvt_pk_bf16(s0[2], s0[3]); p.z = cvt_pk_bf16(s1[0], s1[1]); p.w = cvt_pk_bf16(s1[2], s1[3]); A[et] = __builtin_bit_cast(bf16x8, p); }
#pragma unroll
            for (int ti = 0; ti < 4; ++ti) {
                const LAS unsigned char* qp = L + R_Q + (16 * ti + l15) * RQ_STRIDE + (32 * kb + 4 * rq) * 2;
                const bf16x8 Bq = cat8(*(const LAS s16x4*)qp, *(const LAS s16x4*)(qp + 32));
#pragma unroll
                for (int et = 0; et < 2; ++et) O[et][ti] = __builtin_amdgcn_mfma_f32_16x16x32_bf16(A[et], Bq, O[et][ti], 0, 0, 0); }
            __builtin_amdgcn_sched_barrier(0);
        }
#pragma unroll
        for (int et = 0; et < 2; ++et)
#pragma unroll
            for (int ti = 0; ti < 4; ++ti) O[et][ti] *= gam;
#pragma unroll
        for (int kb = 0; kb < 2; ++kb) {
            bf16x8 Av[2];
#pragma unroll
            for (int et = 0; et < 2; ++et) { const LAS unsigned char* vp = L + R_V + (32 * kb + 4 * rq + tq) * RV_STRIDE + (es + 16 * et + 4 * tp) * 2;
                Av[et] = cat8(tr_read(vp), tr_read(vp + 16 * RV_STRIDE)); }
#pragma unroll
            for (int ti = 2 * kb; ti < 4; ++ti) {
                const bf16x8 Bs = *(const LAS bf16x8*)(L + R_SF + ((ti * 2 + kb) * 64 + lane) * 16);
#pragma unroll
                for (int et = 0; et < 2; ++et) O[et][ti] = __builtin_amdgcn_mfma_f32_16x16x32_bf16(Av[et], Bs, O[et][ti], 0, 0, 0); }
            __builtin_amdgcn_sched_barrier(0);
        }
#pragma unroll
        for (int dt = 0; dt < 8; ++dt) { St[dt][0] *= gam; St[dt][1] *= gam; }
#pragma unroll
        for (int kb = 0; kb < 2; ++kb) {
            bf16x8 Bv[2];
#pragma unroll
            for (int et = 0; et < 2; ++et) { const LAS unsigned char* vp = L + R_V + (32 * kb + 8 * rq + tq) * RV_STRIDE + (es + 16 * et + 4 * tp) * 2;
                Bv[et] = cat8(tr_read(vp), tr_read(vp + 4 * RV_STRIDE)); }
#pragma unroll
            for (int dt = 0; dt < 8; ++dt) { const LAS unsigned char* kp = L + R_K + (32 * kb + 8 * rq + tq) * RQ_STRIDE + (16 * dt + 4 * tp) * 2;
                const bf16x8 Ak = cat8(tr_read(kp), tr_read(kp + 4 * RQ_STRIDE));
#pragma unroll
                for (int et = 0; et < 2; ++et) St[dt][et] = __builtin_amdgcn_mfma_f32_16x16x32_bf16(Ak, Bv[et], St[dt][et], 0, 0, 0);
                if (dt & 1) __builtin_amdgcn_sched_barrier(0); }
        }
#pragma unroll
        for (int dt = 0; dt < 8; ++dt) { St[dt][0] *= g63; St[dt][1] *= g63; }
#pragma unroll
        for (int ti = 0; ti < 4; ++ti) { float s = 0.f, ss = 0.f;
#pragma unroll
            for (int et = 0; et < 2; ++et)
#pragma unroll
                for (int r = 0; r < 4; ++r) { const float v = O[et][ti][r]; s += v; ss += v * v; }
            s += __shfl_xor(s, 16); s += __shfl_xor(s, 32); ss += __shfl_xor(ss, 16); ss += __shfl_xor(ss, 32);
            if (lane < 16) *(LAS f32x2*)(L + R_ST + ((16 * ti + lane) * 8 + w) * 8) = (f32x2){s, ss}; }
        __syncthreads();
        if (cc + 1 < RCPS) { RET_STORE(); if (cc + 2 < RCPS) RET_LOAD(c + 2); }
#pragma unroll
        for (int ti = 0; ti < 4; ++ti) { float s = 0.f, ss = 0.f;
            const LAS f32x4* sp = (const LAS f32x4*)(L + R_ST + (16 * ti + l15) * 64);
#pragma unroll
            for (int k = 0; k < 4; ++k) { const f32x4 v = sp[k]; s += v[0] + v[2]; ss += v[1] + v[3]; }
            const float mean = s * (1.0f / 256.0f), var = ss * (1.0f / 256.0f) - mean * mean, rstd = 1.0f / sqrtf(fmaxf(var, 0.f) + LN_EPS);
#pragma unroll
            for (int et = 0; et < 2; ++et) { const f32x4 o = (O[et][ti] - mean) * rstd;
                u32x2 wv; wv.x = cvt_pk_bf16(o[0], o[1]); wv.y = cvt_pk_bf16(o[2], o[3]);
                *(LAS u32x2*)(L + R_OT + (16 * ti + l15) * RO_STRIDE + (es + 16 * et + 4 * rq) * 2) = wv; } }
        __syncthreads();
#pragma unroll
        for (int k = 0; k < 4; ++k) { f32x4 o0, o1, g0, g1; unpack8(*(const LAS u32x4*)(L + R_OT + olds + k * 16 * RO_STRIDE), o0, o1); unpack8(gp[k], g0, g1);
            *(u32x4*)(Yc + (t0 + 16 * k) * DM * 2 + yoff) = pack8(o0 * g0, o1 * g1); }
    }
#undef RET_LOAD
#undef RET_STORE
}


__device__ __forceinline__ void ret_prepass(Frame& F, int b, int h, int seg) {
    LAS unsigned char* L = F.lds;
    __syncthreads();
    const int tid = F.tid, lane = F.lane, w = F.wave, l15 = lane & 15, rq = lane >> 4, tq = l15 >> 2, tp = lane & 3, es = 32 * w;
    const float gam = __builtin_amdgcn_exp2f(lg2_gamma(h)), g63 = __builtin_amdgcn_exp2f(63.0f * lg2_gamma(h));
    const unsigned qoff = (unsigned)((tid >> 4) * INW + h * 128 + (tid & 15) * 8) * 2u, voffv = (unsigned)((tid >> 5) * INW + C_V + h * 256 + (tid & 31) * 8) * 2u;
    const unsigned qlds = (unsigned)((tid >> 4) * RQ_STRIDE + (tid & 15) * 16), vlds = (unsigned)((tid >> 5) * RV_STRIDE + (tid & 31) * 16);
    u32x4 pk[2], pv[4];
    const size_t tb = (size_t)b * SEQ; const char* Pc = (const char*)WSP(bf16, WS_P);
#define RPP_LOAD(c) do { const char* ub_ = Pc + (tb + (size_t)(c) * 64) * INW * 2; \
        _Pragma("unroll") for (int i = 0; i < 2; ++i) pk[i] = __builtin_nontemporal_load((const u32x4*)(ub_ + (size_t)(32 * i) * INW * 2 + qoff + C_K * 2)); \
        _Pragma("unroll") for (int i = 0; i < 4; ++i) pv[i] = __builtin_nontemporal_load((const u32x4*)(ub_ + (size_t)(16 * i) * INW * 2 + voffv)); } while (0)
#define RPP_STORE() do { \
        _Pragma("unroll") for (int i = 0; i < 2; ++i) *(LAS u32x4*)(L + R_K + qlds + i * 32 * RQ_STRIDE) = pk[i]; \
        _Pragma("unroll") for (int i = 0; i < 4; ++i) *(LAS u32x4*)(L + R_V + vlds + i * 16 * RV_STRIDE) = pv[i]; } while (0)
    const int c0 = seg * RCPS;
    RPP_LOAD(c0); RPP_STORE(); RPP_LOAD(c0 + 1);
    f32x4 St[8][2];
#pragma unroll
    for (int dt = 0; dt < 8; ++dt) { St[dt][0] = (f32x4){0.f, 0.f, 0.f, 0.f}; St[dt][1] = (f32x4){0.f, 0.f, 0.f, 0.f}; }
    __syncthreads();
    for (int cc = 0; cc < RCPS; ++cc) {
#pragma unroll
        for (int dt = 0; dt < 8; ++dt) { St[dt][0] *= gam; St[dt][1] *= gam; }
#pragma unroll
        for (int kb = 0; kb < 2; ++kb) {
            bf16x8 Bv[2];
#pragma unroll
            for (int et = 0; et < 2; ++et) { const LAS unsigned char* vp = L + R_V + (32 * kb + 8 * rq + tq) * RV_STRIDE + (es + 16 * et + 4 * tp) * 2;
                Bv[et] = cat8(tr_read(vp), tr_read(vp + 4 * RV_STRIDE)); }
#pragma unroll
            for (int dt = 0; dt < 8; ++dt) { const LAS unsigned char* kp = L + R_K + (32 * kb + 8 * rq + tq) * RQ_STRIDE + (16 * dt + 4 * tp) * 2;
                const bf16x8 Ak = cat8(tr_read(kp), tr_read(kp + 4 * RQ_STRIDE));
#pragma unroll
                for (int et = 0; et < 2; ++et) St[dt][et] = __builtin_amdgcn_mfma_f32_16x16x32_bf16(Ak, Bv[et], St[dt][et], 0, 0, 0);
                if (dt & 1) __builtin_amdgcn_sched_barrier(0); }
        }
#pragma unroll
        for (int dt = 0; dt < 8; ++dt) { St[dt][0] *= g63; St[dt][1] *= g63; }
        __syncthreads();
        if (cc + 1 < RCPS) { RPP_STORE(); if (cc + 2 < RCPS) RPP_LOAD(c0 + cc + 2); }
        __syncthreads();
    }
    f32x4* sp = (f32x4*)sloc_ptr(F, b * 4 + h, seg, w) + lane;
#pragma unroll
    for (int dt = 0; dt < 8; ++dt)
#pragma unroll
        for (int et = 0; et < 2; ++et) sp[(dt * 2 + et) * 64] = St[dt][et];
#undef RPP_LOAD
#undef RPP_STORE
}

__device__ __forceinline__ float wave_sum_dpp(float v);
constexpr int SGT_STRIDE = 272;
constexpr int SG4_ST = 0, SG4_T = 1024, SG4_U = SG4_T + 128 * SGT_STRIDE, SG4_W = SG4_U + 128 * SGT_STRIDE, SG4_END = SG4_W + 24 * 1024;
static_assert(SG4_END <= RING_BYTES, "SGU LDS");
__device__ __forceinline__ void sgu_unit(Frame& F, int blk, int l, const float* sg_b, const float* sg_ln_g, const float* sg_ln_b) {
    LAS unsigned char* L = F.lds;
    const int tid = F.tid, lane = F.lane, w = F.wave, l15 = lane & 15, rq = lane >> 4, tq = l15 >> 2, tp = lane & 3;
    const size_t t0 = (size_t)blk * 128;
    const char* Pc = (const char*)WSP(bf16, WS_P); char* Yc = (char*)WSP(bf16, WS_YSG);
    const bf16* Wl = WSP(bf16, WS_SGW) + (size_t)l * 8 * 128 * 128;
    __syncthreads();
    const int srow = tid >> 4, sch = tid & 15;
    const unsigned soff = (unsigned)(srow * INW + sch * 8) * 2u, slds = (unsigned)(srow * SGT_STRIDE + sch * 16), yoff = (unsigned)(srow * DM + sch * 8) * 2u;
    unsigned wsrc[3];
#pragma unroll
    for (int i = 0; i < 3; ++i) { const int p = tid + 512 * i, f = p >> 6, ln = p & 63, qt = f < 8 ? (f >> 1) : 4 + ((f - 8) >> 2), kb = f < 8 ? (f & 1) : ((f - 8) & 3);
        wsrc[i] = (unsigned)((16 * qt + (ln & 15)) * 128 + 32 * kb + 8 * (ln >> 4)) * 2u; }
    u32x4 xv[4], xu[4], wreg[3]; f32x4 lnp[4]; float bq[8], bqn[8];
#define SG_LOAD(g_) do { _Pragma("unroll") for (int i = 0; i < 4; ++i) { const char* rp = Pc + ((t0 + 32 * i) * INW + (g_) * 128) * 2 + soff; xv[i] = __builtin_nontemporal_load((const u32x4*)(rp + C_VS * 2)); xu[i] = __builtin_nontemporal_load((const u32x4*)(rp + C_U * 2)); } \
        { const float* lng = sg_ln_g + (size_t)l * DM + (g_) * 128 + sch * 8; const float* lnb = sg_ln_b + (size_t)l * DM + (g_) * 128 + sch * 8; lnp[0] = *(const f32x4*)lng; lnp[1] = *(const f32x4*)(lng + 4); lnp[2] = *(const f32x4*)lnb; lnp[3] = *(const f32x4*)(lnb + 4); } \
        _Pragma("unroll") for (int qt = 0; qt < 8; ++qt) bqn[qt] = sg_b[((size_t)l * 8 + (g_)) * 128 + 16 * qt + l15]; \
        _Pragma("unroll") for (int i = 0; i < 3; ++i) wreg[i] = *(const u32x4*)((const char*)(Wl + (size_t)(g_) * 128 * 128) + wsrc[i]); } while (0)
#define SG_WPUT() do { _Pragma("unroll") for (int i = 0; i < 3; ++i) *(LAS u32x4*)(L + SG4_W + (tid + 512 * i) * 16) = wreg[i]; } while (0)
    SG_LOAD(0);
#pragma unroll 1
    for (int r8 = 0; r8 < 2; ++r8) { u32x4 a[8], b2[8];
#pragma unroll
        for (int r = 0; r < 8; ++r) { const char* rp = Pc + ((t0 + 16 * w + 8 * r8 + r) * INW + C_VS) * 2 + lane * 32; a[r] = *(const u32x4*)rp; b2[r] = *(const u32x4*)(rp + 16); }
#pragma unroll
        for (int r = 0; r < 8; ++r) { f32x4 x0, x1, x2, x3; unpack8(a[r], x0, x1); unpack8(b2[r], x2, x3);
            float s = 0.f, ss = 0.f;
#pragma unroll
            for (int j = 0; j < 4; ++j) { s += x0[j] + x1[j] + x2[j] + x3[j]; ss += x0[j] * x0[j] + x1[j] * x1[j] + x2[j] * x2[j] + x3[j] * x3[j]; }
            s = wave_sum_dpp(s); ss = wave_sum_dpp(ss);
            const float mean = s * (1.0f / 1024.0f), var = ss * (1.0f / 1024.0f) - mean * mean;
            if (lane == 0) *(LAS f32x2*)(L + SG4_ST + (16 * w + 8 * r8 + r) * 8) = (f32x2){mean, 1.0f / sqrtf(fmaxf(var, 0.f) + LN_EPS)}; } }
    SG_WPUT();
    __syncthreads();
#pragma unroll 1
    for (int g = 0; g < 8; ++g) {
#pragma unroll
        for (int qt = 0; qt < 8; ++qt) bq[qt] = bqn[qt];
#pragma unroll
        for (int i = 0; i < 4; ++i) { f32x4 x0, x1; unpack8(xv[i], x0, x1);
            const f32x2 st = *(const LAS f32x2*)(L + SG4_ST + (srow + 32 * i) * 8);
            x0 = (x0 - st.x) * st.y * lnp[0] + lnp[2]; x1 = (x1 - st.x) * st.y * lnp[1] + lnp[3];
            *(LAS u32x4*)(L + SG4_T + slds + i * 32 * SGT_STRIDE) = pack8(x0, x1);
            *(LAS u32x4*)(L + SG4_U + slds + i * 32 * SGT_STRIDE) = xu[i]; }
        if (g < 7) SG_LOAD(g + 1);
        __syncthreads();
        bf16x8 Av[4];
#pragma unroll
        for (int kb = 0; kb < 4; ++kb) { const LAS unsigned char* vp = L + SG4_T + (32 * kb + 8 * rq + tq) * SGT_STRIDE + (16 * w + 4 * tp) * 2; Av[kb] = cat8(tr_read(vp), tr_read(vp + 4 * SGT_STRIDE)); }
#pragma unroll
        for (int qt = 0; qt < 8; ++qt) {
            f32x4 a0 = (f32x4){0.f, 0.f, 0.f, 0.f};
#pragma unroll
            for (int kb = 0; kb < 4; ++kb) { if (qt < 4 && kb >= 2) continue;
                const int f = qt < 4 ? 2 * qt + kb : 8 + 4 * (qt - 4) + kb;
                const bf16x8 Bw = *(const LAS bf16x8*)(L + SG4_W + f * 1024 + lane * 16);
                a0 = __builtin_amdgcn_mfma_f32_16x16x32_bf16(Av[kb], Bw, a0, 0, 0, 0); }
            const f32x4 a = a0 + bq[qt];
            LAS u32x2* up = (LAS u32x2*)(L + SG4_U + (16 * qt + l15) * SGT_STRIDE + (16 * w + 4 * rq) * 2);
            const u32x2 u2 = *up;
            u32x2 wv; wv.x = cvt_pk_bf16(a[0] * bf_lo(u2.x), a[1] * bf_hi(u2.x)); wv.y = cvt_pk_bf16(a[2] * bf_lo(u2.y), a[3] * bf_hi(u2.y));
            *up = wv;
        }
        __syncthreads();
        if (g < 7) SG_WPUT();
#pragma unroll
        for (int i = 0; i < 4; ++i) *(u32x4*)(Yc + ((t0 + 32 * i) * DM + g * 128) * 2 + yoff) = *(const LAS u32x4*)(L + SG4_U + slds + i * 32 * SGT_STRIDE);
    }
#undef SG_LOAD
#undef SG_WPUT
}

__device__ __forceinline__ float wave_sum_dpp(float v) {
    v += __builtin_bit_cast(float, __builtin_amdgcn_update_dpp(0, __builtin_bit_cast(int, v), 0xB1, 0xF, 0xF, true));
    v += __builtin_bit_cast(float, __builtin_amdgcn_update_dpp(0, __builtin_bit_cast(int, v), 0x4E, 0xF, 0xF, true));
    v += __builtin_bit_cast(float, __builtin_amdgcn_update_dpp(0, __builtin_bit_cast(int, v), 0x141, 0xF, 0xF, true));
    v += __builtin_bit_cast(float, __builtin_amdgcn_update_dpp(0, __builtin_bit_cast(int, v), 0x140, 0xF, 0xF, true));
    const int iv = __builtin_bit_cast(int, v);
    return (__builtin_bit_cast(float, __builtin_amdgcn_readlane(iv, 0)) + __builtin_bit_cast(float, __builtin_amdgcn_readlane(iv, 16))) +
           (__builtin_bit_cast(float, __builtin_amdgcn_readlane(iv, 32)) + __builtin_bit_cast(float, __builtin_amdgcn_readlane(iv, 48)));
}
constexpr int RX_STRIDE = 2064, RX_H = 0, RX_L = 16 * RX_STRIDE, RX_PART = 2 * 16 * RX_STRIDE, RX_LOG = RX_PART + 8 * 2 * 1024, RX_END = RX_LOG + 2048;
static_assert(RX_END <= RING_BYTES, "router LDS");
__device__ __forceinline__ void ln_router_phase(Frame& F, int l, int cnt_off, const float* router_w, const float* router_b, const float* ln1_g, const float* ln1_b) {
    LAS unsigned char* L = F.lds;
    LAS int* LCNT = (LAS int*)(F.lds + LCNT_OFF); LAS int* LBASE = (LAS int*)(F.lds + LBASE_OFF); LAS int* LSEL = (LAS int*)(F.lds + LSEL_OFF);
    const int tid = F.tid, lane = F.lane, w = F.wave, l15 = lane & 15, rq = lane >> 4;
    const bf16* Z = WSP(bf16, WS_Z); bf16* X1b = WSP(bf16, WS_X1B); float* st1 = WSP(float, WS_ST1);
    int* selinfo = WSP(int, WS_SEL); float* gates = (float*)(selinfo + (size_t)T * 4); int* tok_list = WSP(int, WS_TOK);
    unsigned* cnt = F.ctl + CW_CNT + cnt_off + l * NE;
    const float* lg = ln1_g + (size_t)l * DM; const float* lb = ln1_b + (size_t)l * DM;
    f32x4 gv[4], bv[4];
#pragma unroll
    for (int j = 0; j < 4; ++j) { gv[j] = *(const f32x4*)(lg + 4 * lane + 256 * j); bv[j] = *(const f32x4*)(lb + 4 * lane + 256 * j); }
    bf16x8 Bh[4][2], Bl[4][2];
    { const float* rw = router_w + (size_t)l * DM * NE;
#pragma unroll
      for (int ks = 0; ks < 4; ++ks)
#pragma unroll
          for (int et = 0; et < 2; ++et) { float x[8];
#pragma unroll
              for (int j = 0; j < 8; ++j) x[j] = rw[(size_t)(128 * w + 32 * ks + 8 * rq + j) * NE + 16 * et + l15];
              u32x4 h, lo;
#pragma unroll
              for (int p = 0; p < 4; ++p) { const unsigned hp = cvt_pk_bf16(x[2 * p], x[2 * p + 1]); h[p] = hp; lo[p] = cvt_pk_bf16(x[2 * p] - bf_lo(hp), x[2 * p + 1] - bf_hi(hp)); }
              Bh[ks][et] = __builtin_bit_cast(bf16x8, h); Bl[ks][et] = __builtin_bit_cast(bf16x8, lo); } }
    const float rbias = router_b[(size_t)l * NE + (lane & 31)];
    for (int chunk = F.bid; chunk < T / 128; chunk += F.G) {
        if (tid < 32) LCNT[tid] = 0;
        __syncthreads();
        const size_t cbase = (size_t)chunk * 128;
        u32x2 nx[2][4];
#pragma unroll
        for (int q = 0; q < 2; ++q)
#pragma unroll
            for (int j = 0; j < 4; ++j) nx[q][j] = *(const u32x2*)(Z + (cbase + 2 * w + q) * DM + 4 * lane + 256 * j);
#pragma unroll 1
        for (int r = 0; r < 8; ++r) {
            u32x2 cu[2][4];
#pragma unroll
            for (int q = 0; q < 2; ++q)
#pragma unroll
                for (int j = 0; j < 4; ++j) cu[q][j] = nx[q][j];
            if (r < 7) {
#pragma unroll
                for (int q = 0; q < 2; ++q)
#pragma unroll
                    for (int j = 0; j < 4; ++j) nx[q][j] = *(const u32x2*)(Z + (cbase + 16 * (r + 1) + 2 * w + q) * DM + 4 * lane + 256 * j); }
#pragma unroll
            for (int q = 0; q < 2; ++q) { const int tl = 16 * r + 2 * w + q; const size_t t = cbase + tl;
                f32x4 v[4]; float s = 0.f;
#pragma unroll
                for (int j = 0; j < 4; ++j) { v[j] = (f32x4){bf_lo(cu[q][j].x), bf_hi(cu[q][j].x), bf_lo(cu[q][j].y), bf_hi(cu[q][j].y)}; s += (v[j][0] + v[j][1]) + (v[j][2] + v[j][3]); }
                const float mean = wave_sum_dpp(s) * (1.0f / DM); float s2 = 0.f;
#pragma unroll
                for (int j = 0; j < 4; ++j) { v[j] = v[j] - mean; s2 += (v[j][0] * v[j][0] + v[j][1] * v[j][1]) + (v[j][2] * v[j][2] + v[j][3] * v[j][3]); }
                const float rstd = 1.0f / sqrtf(wave_sum_dpp(s2) * (1.0f / DM) + LN_EPS);
                if (lane == 0) *(f32x2*)(st1 + t * 2) = (f32x2){mean, rstd};
#pragma unroll
                for (int j = 0; j < 4; ++j) { v[j] = v[j] * rstd * gv[j] + bv[j];
                    if (MOE_FP8) *(unsigned*)((unsigned char*)X1b + t * DM + 4 * lane + 256 * j) = cvt4_fp8(v[j][0] * 4.0f, v[j][1] * 4.0f, v[j][2] * 4.0f, v[j][3] * 4.0f);
                    else { u32x2 wv; wv.x = cvt_pk_bf16(v[j][0], v[j][1]); wv.y = cvt_pk_bf16(v[j][2], v[j][3]); *(u32x2*)(X1b + t * DM + 4 * lane + 256 * j) = wv; }
                    u32x2 h, lo; h.x = cvt_pk_bf16(v[j][0], v[j][1]); h.y = cvt_pk_bf16(v[j][2], v[j][3]);
                    lo.x = cvt_pk_bf16(v[j][0] - bf_lo(h.x), v[j][1] - bf_hi(h.x)); lo.y = cvt_pk_bf16(v[j][2] - bf_lo(h.y), v[j][3] - bf_hi(h.y));
                    *(LAS u32x2*)(L + RX_H + (2 * w + q) * RX_STRIDE + (4 * lane + 256 * j) * 2) = h; *(LAS u32x2*)(L + RX_L + (2 * w + q) * RX_STRIDE + (4 * lane + 256 * j) * 2) = lo; } }
            __syncthreads();
            f32x4 acc[2] = {(f32x4){0.f, 0.f, 0.f, 0.f}, (f32x4){0.f, 0.f, 0.f, 0.f}};
#pragma unroll
            for (int ks = 0; ks < 4; ++ks) {
                const bf16x8 ah = *(const LAS bf16x8*)(L + RX_H + l15 * RX_STRIDE + (128 * w + 32 * ks + 8 * rq) * 2), al = *(const LAS bf16x8*)(L + RX_L + l15 * RX_STRIDE + (128 * w + 32 * ks + 8 * rq) * 2);
#pragma unroll
                for (int et = 0; et < 2; ++et) { acc[et] = __builtin_amdgcn_mfma_f32_16x16x32_bf16(ah, Bh[ks][et], acc[et], 0, 0, 0); acc[et] = __builtin_amdgcn_mfma_f32_16x16x32_bf16(ah, Bl[ks][et], acc[et], 0, 0, 0);
                    acc[et] = __builtin_amdgcn_mfma_f32_16x16x32_bf16(al, Bh[ks][et], acc[et], 0, 0, 0); } }
            *(LAS f32x4*)(L + RX_PART + ((w * 2 + 0) * 64 + lane) * 16) = acc[0]; *(LAS f32x4*)(L + RX_PART + ((w * 2 + 1) * 64 + lane) * 16) = acc[1];
            __syncthreads();
            float xl;
            { const int tk = 2 * w + (lane >> 5), e = lane & 31, src = ((e >> 4) * 64 + (tk >> 2) * 16 + (e & 15)) * 16 + (tk & 3) * 4; float sum = rbias;
#pragma unroll
              for (int v8 = 0; v8 < 8; ++v8) sum += *(const LAS float*)(L + RX_PART + v8 * 2048 + src);
              xl = sum; }
            float tv[4]; int te[4];
#pragma unroll
            for (int k = 0; k < 4; ++k) { float m = xl;
                m = fmaxf(m, __builtin_bit_cast(float, __builtin_amdgcn_update_dpp(0, __builtin_bit_cast(int, m), 0xB1, 0xF, 0xF, true)));
                m = fmaxf(m, __builtin_bit_cast(float, __builtin_amdgcn_update_dpp(0, __builtin_bit_cast(int, m), 0x4E, 0xF, 0xF, true)));
                m = fmaxf(m, __builtin_bit_cast(float, __builtin_amdgcn_update_dpp(0, __builtin_bit_cast(int, m), 0x141, 0xF, 0xF, true)));
                m = fmaxf(m, __builtin_bit_cast(float, __builtin_amdgcn_update_dpp(0, __builtin_bit_cast(int, m), 0x140, 0xF, 0xF, true)));
                const int mi = __builtin_bit_cast(int, m);
                const float mlo = fmaxf(__builtin_bit_cast(float, __builtin_amdgcn_readlane(mi, 0)), __builtin_bit_cast(float, __builtin_amdgcn_readlane(mi, 16)));
                const float mhi = fmaxf(__builtin_bit_cast(float, __builtin_amdgcn_readlane(mi, 32)), __builtin_bit_cast(float, __builtin_amdgcn_readlane(mi, 48)));
                const float mm = lane < 32 ? mlo : mhi;
                const unsigned long long bal = __ballot(xl == mm);
                const int wlo = __builtin_ctz((unsigned)bal | 0x80000000u), whi = __builtin_ctz((unsigned)(bal >> 32) | 0x80000000u);
                const int win = lane < 32 ? wlo : whi;
                tv[k] = mm; te[k] = win;
                if ((lane & 31) == win) xl = -INFINITY; }
            if ((lane & 31) == 0) {
                const int tk = 2 * w + (lane >> 5), tl = 16 * r + tk; const size_t t = cbase + tl;
                const float v0 = tv[0], v1 = tv[1], v2 = tv[2], v3 = tv[3];
                const float p1 = __expf(v1 - v0), p2 = __expf(v2 - v0), p3 = __expf(v3 - v0), inv = 1.0f / (1.0f + p1 + p2 + p3);
#pragma unroll
                for (int k = 0; k < 4; ++k) { const int lp = __hip_atomic_fetch_add(&LCNT[te[k]], 1, __ATOMIC_RELAXED, __HIP_MEMORY_SCOPE_WORKGROUP); LSEL[tl * 4 + k] = (te[k] << 16) | lp; }
                *(f32x4*)(gates + t * 4) = (f32x4){inv, p1 * inv, p2 * inv, p3 * inv};
            }
        }
        __syncthreads();
        if (tid < 32) LBASE[tid] = (int)__hip_atomic_fetch_add(cnt + tid, (unsigned)LCNT[tid], __ATOMIC_RELAXED, __HIP_MEMORY_SCOPE_AGENT);
        __syncthreads();
        { const int sidx = tid, v = LSEL[sidx], e = v >> 16, pos = LBASE[e] + (v & 0xffff); const int t = chunk * 128 + (sidx >> 2);
          tok_list[(size_t)e * T + pos] = t; selinfo[(size_t)t * 4 + (sidx & 3)] = (e << 16) | pos; }
        __syncthreads();
    }
}

__device__ __forceinline__ void moe_tables(Frame& F, int l, bool fill_idx, int nN) {
    LAS int* TS = (LAS int*)(F.lds + TSTART_OFF); LAS int* LC = (LAS int*)(F.lds + LCNT_OFF); LAS int* IDX = (LAS int*)(F.lds + IDX_OFF);
    const unsigned* cnt = F.ctl + CW_CNT + l * NE;
    __syncthreads();
    if (F.tid < 64) {
        const int e = F.tid & 31; const int c = (int)__hip_atomic_load(cnt + e, __ATOMIC_RELAXED, __HIP_MEMORY_SCOPE_AGENT); const int tl = (c + 255) >> 8;
        int inc = tl;
#pragma unroll
        for (int o = 1; o < 32; o <<= 1) { const int y = __shfl_up(inc, o, 32); if (e >= o) inc += y; }
        if (F.tid < 32) { LC[e] = c; TS[e] = inc - tl; if (e == 31) TS[32] = inc; } }
    __syncthreads();
    if (fill_idx) {
        const int* tok_list = WSP(int, WS_TOK); const int ntile = TS[32];
        int tv[IDX_SLOTS];
        const int tsl = TS[F.lane & 31];
#pragma unroll
        for (int s = 0; s < IDX_SLOTS; ++s) { int mtg, pn_; pg8::moe_unit_map(s, F.bid, nN, F.G, mtg, pn_); tv[s] = 0;
            if (mtg < ntile && F.tid < 256) { const int e = __builtin_popcount(((unsigned)__ballot(tsl <= mtg)) >> 1);
                const int r = (mtg - TS[e]) * 256 + F.tid; if (r < LC[e]) tv[s] = tok_list[(size_t)e * T + r]; } }
        if (F.tid < 256) {
#pragma unroll
            for (int s = 0; s < IDX_SLOTS; ++s) IDX[s * 256 + F.tid] = tv[s]; }
        __syncthreads();
    }
}

#if MOE_FP8
typedef unsigned YR_T;
#define YR_LOAD(row_, j_) __builtin_nontemporal_load((const unsigned*)((const unsigned char*)Yr + (row_) * DM + 4 * lane + 256 * (j_)))
#else
typedef u32x2 YR_T;
#define YR_LOAD(row_, j_) (*(const u32x2*)(Yr + (row_) * DM + 4 * lane + 256 * (j_)))
#endif
__device__ __forceinline__ void combine_phase(Frame& F, int l, float* Xo, const float* ln1_g, const float* ln1_b, const float* ln2_g, const float* ln2_b) {
    LAS int* TS = (LAS int*)(F.lds + TSTART_OFF);
    const int lane = F.lane;
    const bf16* Z = WSP(bf16, WS_Z); const float* st1 = WSP(float, WS_ST1); const bf16* Yr = WSP(bf16, WS_YRAW);
    const int* selinfo = WSP(int, WS_SEL); const float* gates = (const float*)(selinfo + (size_t)T * 4);
    bf16* Xb = WSP(bf16, WS_XB);
    const float* lg1 = ln1_g + (size_t)l * DM; const float* lb1 = ln1_b + (size_t)l * DM; const float* lg = ln2_g + (size_t)l * DM; const float* lb = ln2_b + (size_t)l * DM;
    f32x4 gv[4], bv[4], g1v[4], b1v[4];
#pragma unroll
    for (int j = 0; j < 4; ++j) { gv[j] = *(const f32x4*)(lg + 4 * lane + 256 * j); bv[j] = *(const f32x4*)(lb + 4 * lane + 256 * j); g1v[j] = *(const f32x4*)(lg1 + 4 * lane + 256 * j); b1v[j] = *(const f32x4*)(lb1 + 4 * lane + 256 * j); }
    const int tfirst = F.bid * NWAVES + F.wave, tstep = F.G * NWAVES;
    const int ntok = (T - tfirst + tstep - 1) / tstep;
    i32x4 si_n; f32x4 gt_n;
    u32x2 zr[4]; YR_T yr[4][4]; f32x2 ms; f32x4 gt_c;
    { const i32x4 s0 = *(const i32x4*)(selinfo + (size_t)tfirst * 4); gt_c = *(const f32x4*)(gates + (size_t)tfirst * 4); ms = *(const f32x2*)(st1 + (size_t)tfirst * 2);
#pragma unroll
      for (int j = 0; j < 4; ++j) zr[j] = __builtin_nontemporal_load((const u32x2*)(Z + (size_t)tfirst * DM + 4 * lane + 256 * j));
#pragma unroll
      for (int k = 0; k < 4; ++k) { const size_t row = (size_t)TS[s0[k] >> 16] * 256 + (s0[k] & 0xffff);
#pragma unroll
          for (int j = 0; j < 4; ++j) yr[k][j] = YR_LOAD(row, j); }
      const int t1 = tfirst + tstep < T ? tfirst + tstep : tfirst; si_n = *(const i32x4*)(selinfo + (size_t)t1 * 4); gt_n = *(const f32x4*)(gates + (size_t)t1 * 4); }
    for (int i = 0; i < ntok; ++i) {
        const int t = tfirst + i * tstep;
        f32x4 v[4];
#pragma unroll
        for (int j = 0; j < 4; ++j) { const f32x4 zf = (f32x4){bf_lo(zr[j].x), bf_hi(zr[j].x), bf_lo(zr[j].y), bf_hi(zr[j].y)};
            v[j] = ((zf - ms.x) * ms.y * g1v[j] + b1v[j]) * DN_ALPHA; }
#pragma unroll
        for (int k = 0; k < 4; ++k)
#pragma unroll
            for (int j = 0; j < 4; ++j) {
#if MOE_FP8
                const int y = (int)yr[k][j]; const float gt = gt_c[k] * (1.0f / 16.0f);
                v[j][0] += gt * __builtin_amdgcn_cvt_f32_fp8(y, 0); v[j][1] += gt * __builtin_amdgcn_cvt_f32_fp8(y, 1); v[j][2] += gt * __builtin_amdgcn_cvt_f32_fp8(y, 2); v[j][3] += gt * __builtin_amdgcn_cvt_f32_fp8(y, 3);
#else
                const u32x2 y = yr[k][j]; const float gt = gt_c[k];
                v[j][0] += gt * bf_lo(y.x); v[j][1] += gt * bf_hi(y.x); v[j][2] += gt * bf_lo(y.y); v[j][3] += gt * bf_hi(y.y);
#endif
            }
        if (i + 1 < ntok) { const int tn = t + tstep; const i32x4 s1 = si_n; gt_c = gt_n; ms = *(const f32x2*)(st1 + (size_t)tn * 2);
#pragma unroll
            for (int j = 0; j < 4; ++j) zr[j] = __builtin_nontemporal_load((const u32x2*)(Z + (size_t)tn * DM + 4 * lane + 256 * j));
#pragma unroll
            for (int k = 0; k < 4; ++k) { const size_t row = (size_t)TS[s1[k] >> 16] * 256 + (s1[k] & 0xffff);
#pragma unroll
                for (int j = 0; j < 4; ++j) yr[k][j] = YR_LOAD(row, j); }
            const int t2 = tn + tstep < T ? tn + tstep : tn; si_n = *(const i32x4*)(selinfo + (size_t)t2 * 4); gt_n = *(const f32x4*)(gates + (size_t)t2 * 4); }
        float s = 0.f;
#pragma unroll
        for (int j = 0; j < 4; ++j) s += (v[j][0] + v[j][1]) + (v[j][2] + v[j][3]);
        const float mean = wave_sum_dpp(s) * (1.0f / DM); float s2 = 0.f;
#pragma unroll
        for (int j = 0; j < 4; ++j) { v[j] = v[j] - mean; s2 += (v[j][0] * v[j][0] + v[j][1] * v[j][1]) + (v[j][2] * v[j][2] + v[j][3] * v[j][3]); }
        const float rstd = 1.0f / sqrtf(wave_sum_dpp(s2) * (1.0f / DM) + LN_EPS);
#pragma unroll
        for (int j = 0; j < 4; ++j) { v[j] = v[j] * rstd * gv[j] + bv[j];
            if (Xo) *(f32x4*)(Xo + (size_t)t * DM + 4 * lane + 256 * j) = v[j];
            if (!Xo) { u32x2 wv; wv.x = cvt_pk_bf16(v[j][0], v[j][1]); wv.y = cvt_pk_bf16(v[j][2], v[j][3]); *(u32x2*)(Xb + (size_t)t * DM + 4 * lane + 256 * j) = wv; }
            if (INPROJ_FP8 && !Xo) *(unsigned*)(WSP(unsigned char, WS_XQ) + (size_t)t * DM + 4 * lane + 256 * j) = cvt4_fp8(v[j][0] * 4.0f, v[j][1] * 4.0f, v[j][2] * 4.0f, v[j][3] * 4.0f); }
    }
}

constexpr int NPH = 8, N_PHASES = 1 + NL * NPH;
struct Args { const float* in[19]; float* out; unsigned char* ws; int ph_lo, ph_hi; };
static_assert(sizeof(Args) == 19 * 8 + 8 + 8 + 8, "Args has no padding");

__global__ void __launch_bounds__(NTHREADS, 2) mk_fwd(Args args) {
    extern __shared__ __attribute__((aligned(16))) unsigned char lds_raw[];
    Frame F;
    F.lds = (LAS unsigned char*)lds_raw; F.MISC = (volatile LAS unsigned*)(F.lds + MISC_OFF);
    F.tid = threadIdx.x; F.lane = F.tid & 63; F.wave = __builtin_amdgcn_readfirstlane(F.tid >> 6); F.G = gridDim.x; F.bid = blockIdx.x;
    F.ws = args.ws; F.ctl = (unsigned*)(args.ws + WS_CTL);
    if (F.tid < 16) F.MISC[F.tid] = 0u;
    __syncthreads();
    XcdBarrier bar; bar.bar = F.ctl + CW_BAR; bar.x = 0; bar.st = nullptr;
    if (MK_N_LAUNCHES == 1) bar = xcd_barrier_post(F.ctl + CW_BAR, F.MISC + 8);
    const int lo = args.ph_lo, hi = args.ph_hi;
#ifndef PH_MASK
#define PH_MASK 0x1ff
#endif
#define PHON(p) ((PH_MASK >> (p)) & 1)
#ifndef PROBE_DUP
#define PROBE_DUP 0
#endif
#define DUP(p) for (int rep_ = 0; rep_ < 1 + ((PROBE_DUP >> (p)) & 1); ++rep_, frame_refresh(F))
#define IN(k) (lo <= (k) && (k) < hi)
#define REFRESH() frame_refresh(F)
#ifndef PROBE_BAR2
#define PROBE_BAR2 0
#endif
#define SEAM(k) do { if (IN((k) + 1)) { if (MK_N_LAUNCHES == 1) { xcd_barrier(bar); if (PROBE_BAR2) xcd_barrier(bar); } } } while (0)

    if (PHON(8) && IN(0)) { REFRESH(); DUP(8) p0_prologue(F, args.in[0], args.in[1], args.in[2], args.in[7], args.in[8], args.in[5], args.in[13], args.in[15]); SEAM(0); }

    for (int l = 0; l < NL; ++l) {
        const int pb = 1 + l * NPH;
        int z = 0; asm volatile("" : "+s"(z));
#define ARGP(i) (args.in[(i) + z])
        if (PHON(0) && IN(pb + 0)) { REFRESH(); DUP(0) {
            pg8::InProjSched S{INPROJ_FP8 ? (const char*)WSP(unsigned char, WS_XQ) : (const char*)WSP(bf16, WS_XB), (const char*)WSP(unsigned char, WS_WIN) + (size_t)l * INW * DM * (INPROJ_FP8 ? 1 : 2), INPROJ_FP8 ? DM : 2 * DM, F.G, F.bid};
            EpiInProj E{WSP(bf16, WS_P), WSP(bf16, WS_ROPEB), WSP(unsigned char, WS_PG8)};
            pg8::gemm_phase<EpiInProj, pg8::InProjSched, false, true, F8_SP2 != 0, INPROJ_FP8 != 0>(F.lds, INPROJ_FP8 ? DM : 2 * DM, S, E); }
            SEAM(pb + 0);
        }
        if (PHON(1) && IN(pb + 1)) { REFRESH();
            DUP(1) {
#ifndef NO_RET
                if (F.bid < 192) for (int r2 = 0; r2 < 1 + ((PROBE_DUP >> 10) & 1); ++r2, frame_refresh(F)) ret_prepass(F, (F.bid / 3) >> 2, (F.bid / 3) & 3, F.bid % 3);
#endif
#ifndef NO_SGU
                for (int r2 = 0; r2 < 1 + ((PROBE_DUP >> 9) & 1); ++r2, frame_refresh(F)) sgu_unit(F, F.bid, l, ARGP(6), ARGP(3), ARGP(4));
#endif
                if (MK_N_LAUNCHES == 1) xcd_barrier(bar);
                REFRESH();
#ifndef NO_RET
                for (int r2 = 0; r2 < 1 + ((PROBE_DUP >> 11) & 1); ++r2, frame_refresh(F)) ret_unit(F, F.bid >> 4, (F.bid >> 2) & 3, F.bid & 3);
#endif
            }
            SEAM(pb + 1);
        }
        if (PHON(2) && IN(pb + 2)) { REFRESH(); DUP(2) {
            { pg8::DenseSched S; S.init(WSP(bf16, WS_YRET), WSP(bf16, WS_PRET) + (size_t)l * DM * DM, T, DM, DM, F.G, F.bid);
              EpiGate1 E{WSP(bf16, WS_P), WSP(bf16, WS_HF), WSP(unsigned char, WS_PG8)};
              pg8::gemm_phase<EpiGate1, pg8::DenseSched, false, true, true>(F.lds, 2 * DM, S, E); }
            { pg8::DenseSched S; S.init(WSP(bf16, WS_YSG), WSP(bf16, WS_PSG) + (size_t)l * DM * DM, T, DM, DM, F.G, F.bid);
              EpiGate2 E{WSP(bf16, WS_P), WSP(bf16, WS_HF), WSP(bf16, WS_HB), WSP(unsigned char, WS_PG8)};
              pg8::gemm_phase<EpiGate2, pg8::DenseSched, false, true, true>(F.lds, 2 * DM, S, E); } }
            SEAM(pb + 2);
        }
        if (PHON(3) && IN(pb + 3)) { REFRESH(); DUP(3) {
            pg8::DenseSched S; S.init(WSP(bf16, WS_HB), WSP(bf16, WS_WO) + (size_t)l * DM * DM, T, DM, DM, F.G, F.bid);
            EpiResid E{(l == 0) ? ARGP(0) : (const float*)nullptr, WSP(bf16, WS_XB), WSP(bf16, WS_Z)};
            pg8::gemm_phase<EpiResid, pg8::DenseSched, false, true, true>(F.lds, 2 * DM, S, E); }
            SEAM(pb + 3);
        }
        if (PHON(4) && IN(pb + 4)) { REFRESH();
#if (PROBE_DUP >> 4) & 1
            ln_router_phase(F, l, 128, ARGP(11), ARGP(12), ARGP(9), ARGP(10)); xcd_barrier(bar); REFRESH();
#endif
            ln_router_phase(F, l, 0, ARGP(11), ARGP(12), ARGP(9), ARGP(10)); SEAM(pb + 4); }
        if (PHON(5) && IN(pb + 5)) { REFRESH(); DUP(5) {
            moe_tables(F, l, true, 2 * DEXP / 256);
            constexpr int EB = MOE_FP8 ? 1 : 2;
            pg8::MoeSched<true> S{(const char*)WSP(bf16, WS_X1B), (const char*)WSP(unsigned char, WS_W1) + (size_t)l * NE * 2 * DEXP * DM * EB, DM * EB, 2 * DEXP, 2 * DEXP / 256, F.G, F.bid,
                                  (const LAS int*)(F.lds + TSTART_OFF), (const LAS int*)(F.lds + IDX_OFF),
                                  __builtin_amdgcn_readfirstlane(((const LAS int*)(F.lds + TSTART_OFF))[32]), ((const LAS int*)(F.lds + TSTART_OFF))[F.lane & 31]};
            EpiSwiglu E{WSP(bf16, WS_ACT), ARGP(14) + (size_t)l * NE * 2 * DEXP, F.lds};
            pg8::gemm_phase<EpiSwiglu, pg8::MoeSched<true>, true, true, F8_SP2 != 0, MOE_FP8 != 0>(F.lds, DM * EB, S, E); }
            SEAM(pb + 5);
        }
        if (PHON(6) && IN(pb + 6)) { REFRESH(); DUP(6) {
            if (MK_N_LAUNCHES != 1) moe_tables(F, l, false, DM / 256);
            constexpr int EB = MOE_FP8 ? 1 : 2;
            pg8::MoeSched<false> S{(const char*)WSP(bf16, WS_ACT), (const char*)WSP(unsigned char, WS_W2) + (size_t)l * NE * DM * DEXP * EB, DEXP * EB, DM, DM / 256, F.G, F.bid,
                                   (const LAS int*)(F.lds + TSTART_OFF), (const LAS int*)(F.lds + IDX_OFF),
                                   __builtin_amdgcn_readfirstlane(((const LAS int*)(F.lds + TSTART_OFF))[32]), ((const LAS int*)(F.lds + TSTART_OFF))[F.lane & 31]};
            EpiBias E{WSP(bf16, WS_YRAW), ARGP(16) + (size_t)l * NE * DM, F.lds};
            pg8::gemm_phase<EpiBias, pg8::MoeSched<false>, false, true, F8_SP2 != 0, MOE_FP8 != 0>(F.lds, DEXP * EB, S, E); }
            SEAM(pb + 6);
        }
        if (PHON(7) && IN(pb + 7)) { REFRESH(); if (MK_N_LAUNCHES != 1) moe_tables(F, l, false, 1); DUP(7) combine_phase(F, l, (l == NL - 1) ? args.out : (float*)nullptr, ARGP(9), ARGP(10), ARGP(17), ARGP(18)); SEAM(pb + 7); }
    }
#undef IN
#undef SEAM
#undef ARGP
#undef REFRESH
}

extern "C" void kernel_launch(void* const* d_in, const int* in_sizes, int n_in, void* d_out, int out_size, void* d_ws, size_t ws_size, hipStream_t stream) {
    static int grid = 0;
    if (grid == 0) {
        if (n_in != 19 || in_sizes[0] != T * DM || out_size != T * DM || ws_size < WS_END) { fprintf(stderr, "kernel_launch: unexpected shapes (n_in %d, in0 %d, out %d, ws %zu)\n", n_in, n_in > 0 ? in_sizes[0] : -1, out_size, ws_size); grid = -1; return; }
        int dev = 0, cus = 0, per_cu = 0;
        if (hipGetDevice(&dev) != hipSuccess || hipDeviceGetAttribute(&cus, hipDeviceAttributeMultiprocessorCount, dev) != hipSuccess) { fprintf(stderr, "kernel_launch: device query failed\n"); grid = -1; return; }
        if (hipFuncSetAttribute((const void*)mk_fwd, hipFuncAttributeMaxDynamicSharedMemorySize, LDS_BYTES) != hipSuccess) { fprintf(stderr, "kernel_launch: hipFuncSetAttribute failed\n"); grid = -1; return; }
        if (hipOccupancyMaxActiveBlocksPerMultiprocessor(&per_cu, (const void*)mk_fwd, NTHREADS, LDS_BYTES) != hipSuccess || per_cu < 1) fprintf(stderr, "kernel_launch: occupancy query reports %d blocks per CU\n", per_cu);
        (void)hipGetLastError();
        grid = cus < 256 ? cus : 256;
        if (grid != 256) fprintf(stderr, "kernel_launch: %d CUs; the MoE row tables assume 256 workgroups\n", grid);
    }
    if (grid < 0) return;
    (void)hipMemsetAsync((char*)d_ws + WS_CTL, 0, CTL_ZERO_BYTES, stream);
    Args a{};
    for (int i = 0; i < 19; ++i) a.in[i] = (const float*)d_in[i];
    a.out = (float*)d_out; a.ws = (unsigned char*)d_ws;
    if (MK_N_LAUNCHES == 1) {
        a.ph_lo = 0; a.ph_hi = N_PHASES;
        hipLaunchKernelGGL(mk_fwd, dim3(grid), dim3(NTHREADS), LDS_BYTES, stream, a);
    } else {
        for (int p = 0; p < N_PHASES; ++p) { a.ph_lo = p; a.ph_hi = p + 1; hipLaunchKernelGGL(mk_fwd, dim3(grid), dim3(NTHREADS), LDS_BYTES, stream, a); }
    }
    const hipError_t le = hipPeekAtLastError();
    if (le != hipSuccess) fprintf(stderr, "kernel_launch: launch failed: %s\n", hipGetErrorName(le));
}
```
